# Optimizing an MI355X kernel written in HIP

```python
import jax, jax.numpy as jnp
from jax import lax
import numpy as np

D_MODEL = 1024
BATCH = 8
SEQ = 2048
DEPTH = 2

CHUNK = 64
CONV_WIDTH = 512
CONV_KERNEL = 31
RWKV_WIDTH = 512
RWKV_HEAD = 64
RWKV_HEADS = RWKV_WIDTH // RWKV_HEAD
LORA_W = 64
LORA_A = 64
LORA_G = 128
N_EXPERTS = 64
TOP_K = 8
N_GROUPS = 8
TOPK_GROUPS = 4
D_EXPERT = 256
D_SHARED = 256
ROUTED_SCALE = 2.5
EXPERT_BLOCK = 256
RMS_EPS = 1e-6
LN_EPS = 1e-5
GN_EPS = 64e-5

COL_CONV = 2 * CONV_WIDTH
COL_RWKV = 3 * RWKV_WIDTH + LORA_W + LORA_A + LORA_G
COL_GATE = 2 * D_MODEL
D_IN = COL_CONV + COL_RWKV + COL_GATE

kernel_name = 'hybrid_conv_rwkv7_moe_stream_encoder'


def rmsnorm(x, g):
    x32 = x.astype(jnp.float32)
    y = x32 * lax.rsqrt(jnp.mean(x32 * x32, axis=-1, keepdims=True) + RMS_EPS)
    return (y * g.astype(jnp.float32)).astype(x.dtype)


def layernorm(x, g, b):
    x32 = x.astype(jnp.float32)
    mu = jnp.mean(x32, axis=-1, keepdims=True)
    var = jnp.mean(jnp.square(x32 - mu), axis=-1, keepdims=True)
    y = (x32 - mu) * lax.rsqrt(var + LN_EPS) * g.astype(jnp.float32) + b.astype(jnp.float32)
    return y.astype(x.dtype)


def conformer_conv(zc, conv_w, conv_b, ln_g, ln_b, p_conv):
    u = zc[..., :CONV_WIDTH] * jax.nn.sigmoid(zc[..., CONV_WIDTH:])
    u = lax.conv_general_dilated(
        u, conv_w[:, None, :], window_strides=(1,),
        padding=[(CONV_KERNEL - 1, 0)],
        dimension_numbers=('NWC', 'WIO', 'NWC'),
        feature_group_count=CONV_WIDTH) + conv_b
    u = jax.nn.silu(layernorm(u, ln_g, ln_b))
    return u @ p_conv


def rwkv7_time_mix(zr, mu, w0, w2, a0, a2, g2, k_k, k_a, r_k, gn_g, gn_b, p_rwkv):
    B, S, _ = zr.shape
    f32 = jnp.float32
    prev = jnp.pad(zr, ((0, 0), (1, 0), (0, 0)))[:, :S]
    zr = zr + (prev - zr) * mu
    RW = RWKV_WIDTH
    r, k, v, wd, ad, gd = jnp.split(
        zr, [RW, 2 * RW, 3 * RW, 3 * RW + LORA_W, 3 * RW + LORA_W + LORA_A], axis=-1)
    w = -jax.nn.softplus(-(w0 + jnp.tanh(wd) @ w2)) - 0.5
    decay = jnp.exp(-jnp.exp(w.astype(f32)))
    a = jax.nn.sigmoid(a0 + ad @ a2)
    g = jax.nn.sigmoid(gd) @ g2
    kk = k * k_k
    k = k * (1.0 + (a - 1.0) * k_a)

    def heads(t):
        return t.astype(f32).reshape(B, S, RWKV_HEADS, RWKV_HEAD)

    r, k, v, kk, a, decay = (heads(t) for t in (r, k, v, kk, a, decay))
    kk = kk * lax.rsqrt(jnp.maximum(jnp.sum(kk * kk, axis=-1, keepdims=True), 1e-24))

    def step(state, inp):
        r_t, w_t, k_t, v_t, kk_t, a_t = inp
        sa = jnp.einsum('bhvk,bhk->bhv', state, -kk_t)
        state = (state * w_t[:, :, None, :]
                 + sa[..., None] * (kk_t * a_t)[:, :, None, :]
                 + v_t[..., None] * k_t[:, :, None, :])
        y_t = jnp.einsum('bhvk,bhk->bhv', state, r_t)
        return state, y_t

    xs = tuple(jnp.moveaxis(t, 1, 0) for t in (r, decay, k, v, kk, a))
    state0 = jnp.zeros((B, RWKV_HEADS, RWKV_HEAD, RWKV_HEAD), f32)
    _, y = lax.scan(step, state0, xs)
    y = jnp.moveaxis(y, 0, 1)
    mu_y = jnp.mean(y, axis=-1, keepdims=True)
    var_y = jnp.mean(jnp.square(y - mu_y), axis=-1, keepdims=True)
    y = ((y - mu_y) * lax.rsqrt(var_y + GN_EPS)).reshape(B, S, RW)
    y = y * gn_g.astype(f32) + gn_b.astype(f32)
    y = y + (jnp.sum(r * k * r_k.astype(f32), axis=-1, keepdims=True) * v).reshape(B, S, RW)
    return (y.astype(zr.dtype) * g) @ p_rwkv


def mixing_sublayer(h, w_in, mu_shift, conv_w, conv_b, conv_ln_g, conv_ln_b, p_conv,
                    w0, w2, a0, a2, g2, k_k, k_a, r_k, gn_g, gn_b, p_rwkv, w_o):
    z = h @ w_in
    zc, zr, zg = jnp.split(z, [COL_CONV, COL_CONV + COL_RWKV], axis=-1)
    y_conv = conformer_conv(zc, conv_w, conv_b, conv_ln_g, conv_ln_b, p_conv)
    y_rwkv = rwkv7_time_mix(zr, mu_shift, w0, w2, a0, a2, g2, k_k, k_a, r_k, gn_g, gn_b, p_rwkv)
    g_conv, g_rwkv = jnp.split(jax.nn.sigmoid(zg), 2, axis=-1)
    return (g_conv * y_conv + g_rwkv * y_rwkv) @ w_o


def moe_ffn(h, w_router, b_router, we_gate, we_up, we_down, ws_gate, ws_up, ws_down):
    B, S, D = h.shape
    t = h.reshape(-1, D)
    n = t.shape[0]
    f32 = jnp.float32
    per_grp = N_EXPERTS // N_GROUPS
    scores = jax.nn.sigmoid((t @ w_router).astype(f32))
    biased = scores + b_router.astype(f32)
    grp_score = lax.top_k(biased.reshape(n, N_GROUPS, per_grp), 2)[0].sum(-1)
    _, top_grp = lax.top_k(grp_score, TOPK_GROUPS)
    grp_mask = jnp.any(top_grp[:, :, None] == jnp.arange(N_GROUPS), axis=1)
    masked = jnp.where(jnp.repeat(grp_mask, per_grp, axis=1), biased, -jnp.inf)
    _, idx = lax.top_k(masked, TOP_K)
    sel = jnp.take_along_axis(scores, idx, axis=1)
    gate = sel / jnp.sum(sel, axis=-1, keepdims=True) * ROUTED_SCALE

    n_assign = n * TOP_K
    flat_e = idx.reshape(-1)
    order = jnp.argsort(flat_e)
    e_sorted = flat_e[order]
    tok = order // TOP_K
    counts = jnp.bincount(flat_e, length=N_EXPERTS)
    padded = (counts + EXPERT_BLOCK - 1) // EXPERT_BLOCK * EXPERT_BLOCK
    pad_end = jnp.cumsum(padded)
    pad_start = pad_end - padded
    start = jnp.cumsum(counts) - counts
    dest = pad_start[e_sorted] + jnp.arange(n_assign) - start[e_sorted]
    n_blocks = -(-n_assign // EXPERT_BLOCK) + N_EXPERTS
    buf = jnp.zeros((n_blocks * EXPERT_BLOCK, D), t.dtype).at[dest].set(t[tok])
    blk_expert = jnp.minimum(
        jnp.searchsorted(pad_end, jnp.arange(n_blocks) * EXPERT_BLOCK, side='right'),
        N_EXPERTS - 1)

    def expert_block(args):
        xb, e = args
        return (jax.nn.silu(xb @ we_gate[e]) * (xb @ we_up[e])) @ we_down[e]

    yb = lax.map(expert_block, (buf.reshape(n_blocks, EXPERT_BLOCK, D), blk_expert))
    y = yb.reshape(-1, D)[dest] * gate.reshape(-1)[order][:, None].astype(t.dtype)
    routed = jax.ops.segment_sum(y, tok, num_segments=n)
    shared = (jax.nn.silu(t @ ws_gate) * (t @ ws_up)) @ ws_down
    return (routed + shared).reshape(B, S, D)


def setup_inputs(seed: int = 0) -> dict:
    key = jax.random.key(seed)
    keys = jax.random.split(key, 40)
    counter = [0]

    def nk():
        k = keys[counter[0]]
        counter[0] += 1
        return k

    def nrm(shape, scale):
        return jax.random.normal(nk(), shape, jnp.float32) * scale

    def gain(shape):
        return 1.0 + nrm(shape, 0.05)

    L, D, CW, RW = DEPTH, D_MODEL, CONV_WIDTH, RWKV_WIDTH
    return {
        'x': nrm((BATCH, SEQ, D), 1.0),
        'c': nrm((BATCH, D), 1.0),
        'w_ada': nrm((L, D, 6 * D), 0.5 * D ** -0.5),
        'b_ada': nrm((L, 6 * D), 0.02),
        'norm_mix_pre': gain((L, D)),
        'norm_mix_post': gain((L, D)),
        'norm_ffn_pre': gain((L, D)),
        'norm_ffn_post': gain((L, D)),
        'w_in': nrm((L, D, D_IN), D ** -0.5),
        'mu_shift': jax.random.uniform(nk(), (L, COL_RWKV), jnp.float32),
        'conv_w': nrm((L, CONV_KERNEL, CW), CONV_KERNEL ** -0.5),
        'conv_b': nrm((L, CW), 0.02),
        'conv_ln_g': gain((L, CW)),
        'conv_ln_b': nrm((L, CW), 0.02),
        'p_conv': nrm((L, CW, D), CW ** -0.5),
        'w0': nrm((L, RW), 1.0) - 1.5,
        'w2': nrm((L, LORA_W, RW), LORA_W ** -0.5),
        'a0': nrm((L, RW), 0.5),
        'a2': nrm((L, LORA_A, RW), 0.5 * LORA_A ** -0.5),
        'g2': nrm((L, LORA_G, RW), LORA_G ** -0.5),
        'k_k': 0.85 + nrm((L, RW), 0.05),
        'k_a': gain((L, RW)),
        'r_k': nrm((L, RWKV_HEADS, RWKV_HEAD), 0.1),
        'gn_g': gain((L, RW)),
        'gn_b': nrm((L, RW), 0.02),
        'p_rwkv': nrm((L, RW, D), RW ** -0.5),
        'w_o': nrm((L, D, D), D ** -0.5),
        'w_router': nrm((L, D, N_EXPERTS), D ** -0.5),
        'b_router': nrm((L, N_EXPERTS), 0.01),
        'we_gate': nrm((L, N_EXPERTS, D, D_EXPERT), D ** -0.5),
        'we_up': nrm((L, N_EXPERTS, D, D_EXPERT), D ** -0.5),
        'we_down': nrm((L, N_EXPERTS, D_EXPERT, D), D_EXPERT ** -0.5),
        'ws_gate': nrm((L, D, D_SHARED), D ** -0.5),
        'ws_up': nrm((L, D, D_SHARED), D ** -0.5),
        'ws_down': nrm((L, D_SHARED, D), D_SHARED ** -0.5),
    }


def reference(x, c, w_ada, b_ada, norm_mix_pre, norm_mix_post, norm_ffn_pre, norm_ffn_post,
              w_in, mu_shift, conv_w, conv_b, conv_ln_g, conv_ln_b, p_conv,
              w0, w2, a0, a2, g2, k_k, k_a, r_k, gn_g, gn_b, p_rwkv, w_o,
              w_router, b_router, we_gate, we_up, we_down, ws_gate, ws_up, ws_down):
    for l in range(DEPTH):
        mod = jax.nn.silu(c) @ w_ada[l] + b_ada[l]
        sh1, sc1, gt1, sh2, sc2, gt2 = (m[:, None, :] for m in jnp.split(mod, 6, axis=-1))
        h = rmsnorm(x, norm_mix_pre[l]) * (1.0 + sc1) + sh1
        y = mixing_sublayer(h, w_in[l], mu_shift[l], conv_w[l], conv_b[l], conv_ln_g[l],
                            conv_ln_b[l], p_conv[l], w0[l], w2[l], a0[l], a2[l], g2[l],
                            k_k[l], k_a[l], r_k[l], gn_g[l], gn_b[l], p_rwkv[l], w_o[l])
        x = x + gt1 * rmsnorm(y, norm_mix_post[l])
        h = rmsnorm(x, norm_ffn_pre[l]) * (1.0 + sc2) + sh2
        y = moe_ffn(h, w_router[l], b_router[l], we_gate[l], we_up[l], we_down[l],
                    ws_gate[l], ws_up[l], ws_down[l])
        x = x + gt2 * rmsnorm(y, norm_ffn_post[l])
    return x
```

```cpp
#include <hip/hip_runtime.h>
#include <cstdio>
#include <cstdint>

#ifndef MK_PER_PHASE
#define MK_PER_PHASE 0
#endif
#ifndef MK_LAST_PHASE
#define MK_LAST_PHASE 9999
#endif

#define GAS __attribute__((address_space(1)))
#define LAS __attribute__((address_space(3)))
typedef unsigned short bf16;
typedef unsigned v4u __attribute__((ext_vector_type(4)));
typedef unsigned v2u __attribute__((ext_vector_type(2)));
typedef float f32x4 __attribute__((ext_vector_type(4)));
typedef float f32x2 __attribute__((ext_vector_type(2)));
typedef short bf16x8 __attribute__((ext_vector_type(8)));
typedef GAS unsigned gu32;
#define RLX_AGENT __ATOMIC_RELAXED, __HIP_MEMORY_SCOPE_AGENT
#define LDS_WAIT() asm volatile("s_waitcnt lgkmcnt(0)" ::: "memory")
#define VM_WAIT() asm volatile("s_waitcnt vmcnt(0)" ::: "memory")

constexpr int NB = 8, SEQ = 2048, D = 1024, M = NB * SEQ, DEPTH = 2;
constexpr int CW = 512, CKW = 31, RW = 512, RH = 64, NH = 8, LW = 64, LA = 64, LG = 128;
constexpr int NE = 64, TOPK = 8, DE = 256;
constexpr int DIN = 4864, ZR0 = 1024, ZG0 = 2816, COLR = 1792;
constexpr int NLORA = 1536, KLORA = 256;
constexpr float RMS_EPS = 1e-6f, LN_EPS = 1e-5f, GN_EPS = 64e-5f, ROUTED_SCALE = 2.5f;
constexpr int NWAVES = 8, NTHREADS = 512;

enum { I_X = 0, I_C, I_WADA, I_BADA, I_NMPRE, I_NMPOST, I_NFPRE, I_NFPOST, I_WIN, I_MU, I_CONVW, I_CONVB, I_CLNG, I_CLNB, I_PCONV,
       I_W0, I_W2, I_A0, I_A2, I_G2, I_KK, I_KA, I_RK, I_GNG, I_GNB, I_PRWKV, I_WO, I_WROUTER, I_BROUTER, I_WEG, I_WEU, I_WED, I_WSG, I_WSU, I_WSD, N_IN };

constexpr size_t MiB = 1u << 20;
constexpr size_t WS_CTL = 0, CTL_ZERO_BYTES = 1 * MiB;
constexpr size_t WS_MOD = 1 * MiB;
constexpr size_t WS_BONUS = 1 * MiB + 512 * 1024;
constexpr size_t WS_WMIX = 2 * MiB;
constexpr size_t WMIX_STRIDE = 15 * MiB;
constexpr size_t WM_WIN = 0, WM_PCONV = (size_t)DIN * D * 2, WM_PRWKV = WM_PCONV + (size_t)D * CW * 2, WM_WO = WM_PRWKV + (size_t)D * RW * 2, WM_LORA = WM_WO + (size_t)D * D * 2;
static_assert(WM_LORA + (size_t)NLORA * KLORA * 2 <= WMIX_STRIDE, "wmix");
constexpr size_t WS_WGU = 32 * MiB;
constexpr size_t WS_WDN = 97 * MiB;
constexpr size_t WS_H = 130 * MiB;
constexpr size_t WS_LIST = 162 * MiB;
constexpr size_t WS_GW = 167 * MiB;
constexpr size_t WS_TOKA = 172 * MiB;
constexpr size_t WS_S = 173 * MiB;
constexpr size_t WS_Z = WS_S;
constexpr size_t WS_LIN = WS_S + 152 * MiB;
constexpr size_t WS_LOUT = WS_S + 160 * MiB;
constexpr size_t WS_SR = WS_S + 208 * MiB;
constexpr size_t WS_SKP = WS_SR + 16 * MiB, WS_SV = WS_SR + 32 * MiB, WS_SKKN = WS_SR + 48 * MiB, WS_SKA = WS_SR + 64 * MiB;
constexpr size_t WS_SDEC = WS_SR + 80 * MiB;
constexpr size_t WS_YS = WS_SDEC + 32 * MiB;
constexpr size_t WS_UC = WS_S + 352 * MiB;
constexpr size_t WS_YG = WS_SR;
constexpr size_t WS_MERGED = WS_SKKN;
constexpr size_t WS_Y = WS_SDEC;
constexpr size_t WS_ACT = WS_S;
constexpr size_t WS_YEXP = WS_S + 74 * MiB;
constexpr size_t WS_YSH = WS_S + 330 * MiB;
static_assert(WS_YSH == WS_YEXP + (size_t)M * TOPK * D * 2, "YSH follows YEXP");
constexpr size_t WS_END = WS_S + 368 * MiB;
constexpr int CW_BAR = 4096;
constexpr int CW_CNT = 16384;
constexpr int RING_BYTES = 131072, LDS_TAB_OFF = RING_BYTES, LDS_TAB_BYTES = 12288, LDS_ROWTAB_OFF = LDS_TAB_OFF + LDS_TAB_BYTES, MISC_OFF = LDS_ROWTAB_OFF + 2048, LDS_BYTES = 147456;
static_assert(MISC_OFF + 256 <= LDS_BYTES, "lds");

__device__ __forceinline__ unsigned f2bf(float f) { unsigned u = __builtin_bit_cast(unsigned, f); return (u + 0x7fffu + ((u >> 16) & 1u)) >> 16; }
__device__ __forceinline__ unsigned pk2(float lo, float hi) { return f2bf(lo) | (f2bf(hi) << 16); }
__device__ __forceinline__ float bf2f(unsigned b) { return __builtin_bit_cast(float, b << 16); }
__device__ __forceinline__ float bflo(unsigned w) { return __builtin_bit_cast(float, w << 16); }
__device__ __forceinline__ float bfhi(unsigned w) { return __builtin_bit_cast(float, w & 0xffff0000u); }
__device__ __forceinline__ float sigmoidf_(float x) { return 1.0f / (1.0f + __expf(-x)); }
__device__ __forceinline__ float siluf_(float x) { return x / (1.0f + __expf(-x)); }
__device__ __forceinline__ float wave_sum(float v) {
#pragma unroll
    for (int o = 1; o < 64; o <<= 1) v += __shfl_xor(v, o);
    return v;
}

namespace pg8 {
constexpr int BM = 256, BK = 64, HALF = 128, HTB = HALF * BK * 2, STAGE_BYTES = 8 * HTB, NXCD = 8, WGM = 8;
__host__ __device__ __forceinline__ int lds_byte(int r, int c) { const int st = (r >> 4) * 2 + (c >> 5), rr = r & 15, cc = c & 31, ob = rr * 64 + cc * 2; return st * 1024 + (ob ^ (((ob >> 9) & 1) << 5)); }
__host__ __device__ __forceinline__ void stage_rc(int b, int& R, int& C) { const int st = b / 1024, sb = b % 1024, swz = sb ^ (((sb >> 9) & 1) << 5); R = (st >> 1) * 16 + swz / 64; C = (st & 1) * 32 + (swz % 64) / 2; }
__host__ __device__ __forceinline__ int perm32(int rho) { const int n = rho >> 4, i = rho & 15; return 8 * (i >> 2) + 4 * n + (i & 3); }

struct Unit { int a0, b0, o0, oc0, nrows, e, x0; };
struct Gemm { const bf16* A; const bf16* Bt; int K; const int* list; };

struct StaticOrder {
    int nM, nN, nwg, G, c;
    __device__ void init(int M_, int N_, int G_, int c_) { nM = M_ / BM; nN = N_ / BM; nwg = nM * nN; G = G_; c = c_; }
    __device__ bool next(int i, Unit& u) const {
        const long L = (long)i * G + c; if (L >= nwg) return false;
        int wgid = (int)L; { const int q = nwg / NXCD, r = nwg % NXCD, xcd = wgid % NXCD, off = wgid / NXCD; wgid = (xcd < r ? xcd * (q + 1) : r * (q + 1) + (xcd - r) * q) + off; }
        const int nig = WGM * nN, gid = wgid / nig, fm = gid * WGM, gsz = (nM - fm) < WGM ? (nM - fm) : WGM;
        const int pm = fm + ((wgid % nig) % gsz), pn = (wgid % nig) / gsz;
        u.a0 = pm * BM; u.b0 = pn * BM; u.o0 = pm * BM; u.oc0 = pn * BM; u.nrows = BM; u.e = 0; u.x0 = 0; return true;
    }
};

__device__ __forceinline__ unsigned cvt_pk_bf16(float lo, float hi) { unsigned r; asm volatile("v_cvt_pk_bf16_f32 %0, %1, %2" : "=v"(r) : "v"(lo), "v"(hi)); return r; }

struct EpiF32 {
    static constexpr bool PERM = false;
    float* C; int ldc;
    __device__ __forceinline__ void operator()(const f32x4 (&acc)[2][2][4][2], const Unit& u, int wr, int wc, int fr, int fq) const {
        const int row0 = wr * 64 + fr, col0 = u.oc0 + wc * 32 + 4 * fq;
#pragma unroll
        for (int ai = 0; ai < 2; ++ai)
#pragma unroll
            for (int m = 0; m < 4; ++m) { const int r = row0 + ai * HALF + m * 16; if (r < u.nrows) { float* rowp = C + (size_t)(u.o0 + r) * ldc + col0;
#pragma unroll
                for (int bj = 0; bj < 2; ++bj)
#pragma unroll
                    for (int n = 0; n < 2; ++n) *(f32x4*)(rowp + bj * HALF + n * 16) = acc[ai][bj][m][n]; } }
    }
};
struct EpiBf16 {
    static constexpr bool PERM = true;
    bf16* O; int ldc; const float* rowscale;
    __device__ __forceinline__ void operator()(const f32x4 (&acc)[2][2][4][2], const Unit& u, int wr, int wc, int fr, int fq) const {
        const int row0 = wr * 64 + fr, col0 = u.oc0 + wc * 32 + 8 * fq;
#pragma unroll
        for (int ai = 0; ai < 2; ++ai)
#pragma unroll
            for (int m = 0; m < 4; ++m) { const int r = row0 + ai * HALF + m * 16; if (r < u.nrows) { bf16* rowp = O + (size_t)(u.o0 + r) * ldc + col0;
                const float sc = rowscale ? rowscale[u.x0 + r] : 1.0f;
#pragma unroll
                for (int bj = 0; bj < 2; ++bj) { const f32x4 v0 = acc[ai][bj][m][0] * sc, v1 = acc[ai][bj][m][1] * sc;
                    v4u w; w.x = cvt_pk_bf16(v0[0], v0[1]); w.y = cvt_pk_bf16(v0[2], v0[3]); w.z = cvt_pk_bf16(v1[0], v1[1]); w.w = cvt_pk_bf16(v1[2], v1[3]);
                    *(v4u*)(rowp + bj * HALF) = w; } } }
    }
};
template <bool FIRST> struct EpiMerge {
    static constexpr bool PERM = true;
    bf16* O; const bf16* Z; int gcol0;
    __device__ __forceinline__ void operator()(const f32x4 (&acc)[2][2][4][2], const Unit& u, int wr, int wc, int fr, int fq) const {
        const int row0 = u.o0 + wr * 64 + fr, col0 = u.oc0 + wc * 32 + 8 * fq;
#pragma unroll
        for (int ai = 0; ai < 2; ++ai)
#pragma unroll
            for (int m = 0; m < 4; ++m) { const int r = row0 + ai * HALF + m * 16; bf16* rowp = O + (size_t)r * D + col0; const bf16* zp = Z + (size_t)r * DIN + gcol0 + col0;
#pragma unroll
                for (int bj = 0; bj < 2; ++bj) { const v4u g = *(const v4u*)(zp + bj * HALF); const f32x4 a0 = acc[ai][bj][m][0], a1 = acc[ai][bj][m][1];
                    float o[8];
                    o[0] = a0[0] * sigmoidf_(bflo(g.x)); o[1] = a0[1] * sigmoidf_(bfhi(g.x)); o[2] = a0[2] * sigmoidf_(bflo(g.y)); o[3] = a0[3] * sigmoidf_(bfhi(g.y));
                    o[4] = a1[0] * sigmoidf_(bflo(g.z)); o[5] = a1[1] * sigmoidf_(bfhi(g.z)); o[6] = a1[2] * sigmoidf_(bflo(g.w)); o[7] = a1[3] * sigmoidf_(bfhi(g.w));
                    if (!FIRST) { const v4u p = *(const v4u*)(rowp + bj * HALF);
                        o[0] += bflo(p.x); o[1] += bfhi(p.x); o[2] += bflo(p.y); o[3] += bfhi(p.y); o[4] += bflo(p.z); o[5] += bfhi(p.z); o[6] += bflo(p.w); o[7] += bfhi(p.w); }
                    v4u w; w.x = cvt_pk_bf16(o[0], o[1]); w.y = cvt_pk_bf16(o[2], o[3]); w.z = cvt_pk_bf16(o[4], o[5]); w.w = cvt_pk_bf16(o[6], o[7]);
                    *(v4u*)(rowp + bj * HALF) = w; } }
    }
};
struct EpiSwiGLU {
    static constexpr bool PERM = true;
    bf16* O;
    __device__ __forceinline__ void operator()(const f32x4 (&acc)[2][2][4][2], const Unit& u, int wr, int wc, int fr, int fq) const {
        const int row0 = wr * 64 + fr, col0 = (u.oc0 >> 1) + wc * 32 + 8 * fq;
#pragma unroll
        for (int ai = 0; ai < 2; ++ai)
#pragma unroll
            for (int m = 0; m < 4; ++m) { const int r = row0 + ai * HALF + m * 16; if (r < u.nrows) { bf16* rowp = O + (size_t)(u.o0 + r) * DE + col0;
                const f32x4 g0 = acc[ai][0][m][0], g1 = acc[ai][0][m][1], u0 = acc[ai][1][m][0], u1 = acc[ai][1][m][1];
                v4u w; w.x = cvt_pk_bf16(siluf_(g0[0]) * u0[0], siluf_(g0[1]) * u0[1]); w.y = cvt_pk_bf16(siluf_(g0[2]) * u0[2], siluf_(g0[3]) * u0[3]);
                w.z = cvt_pk_bf16(siluf_(g1[0]) * u1[0], siluf_(g1[1]) * u1[1]); w.w = cvt_pk_bf16(siluf_(g1[2]) * u1[2], siluf_(g1[3]) * u1[3]);
                *(v4u*)rowp = w; } }
    }
};

constexpr int ROWTAB_OFF = 131072 + 12288;
template <class Epi, class Sched, bool GATHER>
__device__ __forceinline__ void gemm_phase(LAS unsigned char* lds, const int tid, const Gemm g, const Sched& S, const Epi& E) {
    const int wid = __builtin_amdgcn_readfirstlane(tid >> 6), lane = tid & 63, wr = wid >> 2, wc = wid & 3, fr = lane & 15, fq = lane >> 4;
    const int K = g.K, nt = K / BK;
    int sR, sC; stage_rc(tid * 16, sR, sC);
    const unsigned voffA = (unsigned)(sR * K + sC) * 2u;
    const unsigned voffB = (unsigned)((Epi::PERM ? ((sR & ~31) + perm32(sR & 31)) : sR) * K + sC) * 2u;
    const size_t kstep = (size_t)(BK * 2);
    const size_t pstep = (size_t)64 * K * 2;
    const size_t hstep = (size_t)HALF * K * 2;
    const unsigned ldsw = (unsigned)wid * 1024u;
    const int aoff = lds_byte(wr * 64 + fr, fq * 8), boff = lds_byte(wc * 32 + fr, fq * 8);
    LAS unsigned* rowtab = (LAS unsigned*)(lds + ROWTAB_OFF);
#define PG8_SA(b, h) (((b) * 2 + (h)) * HTB)
#define PG8_SB(b, h) ((4 + (b) * 2 + (h)) * HTB)
#define PG8_STAGE(bufoff, gbase, voff) do { _Pragma("unroll") for (int _i = 0; _i < 2; ++_i) \
        __builtin_amdgcn_global_load_lds((const unsigned*)((const char*)(gbase) + _i * pstep + (voff)), (LAS unsigned*)(lds + (bufoff) + ldsw + _i * 8192), 16, 0, 0); } while (0)
#define PG8_STAGE_G(bufoff, kb, sel, h) do { _Pragma("unroll") for (int _i = 0; _i < 2; ++_i) { const unsigned _ro = rowtab[(sel) * 256 + (h) * HALF + sR + 64 * _i]; \
        __builtin_amdgcn_global_load_lds((const unsigned*)((const char*)(kb) + _ro + (unsigned)(sC * 2)), (LAS unsigned*)(lds + (bufoff) + ldsw + _i * 8192), 16, 0, 0); } } while (0)
#define PG8_STAGE_A(bufoff, basep, kb, sel, h) do { if constexpr (GATHER) PG8_STAGE_G(bufoff, (const char*)g.A + (kb), sel, h); else PG8_STAGE(bufoff, (basep) + (kb) + (h) * hstep, voffA); } while (0)
#define PG8_ROWTAB(sel, u) do { if (tid < 256) { const int _rr = tid < (u).nrows ? tid : (u).nrows - 1; rowtab[(sel) * 256 + tid] = (unsigned)g.list[(u).x0 + _rr] * (unsigned)(K * 2); } } while (0)
#define PG8_LDA(dst, b, h) do { _Pragma("unroll") for (int m = 0; m < 4; ++m) _Pragma("unroll") for (int k = 0; k < 2; ++k) dst[m][k] = *(const LAS bf16x8*)(lds + PG8_SA(b, h) + aoff + m * 2048 + k * 1024); } while (0)
#define PG8_LDB(dst, b, h) do { _Pragma("unroll") for (int n = 0; n < 2; ++n) _Pragma("unroll") for (int k = 0; k < 2; ++k) dst[n][k] = *(const LAS bf16x8*)(lds + PG8_SB(b, h) + boff + n * 2048 + k * 1024); } while (0)
#define PG8_MMA(ai, bj, At, Bt) do { __builtin_amdgcn_s_setprio(1); _Pragma("unroll") for (int m = 0; m < 4; ++m) _Pragma("unroll") for (int n = 0; n < 2; ++n) _Pragma("unroll") for (int k = 0; k < 2; ++k) \
        acc[ai][bj][m][n] = __builtin_amdgcn_mfma_f32_16x16x32_bf16(Bt[n][k], At[m][k], acc[ai][bj][m][n], 0, 0, 0); __builtin_amdgcn_s_setprio(0); } while (0)
#define PG8_WAIT_V(n) asm volatile("s_waitcnt vmcnt(" #n ")" ::: "memory")
#define PG8_WAIT_L(n) asm volatile("s_waitcnt lgkmcnt(" #n ")" ::: "memory")
#define PG8_BAR __builtin_amdgcn_s_barrier()
#define PG8_SCHED __builtin_amdgcn_sched_barrier(0)
    Unit cur, nxt; int ui = 0;
    if (!S.next(0, cur)) return;
    f32x4 acc[2][2][4][2];
#pragma unroll
    for (int a = 0; a < 2; ++a)
#pragma unroll
        for (int b = 0; b < 2; ++b)
#pragma unroll
            for (int m = 0; m < 4; ++m)
#pragma unroll
                for (int n = 0; n < 2; ++n) acc[a][b][m][n] = (f32x4){0.f, 0.f, 0.f, 0.f};
    bf16x8 At[4][2], B0[2][2], B1[2][2];
    int par = 0;
    if constexpr (GATHER) { PG8_ROWTAB(0, cur); asm volatile("s_waitcnt vmcnt(0) lgkmcnt(0)" ::: "memory"); __syncthreads(); }
    const char* cA = (const char*)g.A + (size_t)cur.a0 * K * 2;
    const char* cB = (const char*)g.Bt + (size_t)cur.b0 * K * 2;
    PG8_STAGE(PG8_SB(0, 0), cB, voffB); PG8_STAGE(PG8_SB(0, 1), cB + hstep, voffB); PG8_STAGE_A(PG8_SA(0, 0), cA, 0, 0, 0); PG8_STAGE_A(PG8_SA(0, 1), cA, 0, 0, 1);
    if (wr == 1) PG8_BAR;
    PG8_WAIT_V(2); PG8_BAR;
    PG8_STAGE(PG8_SB(1, 0), cB + kstep, voffB); PG8_STAGE_A(PG8_SA(1, 0), cA, kstep, 0, 0); PG8_STAGE(PG8_SB(1, 1), cB + hstep + kstep, voffB);
    PG8_WAIT_V(6); PG8_BAR;
    for (;;) {
        const bool has_next = S.next(ui + 1, nxt);
        if constexpr (GATHER) { if (has_next) { PG8_ROWTAB(par ^ 1, nxt); asm volatile("s_waitcnt vmcnt(0) lgkmcnt(0)" ::: "memory"); } }
        const char* nA = has_next ? (const char*)g.A + (size_t)nxt.a0 * K * 2 : cA;
        const char* nB = has_next ? (const char*)g.Bt + (size_t)nxt.b0 * K * 2 : cB;
        const int npar = has_next ? (par ^ 1) : par;
        for (int t = 0; t < nt; t += 2) {
            const bool last = (t == nt - 2);
            const size_t k1 = (size_t)(t + 1) * kstep;
            const char* a2 = last ? nA : cA; const size_t k2 = last ? 0 : (size_t)(t + 2) * kstep; const char* b2 = last ? nB : cB + (size_t)(t + 2) * kstep;
            const size_t k3 = k2 + kstep; const char* b3 = b2 + kstep;
            const int p2 = last ? npar : par;
            PG8_LDB(B0, 0, 0); PG8_LDB(B1, 0, 1); PG8_SCHED; PG8_LDA(At, 0, 0); PG8_STAGE_A(PG8_SA(1, 1), cA, k1, par, 1);
            PG8_WAIT_V(8); PG8_WAIT_L(0); PG8_BAR; PG8_MMA(0, 0, At, B0); PG8_MMA(0, 1, At, B1); PG8_BAR; PG8_SCHED;
            PG8_LDA(At, 0, 1); PG8_STAGE(PG8_SB(0, 0), b2, voffB); PG8_STAGE(PG8_SB(0, 1), b2 + hstep, voffB); PG8_STAGE_A(PG8_SA(0, 0), a2, k2, p2, 0);
            PG8_WAIT_V(8); PG8_WAIT_L(0); PG8_BAR; PG8_MMA(1, 0, At, B0); PG8_MMA(1, 1, At, B1); PG8_BAR; PG8_SCHED;
            PG8_LDB(B0, 1, 0); PG8_LDB(B1, 1, 1); PG8_SCHED; PG8_LDA(At, 1, 0); PG8_STAGE_A(PG8_SA(0, 1), a2, k2, p2, 1);
            PG8_WAIT_V(8); PG8_WAIT_L(0); PG8_BAR; PG8_MMA(0, 0, At, B0); PG8_MMA(0, 1, At, B1); PG8_BAR; PG8_SCHED;
            PG8_LDA(At, 1, 1); PG8_STAGE(PG8_SB(1, 0), b3, voffB); PG8_STAGE(PG8_SB(1, 1), b3 + hstep, voffB); PG8_STAGE_A(PG8_SA(1, 0), a2, k3, p2, 0);
            PG8_WAIT_V(8); PG8_WAIT_L(0); PG8_BAR; PG8_MMA(1, 0, At, B0); PG8_MMA(1, 1, At, B1); PG8_BAR; PG8_SCHED;
        }
        if (wr == 0) PG8_BAR;
        E(acc, cur, wr, wc, fr, fq);
        if (!has_next) break;
#pragma unroll
        for (int a = 0; a < 2; ++a)
#pragma unroll
            for (int b = 0; b < 2; ++b)
#pragma unroll
                for (int m = 0; m < 4; ++m)
#pragma unroll
                    for (int n = 0; n < 2; ++n) acc[a][b][m][n] = (f32x4){0.f, 0.f, 0.f, 0.f};
        cur = nxt; cA = nA; cB = nB; par = npar; ++ui;
        if (wr == 1) PG8_BAR;
    }
    PG8_WAIT_V(0);
    PG8_BAR;
#undef PG8_SA
#undef PG8_SB
#undef PG8_STAGE
#undef PG8_STAGE_G
#undef PG8_STAGE_A
#undef PG8_ROWTAB
#undef PG8_LDA
#undef PG8_LDB
#undef PG8_MMA
#undef PG8_WAIT_V
#undef PG8_WAIT_L
#undef PG8_BAR
#undef PG8_SCHED
}
}

#define XB_TMO      128
#define XB_XCNT(j)  (256  + 64 * (j))
#define XB_XSUB(j)  (1280 + 64 * (j))
#define XB_XGEN(j)  (2304 + 64 * (j))
#define XB_TOP      3328
#define XB_TOPGEN   3392
#define XCD_BAR_WORDS 3456
#define XB_SPIN_CAP (1u << 18)
__device__ __forceinline__ unsigned xb_ld(unsigned* p)              { return __hip_atomic_load(p, __ATOMIC_RELAXED, __HIP_MEMORY_SCOPE_AGENT); }
__device__ __forceinline__ unsigned xb_add(unsigned* p, unsigned v) { return __hip_atomic_fetch_add(p, v, __ATOMIC_RELAXED, __HIP_MEMORY_SCOPE_AGENT); }
__device__ __forceinline__ unsigned xb_xcc_id() { return (unsigned)__builtin_amdgcn_s_getreg((3 << 11) | 20) & 0xFu; }
#define XB_SPIN(cond, bar) do { unsigned _sp = 0; while (cond) { __builtin_amdgcn_s_sleep(1); \
    if ((++_sp & 255u) == 0u) { if (xb_ld(&(bar)[XB_TMO])) break; if (_sp > XB_SPIN_CAP) { atomicAdd(&(bar)[XB_TMO], 1u); break; } } } } while (0)
struct XcdBarrier { unsigned* bar; unsigned x; volatile LAS unsigned* st; };
__device__ __forceinline__ XcdBarrier xcd_barrier_post(unsigned* bar, volatile LAS unsigned* st) {
    XcdBarrier b; b.bar = bar; b.x = xb_xcc_id(); b.st = st;
    if (threadIdx.x == 0) (void)xb_add(&bar[XB_XCNT(b.x)], 1u);
    return b;
}
__device__ __forceinline__ void xcd_barrier_complete(unsigned* bar, unsigned x, unsigned& nloc, unsigned& nx) {
    const unsigned G = gridDim.x * gridDim.y * gridDim.z;
    unsigned sum, cnt, mine, sp = 0u;
    for (;;) {
        sum = 0u; cnt = 0u; mine = 0u;
#pragma unroll
        for (unsigned j = 0; j < 16; ++j) { const unsigned c = xb_ld(&bar[XB_XCNT(j)]); sum += c; cnt += (c > 0u) ? 1u : 0u; mine = (j == x) ? c : mine; }
        if (sum == G) break;
        __builtin_amdgcn_s_sleep(1);
        if ((++sp & 255u) == 0u) { if (xb_ld(&bar[XB_TMO])) break; if (sp > XB_SPIN_CAP) { atomicAdd(&bar[XB_TMO], 1u); break; } }
    }
    nloc = mine > 0u ? mine : 1u; nx = cnt > 0u ? cnt : 1u;
}
__device__ __forceinline__ void xcd_barrier(const XcdBarrier& b) {
    asm volatile("s_waitcnt vmcnt(0)" ::: "memory");
    __syncthreads();
    if (threadIdx.x == 0) {
        unsigned* bar = b.bar;
        __builtin_amdgcn_s_waitcnt(0);
        unsigned nloc = b.st[0], nx = b.st[1];
        if (nloc == 0u) { xcd_barrier_complete(bar, b.x, nloc, nx); b.st[0] = nloc; b.st[1] = nx; }
        const unsigned old = xb_add(&bar[XB_XSUB(b.x)], 1u);
        const unsigned gen = old / nloc;
        if (old + 1u == (gen + 1u) * nloc) {
            __builtin_amdgcn_fence(__ATOMIC_RELEASE, "agent");
            asm volatile("s_waitcnt vmcnt(0)" ::: "memory");
            const unsigned og = xb_add(&bar[XB_TOP], 1u);
            const unsigned tg = og / nx;
            if (og + 1u == (tg + 1u) * nx) xb_add(&bar[XB_TOPGEN], 1u);
            else XB_SPIN(xb_ld(&bar[XB_TOPGEN]) == tg, bar);
            __builtin_amdgcn_fence(__ATOMIC_ACQUIRE, "agent");
            xb_add(&bar[XB_XGEN(b.x)], 1u);
            asm volatile("s_waitcnt vmcnt(0)" ::: "memory");
        } else {
            XB_SPIN(xb_ld(&bar[XB_XGEN(b.x)]) == gen, bar);
            __builtin_amdgcn_fence(__ATOMIC_ACQUIRE, "agent");
            asm volatile("s_waitcnt vmcnt(0)" ::: "memory");
        }
    }
    __syncthreads();
}

struct Args { const float* in[N_IN]; float* out; unsigned char* ws; int ph_lo, ph_hi; };
struct Frame {
    LAS unsigned char* lds;
    int tid, lane, wave, G, bid;
    const float* const __attribute__((address_space(4)))* in; float* out; unsigned char* ws;
};
__device__ __forceinline__ const float* mod_ptr(const Frame& F, int l, int b, int part) { return (const float*)(F.ws + WS_MOD) + ((size_t)(l * NB + b) * 6 + part) * D; }

__device__ __forceinline__ void transpose_item(const float* W, int N, int k0, int n0, bf16* WT, int ldo, int drow0, int dcol0, LAS float* scr, int lane) {
#pragma unroll 8
    for (int i = 0; i < 32; ++i) { const int kk = 2 * i + (lane >> 5); scr[kk * 33 + (lane & 31)] = W[(size_t)(k0 + kk) * N + n0 + (lane & 31)]; }
    LDS_WAIT(); asm volatile("" ::: "memory");
    const int c = lane & 7;
#pragma unroll
    for (int j = 0; j < 4; ++j) { const int n = (lane >> 3) + 8 * j; const LAS float* s = scr + (8 * c) * 33 + n;
        v4u o; o.x = pk2(s[0 * 33], s[1 * 33]); o.y = pk2(s[2 * 33], s[3 * 33]); o.z = pk2(s[4 * 33], s[5 * 33]); o.w = pk2(s[6 * 33], s[7 * 33]);
        *(GAS v4u*)(WT + (size_t)(drow0 + n) * ldo + dcol0 + k0 + 8 * c) = o; }
    LDS_WAIT(); asm volatile("" ::: "memory");
}
__device__ __forceinline__ int titems(int K, int N) { return (K / 64) * (N / 32); }
__device__ __forceinline__ void tdo(const float* W, int K, int N, int item, bf16* WT, int ldo, int drow0, LAS float* scr, int lane) {
    const int nblk = N / 32, kb = item / nblk, nb = item % nblk; transpose_item(W, N, 64 * kb, 32 * nb, WT, ldo, drow0 + 32 * nb, 0, scr, lane);
}

__device__ __forceinline__ void phase_mix_weights(Frame& F, int gw, int NGW) {
    LAS float* scr = (LAS float*)(F.lds + 65536 + F.wave * 8704);
    constexpr int T_WIN = (D / 64) * (DIN / 32), T_PC = (CW / 64) * (D / 32), T_PR = (RW / 64) * (D / 32), T_WO = (D / 64) * (D / 32), T_L = T_WIN + T_PC + T_PR + T_WO;
    for (int it = gw; it < DEPTH * T_L; it += NGW) {
        const int l = it / T_L; int r = it % T_L; unsigned char* wm = F.ws + WS_WMIX + (size_t)l * WMIX_STRIDE;
        if (r < T_WIN) { tdo(F.in[I_WIN] + (size_t)l * D * DIN, D, DIN, r, (bf16*)(wm + WM_WIN), D, 0, scr, F.lane); continue; } r -= T_WIN;
        if (r < T_PC) { tdo(F.in[I_PCONV] + (size_t)l * CW * D, CW, D, r, (bf16*)(wm + WM_PCONV), CW, 0, scr, F.lane); continue; } r -= T_PC;
        if (r < T_PR) { tdo(F.in[I_PRWKV] + (size_t)l * RW * D, RW, D, r, (bf16*)(wm + WM_PRWKV), RW, 0, scr, F.lane); continue; } r -= T_PR;
        tdo(F.in[I_WO] + (size_t)l * D * D, D, D, r, (bf16*)(wm + WM_WO), D, 0, scr, F.lane);
    }
    for (int i = gw * 64 + F.lane; i < DEPTH * NLORA * KLORA; i += NGW * 64) {
        const int l = i / (NLORA * KLORA), r = i % (NLORA * KLORA), n = r / KLORA, k = r % KLORA; float v = 0.f;
        if (n < 512) { if (k < 64) v = F.in[I_W2][((size_t)l * LW + k) * RW + n]; }
        else if (n < 1024) { if (k >= 64 && k < 128) v = F.in[I_A2][((size_t)l * LA + (k - 64)) * RW + (n - 512)]; }
        else { if (k >= 128) v = F.in[I_G2][((size_t)l * LG + (k - 128)) * RW + (n - 1024)]; }
        ((bf16*)(F.ws + WS_WMIX + (size_t)l * WMIX_STRIDE + WM_LORA))[r] = (bf16)f2bf(v);
    }
}
__device__ __forceinline__ void phase_expert_weights(Frame& F, int l, int gw, int NGW) {
    LAS float* scr = (LAS float*)(F.lds + 65536 + F.wave * 8704);
    bf16* WGU = (bf16*)(F.ws + WS_WGU); bf16* WDN = (bf16*)(F.ws + WS_WDN);
    constexpr int T_G = (D / 64) * (DE / 32), T_D = (DE / 64) * (D / 32), T_E = 2 * T_G + T_D;
    for (int it = gw; it < (NE + 1) * T_E; it += NGW) {
        const int e = it / T_E; int r = it % T_E;
        if (r < 2 * T_G) { const int up = r >= T_G; if (up) r -= T_G;
            const float* W = (e < NE) ? (up ? F.in[I_WEU] : F.in[I_WEG]) + ((size_t)l * NE + e) * D * DE : (up ? F.in[I_WSU] : F.in[I_WSG]) + (size_t)l * D * DE;
            const int nblk = DE / 32, kb = r / nblk, nb = r % nblk, n0 = 32 * nb;
            const int drow0 = e * 512 + (n0 >> 7) * 256 + (up ? 128 : 0) + (n0 & 127);
            transpose_item(W, DE, 64 * kb, n0, WGU, D, drow0, 0, scr, F.lane);
        } else { r -= 2 * T_G;
            const float* W = (e < NE) ? F.in[I_WED] + ((size_t)l * NE + e) * DE * D : F.in[I_WSD] + (size_t)l * DE * D;
            tdo(W, DE, D, r, WDN, DE, e * D, scr, F.lane);
        }
    }
}
__device__ __forceinline__ void phase_ada(Frame& F) {
    LAS float* sc = (LAS float*)F.lds;
    LAS float* red = (LAS float*)(F.lds + 32768);
    for (int i = F.tid; i < NB * D; i += NTHREADS) { const int b = i / D, k = i % D; sc[k * 8 + b] = siluf_(F.in[I_C][i]); }
    __syncthreads();
    float* mod = (float*)(F.ws + WS_MOD);
    for (int it = F.bid; it < DEPTH * 96; it += F.G) {
        const int l = it / 96, n0 = (it % 96) * 64;
        float acc[8];
#pragma unroll
        for (int b = 0; b < 8; ++b) acc[b] = 0.f;
        const float* wp = F.in[I_WADA] + ((size_t)l * D + F.wave * 128) * (6 * D) + n0 + F.lane;
#pragma unroll 4
        for (int k = 0; k < 128; ++k) { const float wv = wp[(size_t)k * (6 * D)]; const LAS f32x4* s = (const LAS f32x4*)(sc + (F.wave * 128 + k) * 8); const f32x4 s0 = s[0], s1 = s[1];
            acc[0] += s0[0] * wv; acc[1] += s0[1] * wv; acc[2] += s0[2] * wv; acc[3] += s0[3] * wv; acc[4] += s1[0] * wv; acc[5] += s1[1] * wv; acc[6] += s1[2] * wv; acc[7] += s1[3] * wv; }
#pragma unroll
        for (int b = 0; b < 8; ++b) red[(F.wave * 8 + b) * 64 + F.lane] = acc[b];
        __syncthreads();
        { const int b = F.tid >> 6; float s = F.in[I_BADA][(size_t)l * 6 * D + n0 + F.lane];
#pragma unroll
          for (int w = 0; w < 8; ++w) s += red[(w * 8 + b) * 64 + F.lane];
          mod[((size_t)l * NB + b) * 6 * D + n0 + F.lane] = s; }
        __syncthreads();
    }
}

struct Row { f32x4 v[4]; };
__device__ __forceinline__ Row row_load(const float* p, int lane) { Row r; const f32x4* q = (const f32x4*)p + lane;
#pragma unroll
    for (int j = 0; j < 4; ++j) r.v[j] = q[64 * j]; return r; }
__device__ __forceinline__ void row_store(float* p, int lane, const Row& r) { f32x4* q = (f32x4*)p + lane;
#pragma unroll
    for (int j = 0; j < 4; ++j) q[64 * j] = r.v[j]; }
__device__ __forceinline__ float row_sumsq(const Row& r) { float s = 0.f;
#pragma unroll
    for (int j = 0; j < 4; ++j) s += (r.v[j][0] * r.v[j][0] + r.v[j][1] * r.v[j][1]) + (r.v[j][2] * r.v[j][2] + r.v[j][3] * r.v[j][3]); return wave_sum(s); }
__device__ __forceinline__ Row row_modnorm(const Row& x, const float* g, const float* sc, const float* sh, int lane) {
    const float rs = rsqrtf(row_sumsq(x) * (1.0f / D) + RMS_EPS); Row gg = row_load(g, lane), s1 = row_load(sc, lane), s0 = row_load(sh, lane), h;
#pragma unroll
    for (int j = 0; j < 4; ++j) h.v[j] = x.v[j] * rs * gg.v[j] * (1.0f + s1.v[j]) + s0.v[j]; return h; }
__device__ __forceinline__ void row_store_bf16(bf16* p, int lane, const Row& r) { v2u* q = (v2u*)p + lane;
#pragma unroll
    for (int j = 0; j < 4; ++j) { v2u w; w.x = pk2(r.v[j][0], r.v[j][1]); w.y = pk2(r.v[j][2], r.v[j][3]); q[64 * j] = w; } }

__device__ __forceinline__ void phase_rowA(Frame& F, int gw, int NGW) {
    bf16* H = (bf16*)(F.ws + WS_H);
    for (int m = gw; m < M; m += NGW) { const int b = m / SEQ; Row x = row_load(F.in[I_X] + (size_t)m * D, F.lane);
        Row h = row_modnorm(x, F.in[I_NMPRE], mod_ptr(F, 0, b, 1), mod_ptr(F, 0, b, 0), F.lane); row_store_bf16(H + (size_t)m * D, F.lane, h); }
}

__device__ __forceinline__ void phase_conv(Frame& F, int l) {
    const bf16* Z = (const bf16*)(F.ws + WS_Z); bf16* UC = (bf16*)(F.ws + WS_UC);
    LAS float* tile = (LAS float*)F.lds;
    const int c = F.tid;
    float w[CKW];
#pragma unroll
    for (int j = 0; j < CKW; ++j) w[j] = F.in[I_CONVW][((size_t)l * CKW + j) * CW + c];
    const float bias = F.in[I_CONVB][l * CW + c];
    for (int ti = F.bid; ti < M / 32; ti += F.G) {
        const int t0 = ti * 32, s0 = t0 % SEQ;
        float u[62];
#pragma unroll
        for (int i = 0; i < 62; ++i) { float val = 0.f; if (s0 - 30 + i >= 0) { const bf16* zr = Z + (size_t)(t0 - 30 + i) * DIN; val = bf2f(zr[c]) * sigmoidf_(bf2f(zr[CW + c])); } u[i] = val; }
#pragma unroll
        for (int o = 0; o < 32; ++o) { float a = bias;
#pragma unroll
            for (int j = 0; j < CKW; ++j) a += u[o + j] * w[j];
            tile[o * CW + c] = a; }
        __syncthreads();
#pragma unroll
        for (int q = 0; q < 4; ++q) { const int o = 4 * F.wave + q; float v[8]; float s = 0.f;
#pragma unroll
            for (int i = 0; i < 8; ++i) { v[i] = tile[o * CW + F.lane + 64 * i]; s += v[i]; }
            const float mean = wave_sum(s) * (1.0f / CW); float s2 = 0.f;
#pragma unroll
            for (int i = 0; i < 8; ++i) { v[i] -= mean; s2 += v[i] * v[i]; }
            const float rstd = rsqrtf(wave_sum(s2) * (1.0f / CW) + LN_EPS);
#pragma unroll
            for (int i = 0; i < 8; ++i) { const int cc = F.lane + 64 * i; const float y = v[i] * rstd * F.in[I_CLNG][l * CW + cc] + F.in[I_CLNB][l * CW + cc];
                UC[(size_t)(t0 + o) * CW + cc] = (bf16)f2bf(siluf_(y)); } }
        __syncthreads();
    }
}
__device__ __forceinline__ void phase_prep1(Frame& F, int l, int gw, int NGW) {
    const bf16* Z = (const bf16*)(F.ws + WS_Z); bf16* LIN = (bf16*)(F.ws + WS_LIN);
    const f32x4 mu = *((const f32x4*)(F.in[I_MU] + (size_t)l * COLR + 1536) + F.lane);
    for (int m = gw; m < M; m += NGW) {
        const int s = m % SEQ; const v2u cur = *((const v2u*)(Z + (size_t)m * DIN + ZR0 + 1536) + F.lane);
        v2u prv; prv.x = 0u; prv.y = 0u; if (s > 0) prv = *((const v2u*)(Z + (size_t)(m - 1) * DIN + ZR0 + 1536) + F.lane);
        float x[4] = {bflo(cur.x), bfhi(cur.x), bflo(cur.y), bfhi(cur.y)}; const float p[4] = {bflo(prv.x), bfhi(prv.x), bflo(prv.y), bfhi(prv.y)};
#pragma unroll
        for (int i = 0; i < 4; ++i) { x[i] = x[i] + (p[i] - x[i]) * mu[i]; if (F.lane < 16) x[i] = tanhf(x[i]); else if (F.lane >= 32) x[i] = sigmoidf_(x[i]); }
        v2u o; o.x = pk2(x[0], x[1]); o.y = pk2(x[2], x[3]); *((v2u*)(LIN + (size_t)m * KLORA) + F.lane) = o;
    }
}
__device__ __forceinline__ void ld8bf(const bf16* p, float (&o)[8]) { const v4u w = *(const v4u*)p; o[0] = bflo(w.x); o[1] = bfhi(w.x); o[2] = bflo(w.y); o[3] = bfhi(w.y); o[4] = bflo(w.z); o[5] = bfhi(w.z); o[6] = bflo(w.w); o[7] = bfhi(w.w); }
__device__ __forceinline__ void st8bf(bf16* p, const float (&o)[8]) { v4u w; w.x = pk2(o[0], o[1]); w.y = pk2(o[2], o[3]); w.z = pk2(o[4], o[5]); w.w = pk2(o[6], o[7]); *(v4u*)p = w; }
__device__ __forceinline__ void ld8f(const float* p, float (&o)[8]) { const f32x4 a = *(const f32x4*)p, b = *((const f32x4*)p + 1); o[0] = a[0]; o[1] = a[1]; o[2] = a[2]; o[3] = a[3]; o[4] = b[0]; o[5] = b[1]; o[6] = b[2]; o[7] = b[3]; }
__device__ __forceinline__ float grp8_sum(float v) { v += __shfl_xor(v, 1); v += __shfl_xor(v, 2); v += __shfl_xor(v, 4); return v; }
__device__ __forceinline__ void phase_prep2(Frame& F, int l, int gw, int NGW) {
    const bf16* Z = (const bf16*)(F.ws + WS_Z); const bf16* LOUT = (const bf16*)(F.ws + WS_LOUT);
    bf16* SR = (bf16*)(F.ws + WS_SR); bf16* SKP = (bf16*)(F.ws + WS_SKP); bf16* SV = (bf16*)(F.ws + WS_SV); bf16* SKKN = (bf16*)(F.ws + WS_SKKN); bf16* SKA = (bf16*)(F.ws + WS_SKA);
    float* SDEC = (float*)(F.ws + WS_SDEC); float* BONUS = (float*)(F.ws + WS_BONUS);
    const int c = 8 * F.lane;
    float mur[8], muk[8], muv[8], w0[8], a0[8], kkw[8], kaw[8], rkw[8];
    ld8f(F.in[I_MU] + (size_t)l * COLR + c, mur); ld8f(F.in[I_MU] + (size_t)l * COLR + 512 + c, muk); ld8f(F.in[I_MU] + (size_t)l * COLR + 1024 + c, muv);
    ld8f(F.in[I_W0] + l * RW + c, w0); ld8f(F.in[I_A0] + l * RW + c, a0); ld8f(F.in[I_KK] + l * RW + c, kkw); ld8f(F.in[I_KA] + l * RW + c, kaw); ld8f(F.in[I_RK] + l * RW + c, rkw);
    for (int m = gw; m < M; m += NGW) {
        const int s = m % SEQ; const bf16* zr = Z + (size_t)m * DIN + ZR0 + c;
        float r[8], k[8], v[8], pr[8], pk[8], pv[8], lw[8], la[8];
        ld8bf(zr, r); ld8bf(zr + 512, k); ld8bf(zr + 1024, v);
        if (s > 0) { ld8bf(zr - DIN, pr); ld8bf(zr - DIN + 512, pk); ld8bf(zr - DIN + 1024, pv); }
        else {
#pragma unroll
            for (int i = 0; i < 8; ++i) { pr[i] = 0.f; pk[i] = 0.f; pv[i] = 0.f; } }
        ld8bf(LOUT + (size_t)m * NLORA + c, lw); ld8bf(LOUT + (size_t)m * NLORA + 512 + c, la);
        float dec[8], kp[8], kk[8], ka[8]; float ss = 0.f, bo = 0.f;
#pragma unroll
        for (int i = 0; i < 8; ++i) {
            r[i] += (pr[i] - r[i]) * mur[i]; k[i] += (pk[i] - k[i]) * muk[i]; v[i] += (pv[i] - v[i]) * muv[i];
            dec[i] = __expf(-0.60653066f * sigmoidf_(w0[i] + lw[i]));
            const float a = sigmoidf_(a0[i] + la[i]);
            kk[i] = k[i] * kkw[i]; kp[i] = k[i] * (1.0f + (a - 1.0f) * kaw[i]); ka[i] = a;
            ss += kk[i] * kk[i]; bo += r[i] * kp[i] * rkw[i];
        }
        ss = grp8_sum(ss); bo = grp8_sum(bo);
        const float inv = rsqrtf(fmaxf(ss, 1e-24f));
#pragma unroll
        for (int i = 0; i < 8; ++i) { kk[i] *= inv; ka[i] *= kk[i]; }
        const size_t o = (size_t)m * RW + c;
        st8bf(SR + o, r); st8bf(SKP + o, kp); st8bf(SV + o, v); st8bf(SKKN + o, kk); st8bf(SKA + o, ka);
        *(f32x4*)(SDEC + o) = (f32x4){dec[0], dec[1], dec[2], dec[3]}; *((f32x4*)(SDEC + o) + 1) = (f32x4){dec[4], dec[5], dec[6], dec[7]};
        if ((F.lane & 7) == 0) BONUS[(size_t)m * NH + (F.lane >> 3)] = bo;
    }
}
__device__ __forceinline__ void phase_scan(Frame& F) {
    const bf16* SR = (const bf16*)(F.ws + WS_SR); const bf16* SKP = (const bf16*)(F.ws + WS_SKP); const bf16* SV = (const bf16*)(F.ws + WS_SV);
    const bf16* SKKN = (const bf16*)(F.ws + WS_SKKN); const bf16* SKA = (const bf16*)(F.ws + WS_SKA); const float* SDEC = (const float*)(F.ws + WS_SDEC);
    float* YS = (float*)(F.ws + WS_YS);
    LAS float* buf = (LAS float*)F.lds;
    const int vr = F.lane >> 3, ke = F.lane & 7, vidx = 8 * F.wave + vr;
    for (int bh = F.bid; bh < NB * NH; bh += F.G) {
        const int b = bh / NH, h = bh % NH; const size_t m0 = (size_t)b * SEQ;
        float S[8];
#pragma unroll
        for (int i = 0; i < 8; ++i) S[i] = 0.f;
        for (int c0 = 0; c0 < SEQ; c0 += 64) {
            __syncthreads();
            for (int idx = F.tid; idx < 64 * 64; idx += NTHREADS) { const int t = idx >> 6, k = idx & 63; const size_t g = (m0 + c0 + t) * RW + h * RH + k; LAS float* d = buf + t * 384 + k;
                d[0] = bf2f(SR[g]); d[64] = SDEC[g]; d[128] = bf2f(SKP[g]); d[192] = bf2f(SKKN[g]); d[256] = bf2f(SKA[g]); d[320] = bf2f(SV[g]); }
            __syncthreads();
            for (int t = 0; t < 64; ++t) {
                const LAS float* d = buf + t * 384 + ke * 8;
                float r[8], dc[8], kp[8], kn[8], ka[8];
#pragma unroll
                for (int i = 0; i < 8; ++i) { r[i] = d[i]; dc[i] = d[64 + i]; kp[i] = d[128 + i]; kn[i] = d[192 + i]; ka[i] = d[256 + i]; }
                const float v = buf[t * 384 + 320 + vidx];
                float sa = 0.f;
#pragma unroll
                for (int i = 0; i < 8; ++i) sa += S[i] * kn[i];
                sa = -grp8_sum(sa);
                float y = 0.f;
#pragma unroll
                for (int i = 0; i < 8; ++i) { S[i] = S[i] * dc[i] + sa * ka[i] + v * kp[i]; y += S[i] * r[i]; }
                y = grp8_sum(y);
                if (ke == 0) YS[(m0 + c0 + t) * RW + h * RH + vidx] = y;
            }
        }
    }
}
__device__ __forceinline__ void phase_post(Frame& F, int l, int gw, int NGW) {
    const float* YS = (const float*)(F.ws + WS_YS); const bf16* SV = (const bf16*)(F.ws + WS_SV); const bf16* LOUT = (const bf16*)(F.ws + WS_LOUT); const float* BONUS = (const float*)(F.ws + WS_BONUS);
    bf16* YG = (bf16*)(F.ws + WS_YG);
    const int c = 8 * F.lane; float gg[8], gb[8]; ld8f(F.in[I_GNG] + l * RW + c, gg); ld8f(F.in[I_GNB] + l * RW + c, gb);
    for (int m = gw; m < M; m += NGW) {
        float y[8], v[8], g[8]; ld8f(YS + (size_t)m * RW + c, y); ld8bf(SV + (size_t)m * RW + c, v); ld8bf(LOUT + (size_t)m * NLORA + 1024 + c, g);
        float s = 0.f;
#pragma unroll
        for (int i = 0; i < 8; ++i) s += y[i];
        const float mean = grp8_sum(s) * (1.0f / RH); float s2 = 0.f;
#pragma unroll
        for (int i = 0; i < 8; ++i) { y[i] -= mean; s2 += y[i] * y[i]; }
        const float rstd = rsqrtf(grp8_sum(s2) * (1.0f / RH) + GN_EPS); const float bo = BONUS[(size_t)m * NH + (F.lane >> 3)];
        float o[8];
#pragma unroll
        for (int i = 0; i < 8; ++i) o[i] = (y[i] * rstd * gg[i] + gb[i] + bo * v[i]) * g[i];
        st8bf(YG + (size_t)m * RW + c, o);
    }
}

__device__ __forceinline__ unsigned* cnt_word(const Frame& F, int l, int e) { return (unsigned*)(F.ws + WS_CTL) + CW_CNT + (l * NE + e) * 64; }
__device__ __forceinline__ void phase_rowB(Frame& F, int l, int gw, int NGW) {
    const float* Y = (const float*)(F.ws + WS_Y); bf16* H = (bf16*)(F.ws + WS_H);
    int* LIST = (int*)(F.ws + WS_LIST); float* GW = (float*)(F.ws + WS_GW); int* TOKA = (int*)(F.ws + WS_TOKA);
    const float* xsrc = (l == 0) ? F.in[I_X] : F.out;
    LAS float* hrow = (LAS float*)(F.lds + F.wave * 4096);
    const float* wr = F.in[I_WROUTER] + (size_t)l * D * NE; const float br = F.in[I_BROUTER][l * NE + F.lane];
    for (int m = gw; m < M; m += NGW) {
        const int b = m / SEQ;
        Row y = row_load(Y + (size_t)m * D, F.lane), x = row_load(xsrc + (size_t)m * D, F.lane), gp = row_load(F.in[I_NMPOST] + l * D, F.lane), gt = row_load(mod_ptr(F, l, b, 2), F.lane);
        const float rs = rsqrtf(row_sumsq(y) * (1.0f / D) + RMS_EPS);
#pragma unroll
        for (int j = 0; j < 4; ++j) x.v[j] = x.v[j] + gt.v[j] * (y.v[j] * rs * gp.v[j]);
        row_store(F.out + (size_t)m * D, F.lane, x);
        Row h = row_modnorm(x, F.in[I_NFPRE] + l * D, mod_ptr(F, l, b, 4), mod_ptr(F, l, b, 3), F.lane);
        row_store_bf16(H + (size_t)m * D, F.lane, h);
#pragma unroll
        for (int j = 0; j < 4; ++j) *((LAS f32x4*)hrow + F.lane + 64 * j) = h.v[j];
        LDS_WAIT(); __builtin_amdgcn_wave_barrier();
        float lg = 0.f;
#pragma unroll 4
        for (int k4 = 0; k4 < D / 4; ++k4) { const f32x4 hv = *((const LAS f32x4*)hrow + k4); const float* wp = wr + (size_t)k4 * 4 * NE + F.lane;
            lg += hv[0] * wp[0]; lg += hv[1] * wp[NE]; lg += hv[2] * wp[2 * NE]; lg += hv[3] * wp[3 * NE]; }
        __builtin_amdgcn_wave_barrier();
        const float score = sigmoidf_(lg), biased = score + br;
        int rk = 0;
#pragma unroll
        for (int d = 1; d < 8; ++d) { const float o = __shfl_xor(biased, d); rk += (o > biased || (o == biased && (F.lane ^ d) < F.lane)) ? 1 : 0; }
        const float gs = grp8_sum(rk < 2 ? biased : 0.f);
        const int g = F.lane >> 3; int grk = 0;
#pragma unroll
        for (int d = 1; d < 8; ++d) { const float o = __shfl_xor(gs, d * 8); grk += (o > gs || (o == gs && (g ^ d) < g)) ? 1 : 0; }
        const float masked = (grk < 4) ? biased : -__builtin_inff();
        int rank = 0;
#pragma unroll
        for (int d = 1; d < 64; ++d) { const float o = __shfl_xor(masked, d); rank += (o > masked || (o == masked && (F.lane ^ d) < F.lane)) ? 1 : 0; }
        const bool chosen = rank < TOPK;
        const float ssum = wave_sum(chosen ? score : 0.f);
        if (chosen) { const int e = F.lane; const unsigned pos = __hip_atomic_fetch_add(cnt_word(F, l, e), 1u, RLX_AGENT);
            LIST[(size_t)e * M + pos] = m; GW[(size_t)e * M + pos] = score / ssum * ROUTED_SCALE; TOKA[(size_t)m * TOPK + rank] = e * 65536 + (int)pos; }
        if (F.lane == 0) { LIST[(size_t)NE * M + m] = m; GW[(size_t)NE * M + m] = 1.0f; }
    }
}

struct MoeTab { LAS int* cnt; LAS int* start; LAS int* tstart; LAS int* ntiles; LAS int* tiles; };
__device__ __forceinline__ MoeTab moe_tab(const Frame& F) { MoeTab T; LAS int* p = (LAS int*)(F.lds + LDS_TAB_OFF); T.cnt = p; T.start = p + 80; T.tstart = p + 160; T.ntiles = p + 240; T.tiles = p + 256; return T; }
__device__ __forceinline__ void moe_build(Frame& F, int l, bool with_tiles) {
    MoeTab T = moe_tab(F);
    __syncthreads();
    if (F.tid <= NE) T.cnt[F.tid] = (F.tid < NE) ? (int)__hip_atomic_load(cnt_word(F, l, F.tid), RLX_AGENT) : M;
    __syncthreads();
    if (F.tid <= NE) { int s = 0, ts = 0; for (int e = 0; e < F.tid; ++e) { const int c = T.cnt[e]; s += c; ts += (c + 255) >> 8; } T.start[F.tid] = s; T.tstart[F.tid] = ts;
        if (F.tid == NE) T.ntiles[0] = ts + ((M + 255) >> 8);
        if (with_tiles) { const int c = T.cnt[F.tid]; const int nt = (c + 255) >> 8;
            for (int rt = 0; rt < nt; ++rt) { LAS int* q = T.tiles + (ts + rt) * 4; q[0] = F.tid; q[1] = rt * 256; q[2] = s + rt * 256; q[3] = (c - rt * 256) < 256 ? (c - rt * 256) : 256; } } }
    __syncthreads();
}
struct MoeOrder {
    LAS const int* tiles; int ntiles, npn, nwg, G, c, bstride;
    __device__ bool next(int i, pg8::Unit& u) const {
        const long L = (long)i * G + c; if (L >= nwg) return false;
        int wgid = (int)L; { const int q = nwg / 8, r = nwg % 8, xcd = wgid % 8, off = wgid / 8; wgid = (xcd < r ? xcd * (q + 1) : r * (q + 1) + (xcd - r) * q) + off; }
        const int tile = wgid / npn, pn = wgid % npn; LAS const int* q = tiles + tile * 4;
        u.e = q[0]; u.x0 = u.e * M + q[1]; u.o0 = q[2]; u.nrows = q[3]; u.b0 = u.e * bstride + pn * 256; u.oc0 = pn * 256; u.a0 = q[2]; return true;
    }
};
__device__ __forceinline__ Row row_load_bf16(const bf16* p, int lane) { Row r; const v2u* q = (const v2u*)p + lane;
#pragma unroll
    for (int j = 0; j < 4; ++j) { const v2u w = q[64 * j]; r.v[j] = (f32x4){bflo(w.x), bfhi(w.x), bflo(w.y), bfhi(w.y)}; } return r; }
__device__ __forceinline__ void phase_rowC(Frame& F, int l, int gw, int NGW) {
    const bf16* YEXP = (const bf16*)(F.ws + WS_YEXP); const bf16* YSH = (const bf16*)(F.ws + WS_YSH); const int* TOKA = (const int*)(F.ws + WS_TOKA); bf16* H = (bf16*)(F.ws + WS_H);
    MoeTab T = moe_tab(F);
    for (int m = gw; m < M; m += NGW) {
        const int b = m / SEQ;
        Row y = row_load_bf16(YSH + (size_t)m * D, F.lane);
#pragma unroll
        for (int j8 = 0; j8 < TOPK; ++j8) { const int ep = TOKA[(size_t)m * TOPK + j8]; const int slot = T.start[ep >> 16] + (ep & 65535); const Row t = row_load_bf16(YEXP + (size_t)slot * D, F.lane);
#pragma unroll
            for (int j = 0; j < 4; ++j) y.v[j] += t.v[j]; }
        Row x = row_load(F.out + (size_t)m * D, F.lane), gp = row_load(F.in[I_NFPOST] + l * D, F.lane), gt = row_load(mod_ptr(F, l, b, 5), F.lane);
        const float rs = rsqrtf(row_sumsq(y) * (1.0f / D) + RMS_EPS);
#pragma unroll
        for (int j = 0; j < 4; ++j) x.v[j] = x.v[j] + gt.v[j] * (y.v[j] * rs * gp.v[j]);
        row_store(F.out + (size_t)m * D, F.lane, x);
        if (l + 1 < DEPTH) { Row h = row_modnorm(x, F.in[I_NMPRE] + (l + 1) * D, mod_ptr(F, l + 1, b, 1), mod_ptr(F, l + 1, b, 0), F.lane); row_store_bf16(H + (size_t)m * D, F.lane, h); }
    }
}

__device__ __forceinline__ void phase_begin(Frame& F) { asm volatile("" : "+s"(F.in), "+s"(F.ws), "+s"(F.out), "+s"(F.bid), "+s"(F.G)); asm volatile("" : "+v"(F.tid)); F.lane = F.tid & 63; F.wave = __builtin_amdgcn_readfirstlane(F.tid >> 6); }
constexpr int PH_PER_LAYER = 12, NPH = 2 + DEPTH * PH_PER_LAYER;
__device__ __forceinline__ void bar_launder(XcdBarrier& bar) { asm volatile("" : "+s"(bar.bar)); }
#define IN(k) (phase_begin(F), bar_launder(bar), (lo <= (k) && (k) < hi))
#define SEAM(k) do { if (!MK_PER_PHASE && (k) + 1 < hi) xcd_barrier(bar); } while (0)
template <int L> __device__ __forceinline__ void layer_phases(Frame& F, XcdBarrier& bar, const int lo, const int hi) {
    constexpr int l = L, p0 = 2 + L * PH_PER_LAYER;
#define GW_ const int gw = F.bid * NWAVES + F.wave, NGW = F.G * NWAVES
#define WM_ unsigned char* wm = F.ws + WS_WMIX + (size_t)l * WMIX_STRIDE
    if (IN(p0 + 0)) { WM_; pg8::Gemm g{(const bf16*)(F.ws + WS_H), (const bf16*)(wm + WM_WIN), D, nullptr}; pg8::StaticOrder S; S.init(M, DIN, F.G, F.bid);
        pg8::EpiBf16 E{(bf16*)(F.ws + WS_Z), DIN, nullptr}; pg8::gemm_phase<pg8::EpiBf16, pg8::StaticOrder, false>(F.lds, F.tid, g, S, E); SEAM(p0 + 0); }
    if (IN(p0 + 1)) { GW_; phase_conv(F, l); phase_prep1(F, l, gw, NGW); SEAM(p0 + 1); }
    if (IN(p0 + 2)) { WM_; pg8::Gemm g{(const bf16*)(F.ws + WS_LIN), (const bf16*)(wm + WM_LORA), KLORA, nullptr}; pg8::StaticOrder S; S.init(M, NLORA, F.G, F.bid);
        pg8::EpiBf16 E{(bf16*)(F.ws + WS_LOUT), NLORA, nullptr}; pg8::gemm_phase<pg8::EpiBf16, pg8::StaticOrder, false>(F.lds, F.tid, g, S, E); SEAM(p0 + 2); }
    if (IN(p0 + 3)) { GW_; phase_prep2(F, l, gw, NGW); SEAM(p0 + 3); }
    if (IN(p0 + 4)) { GW_; phase_expert_weights(F, l, gw, NGW); phase_scan(F); SEAM(p0 + 4); }
    if (IN(p0 + 5)) { GW_; phase_post(F, l, gw, NGW); SEAM(p0 + 5); }
    if (IN(p0 + 6)) { WM_; pg8::StaticOrder S; S.init(M, D, F.G, F.bid);
        { pg8::Gemm g{(const bf16*)(F.ws + WS_UC), (const bf16*)(wm + WM_PCONV), CW, nullptr}; pg8::EpiMerge<true> E{(bf16*)(F.ws + WS_MERGED), (const bf16*)(F.ws + WS_Z), ZG0};
          pg8::gemm_phase<pg8::EpiMerge<true>, pg8::StaticOrder, false>(F.lds, F.tid, g, S, E); }
        { pg8::Gemm g{(const bf16*)(F.ws + WS_YG), (const bf16*)(wm + WM_PRWKV), RW, nullptr}; pg8::EpiMerge<false> E{(bf16*)(F.ws + WS_MERGED), (const bf16*)(F.ws + WS_Z), ZG0 + D};
          pg8::gemm_phase<pg8::EpiMerge<false>, pg8::StaticOrder, false>(F.lds, F.tid, g, S, E); }
        SEAM(p0 + 6); }
    if (IN(p0 + 7)) { WM_; pg8::Gemm g{(const bf16*)(F.ws + WS_MERGED), (const bf16*)(wm + WM_WO), D, nullptr}; pg8::StaticOrder S; S.init(M, D, F.G, F.bid);
        pg8::EpiF32 E{(float*)(F.ws + WS_Y), D}; pg8::gemm_phase<pg8::EpiF32, pg8::StaticOrder, false>(F.lds, F.tid, g, S, E); SEAM(p0 + 7); }
    if (IN(p0 + 8)) { GW_; phase_rowB(F, l, gw, NGW); SEAM(p0 + 8); }
    if (IN(p0 + 9)) { moe_build(F, l, true); MoeTab T = moe_tab(F);
        MoeOrder S{T.tiles, T.ntiles[0], 2, T.ntiles[0] * 2, F.G, F.bid, 512};
        pg8::Gemm g{(const bf16*)(F.ws + WS_H), (const bf16*)(F.ws + WS_WGU), D, (const int*)(F.ws + WS_LIST)};
        pg8::EpiSwiGLU E{(bf16*)(F.ws + WS_ACT)}; pg8::gemm_phase<pg8::EpiSwiGLU, MoeOrder, true>(F.lds, F.tid, g, S, E); SEAM(p0 + 9); }
    if (IN(p0 + 10)) { moe_build(F, l, true); MoeTab T = moe_tab(F);
        MoeOrder S{T.tiles, T.ntiles[0], 4, T.ntiles[0] * 4, F.G, F.bid, 1024};
        pg8::Gemm g{(const bf16*)(F.ws + WS_ACT), (const bf16*)(F.ws + WS_WDN), DE, nullptr};
        pg8::EpiBf16 E{(bf16*)(F.ws + WS_YEXP), D, (const float*)(F.ws + WS_GW)}; pg8::gemm_phase<pg8::EpiBf16, MoeOrder, false>(F.lds, F.tid, g, S, E); SEAM(p0 + 10); }
    if (IN(p0 + 11)) { GW_; moe_build(F, l, false); phase_rowC(F, l, gw, NGW); SEAM(p0 + 11); }
}
__global__ void __launch_bounds__(NTHREADS, 2) mk_fwd(Args args) {
    extern __shared__ __attribute__((aligned(16))) unsigned char lds_raw[];
    Frame F; F.lds = (LAS unsigned char*)lds_raw; F.tid = threadIdx.x; F.lane = F.tid & 63; F.wave = __builtin_amdgcn_readfirstlane(F.tid >> 6);
    F.G = gridDim.x; F.bid = blockIdx.x; F.in = (const float* const __attribute__((address_space(4)))*)__builtin_amdgcn_kernarg_segment_ptr(); F.out = args.out; F.ws = args.ws;
    volatile LAS unsigned* MISC = (volatile LAS unsigned*)(F.lds + MISC_OFF);
    if (F.tid < 64) MISC[F.tid] = 0u;
    __syncthreads();
    XcdBarrier bar; bar.bar = (unsigned*)(F.ws + WS_CTL) + CW_BAR; bar.x = 0; bar.st = nullptr;
    if (!MK_PER_PHASE) bar = xcd_barrier_post((unsigned*)(F.ws + WS_CTL) + CW_BAR, MISC + 8);
    const int lo = args.ph_lo, hi = (args.ph_hi < MK_LAST_PHASE + 1) ? args.ph_hi : MK_LAST_PHASE + 1;
    if (IN(0)) { GW_; phase_ada(F); phase_mix_weights(F, gw, NGW); SEAM(0); }
    if (IN(1)) { GW_; phase_rowA(F, gw, NGW); SEAM(1); }
    layer_phases<0>(F, bar, lo, hi);
    layer_phases<1>(F, bar, lo, hi);
    if (MK_LAST_PHASE < 2 + 8 && args.ph_hi == NPH) { phase_begin(F); for (size_t i = (size_t)F.bid * NTHREADS + F.tid; i < (size_t)M * D / 4; i += (size_t)F.G * NTHREADS) ((f32x4*)F.out)[i] = ((const f32x4*)F.in[I_X])[i]; }
}
#undef IN
#undef SEAM
#undef GW_
#undef WM_

extern "C" void kernel_launch(void* const* d_in, const int* in_sizes, int n_in, void* d_out, int out_size, void* d_ws, size_t ws_size, hipStream_t stream) {
    static int grid = 0;
    if (grid == 0) {
        if (n_in != N_IN || out_size != M * D) { fprintf(stderr, "kernel_launch: unexpected shapes (n_in %d out %d ws %zu need %zu)\n", n_in, out_size, ws_size, (size_t)WS_END); grid = -1; return; }
        if (ws_size < WS_END) { fprintf(stderr, "kernel_launch: ws too small %zu < %zu\n", ws_size, (size_t)WS_END); grid = -2; }
        int dev = 0, cus = 0;
        if (hipGetDevice(&dev) != hipSuccess || hipDeviceGetAttribute(&cus, hipDeviceAttributeMultiprocessorCount, dev) != hipSuccess) { grid = -1; return; }
        if (hipFuncSetAttribute((const void*)mk_fwd, hipFuncAttributeMaxDynamicSharedMemorySize, LDS_BYTES) != hipSuccess) { fprintf(stderr, "kernel_launch: hipFuncSetAttribute failed\n"); grid = -1; return; }
        (void)hipGetLastError();
        grid = cus;
    }
    if (grid == -2) { (void)hipMemsetAsync(d_out, 0, (size_t)out_size * 4, stream); return; }
    if (grid < 0) return;
    (void)hipMemsetAsync((char*)d_ws + WS_CTL, 0, CTL_ZERO_BYTES, stream);
    Args a{};
    for (int i = 0; i < N_IN; ++i) a.in[i] = (const float*)d_in[i];
    a.out = (float*)d_out; a.ws = (unsigned char*)d_ws;
#if MK_PER_PHASE
    for (int p = 0; p < NPH && p <= MK_LAST_PHASE; ++p) { a.ph_lo = p; a.ph_hi = p + 1; hipLaunchKernelGGL(mk_fwd, dim3(grid), dim3(NTHREADS), LDS_BYTES, stream, a); }
#else
    a.ph_lo = 0; a.ph_hi = NPH;
    hipLaunchKernelGGL(mk_fwd, dim3(grid), dim3(NTHREADS), LDS_BYTES, stream, a);
#endif
}
```

```cpp
#include <hip/hip_runtime.h>
#include <cstdio>
#include <cstdint>

#ifndef MK_PER_PHASE
#define MK_PER_PHASE 0
#endif
#ifndef MK_LAST_PHASE
#define MK_LAST_PHASE 9999
#endif

#define GAS __attribute__((address_space(1)))
#define LAS __attribute__((address_space(3)))
typedef unsigned short bf16;
typedef unsigned v4u __attribute__((ext_vector_type(4)));
typedef unsigned v2u __attribute__((ext_vector_type(2)));
typedef float f32x4 __attribute__((ext_vector_type(4)));
typedef float f32x2 __attribute__((ext_vector_type(2)));
typedef short bf16x8 __attribute__((ext_vector_type(8)));
typedef GAS unsigned gu32;
#define RLX_AGENT __ATOMIC_RELAXED, __HIP_MEMORY_SCOPE_AGENT
#define LDS_WAIT() asm volatile("s_waitcnt lgkmcnt(0)" ::: "memory")
#define VM_WAIT() asm volatile("s_waitcnt vmcnt(0)" ::: "memory")

constexpr int NB = 8, SEQ = 2048, D = 1024, M = NB * SEQ, DEPTH = 2;
constexpr int CW = 512, CKW = 31, RW = 512, RH = 64, NH = 8, LW = 64, LA = 64, LG = 128;
constexpr int NE = 64, TOPK = 8, DE = 256;
constexpr int DIN = 4864, ZR0 = 1024, ZG0 = 2816, COLR = 1792;
constexpr int NLORA = 1536, KLORA = 256;
constexpr float RMS_EPS = 1e-6f, LN_EPS = 1e-5f, GN_EPS = 64e-5f, ROUTED_SCALE = 2.5f;
constexpr int NWAVES = 8, NTHREADS = 512;

enum { I_X = 0, I_C, I_WADA, I_BADA, I_NMPRE, I_NMPOST, I_NFPRE, I_NFPOST, I_WIN, I_MU, I_CONVW, I_CONVB, I_CLNG, I_CLNB, I_PCONV,
       I_W0, I_W2, I_A0, I_A2, I_G2, I_KK, I_KA, I_RK, I_GNG, I_GNB, I_PRWKV, I_WO, I_WROUTER, I_BROUTER, I_WEG, I_WEU, I_WED, I_WSG, I_WSU, I_WSD, N_IN };

constexpr size_t MiB = 1u << 20;
constexpr size_t WS_CTL = 0, CTL_ZERO_BYTES = 1 * MiB;
constexpr size_t WS_MOD = 1 * MiB;
constexpr size_t WS_BONUS = 1 * MiB + 512 * 1024;
constexpr size_t WS_WMIX = 2 * MiB;
constexpr size_t WMIX_STRIDE = 15 * MiB;
constexpr size_t WM_WIN = 0, WM_PCONV = (size_t)DIN * D * 2, WM_PRWKV = WM_PCONV + (size_t)D * CW * 2, WM_WO = WM_PRWKV + (size_t)D * RW * 2, WM_LORA = WM_WO + (size_t)D * D * 2;
static_assert(WM_LORA + (size_t)NLORA * KLORA * 2 <= WMIX_STRIDE, "wmix");
constexpr size_t WS_WGU = 32 * MiB;
constexpr size_t WS_WDN = 97 * MiB;
constexpr size_t WS_H = 130 * MiB;
constexpr size_t WS_LIST = 162 * MiB;
constexpr size_t WS_GW = 167 * MiB;
constexpr size_t WS_TOKA = 172 * MiB;
constexpr size_t WS_S = 173 * MiB;
constexpr size_t WS_ZC = WS_S;
constexpr size_t WS_ZR = WS_S + 32 * MiB;
constexpr size_t WS_ZG = WS_S + 88 * MiB;
constexpr size_t WS_CQ = WS_S;
constexpr size_t WS_CG = WS_S + 16 * MiB;
constexpr size_t WS_CH = WS_S + 32 * MiB;
constexpr int ZCW = 1024, ZRW = 1792, ZGW = 2048;
constexpr size_t WS_LIN = WS_S + 152 * MiB;
constexpr size_t WS_LOUT = WS_S + 160 * MiB;
constexpr size_t WS_SR = WS_S + 208 * MiB;
constexpr size_t WS_SKP = WS_SR + 16 * MiB, WS_SV = WS_SR + 32 * MiB, WS_SKKN = WS_SR + 48 * MiB, WS_SKA = WS_SR + 64 * MiB;
constexpr size_t WS_SDEC = WS_SR + 80 * MiB;
constexpr size_t WS_YS = WS_SDEC + 32 * MiB;
constexpr size_t WS_UC = WS_S + 352 * MiB;
constexpr size_t WS_YG = WS_SR;
constexpr size_t WS_MERGED = WS_SKKN;
constexpr size_t WS_Y = WS_SDEC;
constexpr size_t WS_ACT = WS_S;
constexpr size_t WS_YEXP = WS_S + 74 * MiB;
constexpr size_t WS_YSH = WS_S + 330 * MiB;
static_assert(WS_YSH == WS_YEXP + (size_t)M * TOPK * D * 2, "YSH follows YEXP");
constexpr size_t WS_END = WS_S + 368 * MiB;
constexpr int CW_BAR = 4096;
constexpr int CW_CNT = 16384;
constexpr int RING_BYTES = 131072, LDS_TAB_OFF = RING_BYTES, LDS_TAB_BYTES = 12288, LDS_ROWTAB_OFF = LDS_TAB_OFF + LDS_TAB_BYTES, MISC_OFF = LDS_ROWTAB_OFF + 2048, LDS_BYTES = 147456;
static_assert(MISC_OFF + 256 <= LDS_BYTES, "lds");

__device__ __forceinline__ unsigned f2bf(float f) { unsigned u = __builtin_bit_cast(unsigned, f); return (u + 0x7fffu + ((u >> 16) & 1u)) >> 16; }
__device__ __forceinline__ unsigned pk2(float lo, float hi) { return f2bf(lo) | (f2bf(hi) << 16); }
__device__ __forceinline__ float bf2f(unsigned b) { return __builtin_bit_cast(float, b << 16); }
__device__ __forceinline__ float bflo(unsigned w) { return __builtin_bit_cast(float, w << 16); }
__device__ __forceinline__ float bfhi(unsigned w) { return __builtin_bit_cast(float, w & 0xffff0000u); }
__device__ __forceinline__ float sigmoidf_(float x) { return 1.0f / (1.0f + __expf(-x)); }
__device__ __forceinline__ float siluf_(float x) { return x / (1.0f + __expf(-x)); }
__device__ __forceinline__ float wave_sum(float v) {
#pragma unroll
    for (int o = 1; o < 64; o <<= 1) v += __shfl_xor(v, o);
    return v;
}

namespace pg8 {
constexpr int BM = 256, BK = 64, HALF = 128, HTB = HALF * BK * 2, STAGE_BYTES = 8 * HTB, NXCD = 8, WGM = 8;
__host__ __device__ __forceinline__ int lds_byte(int r, int c) { const int st = (r >> 4) * 2 + (c >> 5), rr = r & 15, cc = c & 31, ob = rr * 64 + cc * 2; return st * 1024 + (ob ^ (((ob >> 9) & 1) << 5)); }
__host__ __device__ __forceinline__ void stage_rc(int b, int& R, int& C) { const int st = b / 1024, sb = b % 1024, swz = sb ^ (((sb >> 9) & 1) << 5); R = (st >> 1) * 16 + swz / 64; C = (st & 1) * 32 + (swz % 64) / 2; }
__host__ __device__ __forceinline__ int perm32(int rho) { const int n = rho >> 4, i = rho & 15; return 8 * (i >> 2) + 4 * n + (i & 3); }

struct Unit { int a0, b0, o0, oc0, nrows, e, x0; };
struct Gemm { const bf16* A; const bf16* Bt; int K; const int* list; };

struct StaticOrder {
    int nM, nN, nwg, G, c;
    __device__ void init(int M_, int N_, int G_, int c_) { nM = M_ / BM; nN = N_ / BM; nwg = nM * nN; G = G_; c = c_; }
    __device__ bool next(int i, Unit& u) const {
        const long L = (long)i * G + c; if (L >= nwg) return false;
        int wgid = (int)L; { const int q = nwg / NXCD, r = nwg % NXCD, xcd = wgid % NXCD, off = wgid / NXCD; wgid = (xcd < r ? xcd * (q + 1) : r * (q + 1) + (xcd - r) * q) + off; }
        const int nig = WGM * nN, gid = wgid / nig, fm = gid * WGM, gsz = (nM - fm) < WGM ? (nM - fm) : WGM;
        const int pm = fm + ((wgid % nig) % gsz), pn = (wgid % nig) / gsz;
        u.a0 = pm * BM; u.b0 = pn * BM; u.o0 = pm * BM; u.oc0 = pn * BM; u.nrows = BM; u.e = 0; u.x0 = 0; return true;
    }
};

__device__ __forceinline__ unsigned cvt_pk_bf16(float lo, float hi) { unsigned r; asm volatile("v_cvt_pk_bf16_f32 %0, %1, %2" : "=v"(r) : "v"(lo), "v"(hi)); return r; }

struct EpiF32 {
    static constexpr bool PERM = false;
    float* C; int ldc;
    __device__ __forceinline__ void operator()(const f32x4 (&acc)[2][2][4][2], const Unit& u, int wr, int wc, int fr, int fq) const {
        const int row0 = wr * 64 + fr, col0 = u.oc0 + wc * 32 + 4 * fq;
#pragma unroll
        for (int ai = 0; ai < 2; ++ai)
#pragma unroll
            for (int m = 0; m < 4; ++m) { const int r = row0 + ai * HALF + m * 16; if (r < u.nrows) { float* rowp = C + (size_t)(u.o0 + r) * ldc + col0;
#pragma unroll
                for (int bj = 0; bj < 2; ++bj)
#pragma unroll
                    for (int n = 0; n < 2; ++n) *(f32x4*)(rowp + bj * HALF + n * 16) = acc[ai][bj][m][n]; } }
    }
};
struct EpiBf16 {
    static constexpr bool PERM = true;
    bf16* O; int ldc; const float* rowscale;
    __device__ __forceinline__ void operator()(const f32x4 (&acc)[2][2][4][2], const Unit& u, int wr, int wc, int fr, int fq) const {
        const int row0 = wr * 64 + fr, col0 = u.oc0 + wc * 32 + 8 * fq;
#pragma unroll
        for (int ai = 0; ai < 2; ++ai)
#pragma unroll
            for (int m = 0; m < 4; ++m) { const int r = row0 + ai * HALF + m * 16; if (r < u.nrows) { bf16* rowp = O + (size_t)(u.o0 + r) * ldc + col0;
                const float sc = rowscale ? rowscale[u.x0 + r] : 1.0f;
#pragma unroll
                for (int bj = 0; bj < 2; ++bj) { const f32x4 v0 = acc[ai][bj][m][0] * sc, v1 = acc[ai][bj][m][1] * sc;
                    v4u w; w.x = cvt_pk_bf16(v0[0], v0[1]); w.y = cvt_pk_bf16(v0[2], v0[3]); w.z = cvt_pk_bf16(v1[0], v1[1]); w.w = cvt_pk_bf16(v1[2], v1[3]);
                    *(v4u*)(rowp + bj * HALF) = w; } } }
    }
};
template <bool FIRST> struct EpiMerge {
    static constexpr bool PERM = true;
    bf16* O; const bf16* Z; int gcol0;
    __device__ __forceinline__ void operator()(const f32x4 (&acc)[2][2][4][2], const Unit& u, int wr, int wc, int fr, int fq) const {
        const int row0 = u.o0 + wr * 64 + fr, col0 = u.oc0 + wc * 32 + 8 * fq;
#pragma unroll
        for (int ai = 0; ai < 2; ++ai)
#pragma unroll
            for (int m = 0; m < 4; ++m) { const int r = row0 + ai * HALF + m * 16; bf16* rowp = O + (size_t)r * D + col0; const bf16* zp = Z + (size_t)r * 2048 + gcol0 + col0;
#pragma unroll
                for (int bj = 0; bj < 2; ++bj) { const v4u g = *(const v4u*)(zp + bj * HALF); const f32x4 a0 = acc[ai][bj][m][0], a1 = acc[ai][bj][m][1];
                    float o[8];
                    o[0] = a0[0] * sigmoidf_(bflo(g.x)); o[1] = a0[1] * sigmoidf_(bfhi(g.x)); o[2] = a0[2] * sigmoidf_(bflo(g.y)); o[3] = a0[3] * sigmoidf_(bfhi(g.y));
                    o[4] = a1[0] * sigmoidf_(bflo(g.z)); o[5] = a1[1] * sigmoidf_(bfhi(g.z)); o[6] = a1[2] * sigmoidf_(bflo(g.w)); o[7] = a1[3] * sigmoidf_(bfhi(g.w));
                    if (!FIRST) { const v4u p = *(const v4u*)(rowp + bj * HALF);
                        o[0] += bflo(p.x); o[1] += bfhi(p.x); o[2] += bflo(p.y); o[3] += bfhi(p.y); o[4] += bflo(p.z); o[5] += bfhi(p.z); o[6] += bflo(p.w); o[7] += bfhi(p.w); }
                    v4u w; w.x = cvt_pk_bf16(o[0], o[1]); w.y = cvt_pk_bf16(o[2], o[3]); w.z = cvt_pk_bf16(o[4], o[5]); w.w = cvt_pk_bf16(o[6], o[7]);
                    *(v4u*)(rowp + bj * HALF) = w; } }
    }
};
struct EpiSwiGLU {
    static constexpr bool PERM = true;
    bf16* O;
    __device__ __forceinline__ void operator()(const f32x4 (&acc)[2][2][4][2], const Unit& u, int wr, int wc, int fr, int fq) const {
        const int row0 = wr * 64 + fr, col0 = (u.oc0 >> 1) + wc * 32 + 8 * fq;
#pragma unroll
        for (int ai = 0; ai < 2; ++ai)
#pragma unroll
            for (int m = 0; m < 4; ++m) { const int r = row0 + ai * HALF + m * 16; if (r < u.nrows) { bf16* rowp = O + (size_t)(u.o0 + r) * DE + col0;
                const f32x4 g0 = acc[ai][0][m][0], g1 = acc[ai][0][m][1], u0 = acc[ai][1][m][0], u1 = acc[ai][1][m][1];
                v4u w; w.x = cvt_pk_bf16(siluf_(g0[0]) * u0[0], siluf_(g0[1]) * u0[1]); w.y = cvt_pk_bf16(siluf_(g0[2]) * u0[2], siluf_(g0[3]) * u0[3]);
                w.z = cvt_pk_bf16(siluf_(g1[0]) * u1[0], siluf_(g1[1]) * u1[1]); w.w = cvt_pk_bf16(siluf_(g1[2]) * u1[2], siluf_(g1[3]) * u1[3]);
                *(v4u*)rowp = w; } }
    }
};

constexpr int ROWTAB_OFF = 131072 + 12288;
template <class Epi, class Sched, bool GATHER>
__device__ __forceinline__ void gemm_phase(LAS unsigned char* lds, const int tid, const Gemm g, const Sched& S, const Epi& E) {
    const int wid = __builtin_amdgcn_readfirstlane(tid >> 6), lane = tid & 63, wr = wid >> 2, wc = wid & 3, fr = lane & 15, fq = lane >> 4;
    const int K = g.K, nt = K / BK;
    int sR, sC; stage_rc(tid * 16, sR, sC);
    const unsigned voffA = (unsigned)(sR * K + sC) * 2u;
    const unsigned voffB = (unsigned)((Epi::PERM ? ((sR & ~31) + perm32(sR & 31)) : sR) * K + sC) * 2u;
    const size_t kstep = (size_t)(BK * 2);
    const size_t pstep = (size_t)64 * K * 2;
    const size_t hstep = (size_t)HALF * K * 2;
    const unsigned ldsw = (unsigned)wid * 1024u;
    const int aoff = lds_byte(wr * 64 + fr, fq * 8), boff = lds_byte(wc * 32 + fr, fq * 8);
    LAS unsigned* rowtab = (LAS unsigned*)(lds + ROWTAB_OFF);
#define PG8_SA(b, h) (((b) * 2 + (h)) * HTB)
#define PG8_SB(b, h) ((4 + (b) * 2 + (h)) * HTB)
#define PG8_STAGE(bufoff, gbase, voff) do { _Pragma("unroll") for (int _i = 0; _i < 2; ++_i) \
        __builtin_amdgcn_global_load_lds((const unsigned*)((const char*)(gbase) + _i * pstep + (voff)), (LAS unsigned*)(lds + (bufoff) + ldsw + _i * 8192), 16, 0, 0); } while (0)
#define PG8_STAGE_G(bufoff, kb, sel, h) do { _Pragma("unroll") for (int _i = 0; _i < 2; ++_i) { const unsigned _ro = rowtab[(sel) * 256 + (h) * HALF + sR + 64 * _i]; \
        __builtin_amdgcn_global_load_lds((const unsigned*)((const char*)(kb) + _ro + (unsigned)(sC * 2)), (LAS unsigned*)(lds + (bufoff) + ldsw + _i * 8192), 16, 0, 0); } } while (0)
#define PG8_STAGE_A(bufoff, basep, kb, sel, h) do { if constexpr (GATHER) PG8_STAGE_G(bufoff, (const char*)g.A + (kb), sel, h); else PG8_STAGE(bufoff, (basep) + (kb) + (h) * hstep, voffA); } while (0)
#define PG8_ROWTAB(sel, u) do { if (tid < 256) { const int _rr = tid < (u).nrows ? tid : (u).nrows - 1; rowtab[(sel) * 256 + tid] = (unsigned)g.list[(u).x0 + _rr] * (unsigned)(K * 2); } } while (0)
#define PG8_LDA(dst, b, h) do { _Pragma("unroll") for (int m = 0; m < 4; ++m) _Pragma("unroll") for (int k = 0; k < 2; ++k) dst[m][k] = *(const LAS bf16x8*)(lds + PG8_SA(b, h) + aoff + m * 2048 + k * 1024); } while (0)
#define PG8_LDB(dst, b, h) do { _Pragma("unroll") for (int n = 0; n < 2; ++n) _Pragma("unroll") for (int k = 0; k < 2; ++k) dst[n][k] = *(const LAS bf16x8*)(lds + PG8_SB(b, h) + boff + n * 2048 + k * 1024); } while (0)
#define PG8_MMA(ai, bj, At, Bt) do { __builtin_amdgcn_s_setprio(1); _Pragma("unroll") for (int m = 0; m < 4; ++m) _Pragma("unroll") for (int n = 0; n < 2; ++n) _Pragma("unroll") for (int k = 0; k < 2; ++k) \
        acc[ai][bj][m][n] = __builtin_amdgcn_mfma_f32_16x16x32_bf16(Bt[n][k], At[m][k], acc[ai][bj][m][n], 0, 0, 0); __builtin_amdgcn_s_setprio(0); } while (0)
#define PG8_WAIT_V(n) asm volatile("s_waitcnt vmcnt(" #n ")" ::: "memory")
#define PG8_WAIT_L(n) asm volatile("s_waitcnt lgkmcnt(" #n ")" ::: "memory")
#define PG8_BAR __builtin_amdgcn_s_barrier()
#define PG8_SCHED __builtin_amdgcn_sched_barrier(0)
    Unit cur, nxt; int ui = 0;
    if (!S.next(0, cur)) return;
    f32x4 acc[2][2][4][2];
#pragma unroll
    for (int a = 0; a < 2; ++a)
#pragma unroll
        for (int b = 0; b < 2; ++b)
#pragma unroll
            for (int m = 0; m < 4; ++m)
#pragma unroll
                for (int n = 0; n < 2; ++n) acc[a][b][m][n] = (f32x4){0.f, 0.f, 0.f, 0.f};
    bf16x8 At[4][2], B0[2][2], B1[2][2];
    int par = 0;
    if constexpr (GATHER) { PG8_ROWTAB(0, cur); asm volatile("s_waitcnt vmcnt(0) lgkmcnt(0)" ::: "memory"); __syncthreads(); }
    const char* cA = (const char*)g.A + (size_t)cur.a0 * K * 2;
    const char* cB = (const char*)g.Bt + (size_t)cur.b0 * K * 2;
    PG8_STAGE(PG8_SB(0, 0), cB, voffB); PG8_STAGE(PG8_SB(0, 1), cB + hstep, voffB); PG8_STAGE_A(PG8_SA(0, 0), cA, 0, 0, 0); PG8_STAGE_A(PG8_SA(0, 1), cA, 0, 0, 1);
    if (wr == 1) PG8_BAR;
    PG8_WAIT_V(2); PG8_BAR;
    PG8_STAGE(PG8_SB(1, 0), cB + kstep, voffB); PG8_STAGE_A(PG8_SA(1, 0), cA, kstep, 0, 0); PG8_STAGE(PG8_SB(1, 1), cB + hstep + kstep, voffB);
    PG8_WAIT_V(6); PG8_BAR;
    for (;;) {
        const bool has_next = S.next(ui + 1, nxt);
        if constexpr (GATHER) { if (has_next) { PG8_ROWTAB(par ^ 1, nxt); asm volatile("s_waitcnt vmcnt(0) lgkmcnt(0)" ::: "memory"); } }
        const char* nA = has_next ? (const char*)g.A + (size_t)nxt.a0 * K * 2 : cA;
        const char* nB = has_next ? (const char*)g.Bt + (size_t)nxt.b0 * K * 2 : cB;
        const int npar = has_next ? (par ^ 1) : par;
        for (int t = 0; t < nt; t += 2) {
            const bool last = (t == nt - 2);
            const size_t k1 = (size_t)(t + 1) * kstep;
            const char* a2 = last ? nA : cA; const size_t k2 = last ? 0 : (size_t)(t + 2) * kstep; const char* b2 = last ? nB : cB + (size_t)(t + 2) * kstep;
            const size_t k3 = k2 + kstep; const char* b3 = b2 + kstep;
            const int p2 = last ? npar : par;
            PG8_LDB(B0, 0, 0); PG8_LDB(B1, 0, 1); PG8_SCHED; PG8_LDA(At, 0, 0); PG8_STAGE_A(PG8_SA(1, 1), cA, k1, par, 1);
            PG8_WAIT_V(8); PG8_WAIT_L(0); PG8_BAR; PG8_MMA(0, 0, At, B0); PG8_MMA(0, 1, At, B1); PG8_BAR; PG8_SCHED;
            PG8_LDA(At, 0, 1); PG8_STAGE(PG8_SB(0, 0), b2, voffB); PG8_STAGE(PG8_SB(0, 1), b2 + hstep, voffB); PG8_STAGE_A(PG8_SA(0, 0), a2, k2, p2, 0);
            PG8_WAIT_V(8); PG8_WAIT_L(0); PG8_BAR; PG8_MMA(1, 0, At, B0); PG8_MMA(1, 1, At, B1); PG8_BAR; PG8_SCHED;
            PG8_LDB(B0, 1, 0); PG8_LDB(B1, 1, 1); PG8_SCHED; PG8_LDA(At, 1, 0); PG8_STAGE_A(PG8_SA(0, 1), a2, k2, p2, 1);
            PG8_WAIT_V(8); PG8_WAIT_L(0); PG8_BAR; PG8_MMA(0, 0, At, B0); PG8_MMA(0, 1, At, B1); PG8_BAR; PG8_SCHED;
            PG8_LDA(At, 1, 1); PG8_STAGE(PG8_SB(1, 0), b3, voffB); PG8_STAGE(PG8_SB(1, 1), b3 + hstep, voffB); PG8_STAGE_A(PG8_SA(1, 0), a2, k3, p2, 0);
            PG8_WAIT_V(8); PG8_WAIT_L(0); PG8_BAR; PG8_MMA(1, 0, At, B0); PG8_MMA(1, 1, At, B1); PG8_BAR; PG8_SCHED;
        }
        if (wr == 0) PG8_BAR;
        E(acc, cur, wr, wc, fr, fq);
        if (!has_next) break;
#pragma unroll
        for (int a = 0; a < 2; ++a)
#pragma unroll
            for (int b = 0; b < 2; ++b)
#pragma unroll
                for (int m = 0; m < 4; ++m)
#pragma unroll
                    for (int n = 0; n < 2; ++n) acc[a][b][m][n] = (f32x4){0.f, 0.f, 0.f, 0.f};
        cur = nxt; cA = nA; cB = nB; par = npar; ++ui;
        if (wr == 1) PG8_BAR;
    }
    PG8_WAIT_V(0);
    PG8_BAR;
#undef PG8_SA
#undef PG8_SB
#undef PG8_STAGE
#undef PG8_STAGE_G
#undef PG8_STAGE_A
#undef PG8_ROWTAB
#undef PG8_LDA
#undef PG8_LDB
#undef PG8_MMA
#undef PG8_WAIT_V
#undef PG8_WAIT_L
#undef PG8_BAR
#undef PG8_SCHED
}
}

#define XB_TMO      128
#define XB_XCNT(j)  (256  + 64 * (j))
#define XB_XSUB(j)  (1280 + 64 * (j))
#define XB_XGEN(j)  (2304 + 64 * (j))
#define XB_TOP      3328
#define XB_TOPGEN   3392
#define XCD_BAR_WORDS 3456
#define XB_SPIN_CAP (1u << 18)
__device__ __forceinline__ unsigned xb_ld(unsigned* p)              { return __hip_atomic_load(p, __ATOMIC_RELAXED, __HIP_MEMORY_SCOPE_AGENT); }
__device__ __forceinline__ unsigned xb_add(unsigned* p, unsigned v) { return __hip_atomic_fetch_add(p, v, __ATOMIC_RELAXED, __HIP_MEMORY_SCOPE_AGENT); }
__device__ __forceinline__ unsigned xb_xcc_id() { return (unsigned)__builtin_amdgcn_s_getreg((3 << 11) | 20) & 0xFu; }
#define XB_SPIN(cond, bar) do { unsigned _sp = 0; while (cond) { __builtin_amdgcn_s_sleep(1); \
    if ((++_sp & 255u) == 0u) { if (xb_ld(&(bar)[XB_TMO])) break; if (_sp > XB_SPIN_CAP) { atomicAdd(&(bar)[XB_TMO], 1u); break; } } } } while (0)
struct XcdBarrier { unsigned* bar; unsigned x; volatile LAS unsigned* st; };
__device__ __forceinline__ XcdBarrier xcd_barrier_post(unsigned* bar, volatile LAS unsigned* st) {
    XcdBarrier b; b.bar = bar; b.x = xb_xcc_id(); b.st = st;
    if (threadIdx.x == 0) (void)xb_add(&bar[XB_XCNT(b.x)], 1u);
    return b;
}
__device__ __forceinline__ void xcd_barrier_complete(unsigned* bar, unsigned x, unsigned& nloc, unsigned& nx) {
    const unsigned G = gridDim.x * gridDim.y * gridDim.z;
    unsigned sum, cnt, mine, sp = 0u;
    for (;;) {
        sum = 0u; cnt = 0u; mine = 0u;
#pragma unroll
        for (unsigned j = 0; j < 16; ++j) { const unsigned c = xb_ld(&bar[XB_XCNT(j)]); sum += c; cnt += (c > 0u) ? 1u : 0u; mine = (j == x) ? c : mine; }
        if (sum == G) break;
        __builtin_amdgcn_s_sleep(1);
        if ((++sp & 255u) == 0u) { if (xb_ld(&bar[XB_TMO])) break; if (sp > XB_SPIN_CAP) { atomicAdd(&bar[XB_TMO], 1u); break; } }
    }
    nloc = mine > 0u ? mine : 1u; nx = cnt > 0u ? cnt : 1u;
}
__device__ __forceinline__ void xcd_barrier(const XcdBarrier& b) {
    asm volatile("s_waitcnt vmcnt(0)" ::: "memory");
    __syncthreads();
    if (threadIdx.x == 0) {
        unsigned* bar = b.bar;
        __builtin_amdgcn_s_waitcnt(0);
        unsigned nloc = b.st[0], nx = b.st[1];
        if (nloc == 0u) { xcd_barrier_complete(bar, b.x, nloc, nx); b.st[0] = nloc; b.st[1] = nx; }
        const unsigned old = xb_add(&bar[XB_XSUB(b.x)], 1u);
        const unsigned gen = old / nloc;
        if (old + 1u == (gen + 1u) * nloc) {
            __builtin_amdgcn_fence(__ATOMIC_RELEASE, "agent");
            asm volatile("s_waitcnt vmcnt(0)" ::: "memory");
            const unsigned og = xb_add(&bar[XB_TOP], 1u);
            const unsigned tg = og / nx;
            if (og + 1u == (tg + 1u) * nx) xb_add(&bar[XB_TOPGEN], 1u);
            else XB_SPIN(xb_ld(&bar[XB_TOPGEN]) == tg, bar);
            __builtin_amdgcn_fence(__ATOMIC_ACQUIRE, "agent");
            xb_add(&bar[XB_XGEN(b.x)], 1u);
            asm volatile("s_waitcnt vmcnt(0)" ::: "memory");
        } else {
            XB_SPIN(xb_ld(&bar[XB_XGEN(b.x)]) == gen, bar);
            __builtin_amdgcn_fence(__ATOMIC_ACQUIRE, "agent");
            asm volatile("s_waitcnt vmcnt(0)" ::: "memory");
        }
    }
    __syncthreads();
}

struct Args { const float* in[N_IN]; float* out; unsigned char* ws; int ph_lo, ph_hi; };
struct Frame {
    LAS unsigned char* lds;
    int tid, lane, wave, G, bid;
    const float* const __attribute__((address_space(4)))* in; float* out; unsigned char* ws;
};
__device__ __forceinline__ const float* mod_ptr(const Frame& F, int l, int b, int part) { return (const float*)(F.ws + WS_MOD) + ((size_t)(l * NB + b) * 6 + part) * D; }

__device__ __forceinline__ void transpose_item(const float* W, int N, int k0, int n0, bf16* WT, int ldo, int drow0, int dcol0, LAS float* scr, int lane) {
#pragma unroll 8
    for (int i = 0; i < 32; ++i) { const int kk = 2 * i + (lane >> 5); scr[kk * 33 + (lane & 31)] = W[(size_t)(k0 + kk) * N + n0 + (lane & 31)]; }
    LDS_WAIT(); asm volatile("" ::: "memory");
    const int c = lane & 7;
#pragma unroll
    for (int j = 0; j < 4; ++j) { const int n = (lane >> 3) + 8 * j; const LAS float* s = scr + (8 * c) * 33 + n;
        v4u o; o.x = pk2(s[0 * 33], s[1 * 33]); o.y = pk2(s[2 * 33], s[3 * 33]); o.z = pk2(s[4 * 33], s[5 * 33]); o.w = pk2(s[6 * 33], s[7 * 33]);
        *(GAS v4u*)(WT + (size_t)(drow0 + n) * ldo + dcol0 + k0 + 8 * c) = o; }
    LDS_WAIT(); asm volatile("" ::: "memory");
}
__device__ __forceinline__ int titems(int K, int N) { return (K / 64) * (N / 32); }
__device__ __forceinline__ void tdo(const float* W, int K, int N, int item, bf16* WT, int ldo, int drow0, LAS float* scr, int lane) {
    const int nblk = N / 32, kb = item / nblk, nb = item % nblk; transpose_item(W, N, 64 * kb, 32 * nb, WT, ldo, drow0 + 32 * nb, 0, scr, lane);
}

__device__ __forceinline__ void phase_mix_weights(Frame& F, int gw, int NGW) {
    LAS float* scr = (LAS float*)(F.lds + 65536 + F.wave * 8704);
    constexpr int T_WIN = (D / 64) * (DIN / 32), T_PC = (CW / 64) * (D / 32), T_PR = (RW / 64) * (D / 32), T_WO = (D / 64) * (D / 32), T_L = T_WIN + T_PC + T_PR + T_WO;
    for (int it = gw; it < DEPTH * T_L; it += NGW) {
        const int l = it / T_L; int r = it % T_L; unsigned char* wm = F.ws + WS_WMIX + (size_t)l * WMIX_STRIDE;
        if (r < T_WIN) { tdo(F.in[I_WIN] + (size_t)l * D * DIN, D, DIN, r, (bf16*)(wm + WM_WIN), D, 0, scr, F.lane); continue; } r -= T_WIN;
        if (r < T_PC) { tdo(F.in[I_PCONV] + (size_t)l * CW * D, CW, D, r, (bf16*)(wm + WM_PCONV), CW, 0, scr, F.lane); continue; } r -= T_PC;
        if (r < T_PR) { tdo(F.in[I_PRWKV] + (size_t)l * RW * D, RW, D, r, (bf16*)(wm + WM_PRWKV), RW, 0, scr, F.lane); continue; } r -= T_PR;
        tdo(F.in[I_WO] + (size_t)l * D * D, D, D, r, (bf16*)(wm + WM_WO), D, 0, scr, F.lane);
    }
    for (int i = gw * 64 + F.lane; i < DEPTH * NLORA * KLORA; i += NGW * 64) {
        const int l = i / (NLORA * KLORA), r = i % (NLORA * KLORA), n = r / KLORA, k = r % KLORA; float v = 0.f;
        if (n < 512) { if (k < 64) v = F.in[I_W2][((size_t)l * LW + k) * RW + n]; }
        else if (n < 1024) { if (k >= 64 && k < 128) v = F.in[I_A2][((size_t)l * LA + (k - 64)) * RW + (n - 512)]; }
        else { if (k >= 128) v = F.in[I_G2][((size_t)l * LG + (k - 128)) * RW + (n - 1024)]; }
        ((bf16*)(F.ws + WS_WMIX + (size_t)l * WMIX_STRIDE + WM_LORA))[r] = (bf16)f2bf(v);
    }
}
__device__ __forceinline__ void phase_expert_weights(Frame& F, int l, int gw, int NGW) {
    LAS float* scr = (LAS float*)(F.lds + 65536 + F.wave * 8704);
    bf16* WGU = (bf16*)(F.ws + WS_WGU); bf16* WDN = (bf16*)(F.ws + WS_WDN);
    constexpr int T_G = (D / 64) * (DE / 32), T_D = (DE / 64) * (D / 32), T_E = 2 * T_G + T_D;
    for (int it = gw; it < (NE + 1) * T_E; it += NGW) {
        const int e = it / T_E; int r = it % T_E;
        if (r < 2 * T_G) { const int up = r >= T_G; if (up) r -= T_G;
            const float* W = (e < NE) ? (up ? F.in[I_WEU] : F.in[I_WEG]) + ((size_t)l * NE + e) * D * DE : (up ? F.in[I_WSU] : F.in[I_WSG]) + (size_t)l * D * DE;
            const int nblk = DE / 32, kb = r / nblk, nb = r % nblk, n0 = 32 * nb;
            const int drow0 = e * 512 + (n0 >> 7) * 256 + (up ? 128 : 0) + (n0 & 127);
            transpose_item(W, DE, 64 * kb, n0, WGU, D, drow0, 0, scr, F.lane);
        } else { r -= 2 * T_G;
            const float* W = (e < NE) ? F.in[I_WED] + ((size_t)l * NE + e) * DE * D : F.in[I_WSD] + (size_t)l * DE * D;
            tdo(W, DE, D, r, WDN, DE, e * D, scr, F.lane);
        }
    }
}
__device__ __forceinline__ void phase_ada(Frame& F) {
    LAS float* sc = (LAS float*)F.lds;
    LAS float* red = (LAS float*)(F.lds + 32768);
    for (int i = F.tid; i < NB * D; i += NTHREADS) { const int b = i / D, k = i % D; sc[k * 8 + b] = siluf_(F.in[I_C][i]); }
    __syncthreads();
    float* mod = (float*)(F.ws + WS_MOD);
    for (int it = F.bid; it < DEPTH * 96; it += F.G) {
        const int l = it / 96, n0 = (it % 96) * 64;
        float acc[8];
#pragma unroll
        for (int b = 0; b < 8; ++b) acc[b] = 0.f;
        const float* wp = F.in[I_WADA] + ((size_t)l * D + F.wave * 128) * (6 * D) + n0 + F.lane;
#pragma unroll 4
        for (int k = 0; k < 128; ++k) { const float wv = wp[(size_t)k * (6 * D)]; const LAS f32x4* s = (const LAS f32x4*)(sc + (F.wave * 128 + k) * 8); const f32x4 s0 = s[0], s1 = s[1];
            acc[0] += s0[0] * wv; acc[1] += s0[1] * wv; acc[2] += s0[2] * wv; acc[3] += s0[3] * wv; acc[4] += s1[0] * wv; acc[5] += s1[1] * wv; acc[6] += s1[2] * wv; acc[7] += s1[3] * wv; }
#pragma unroll
        for (int b = 0; b < 8; ++b) red[(F.wave * 8 + b) * 64 + F.lane] = acc[b];
        __syncthreads();
        { const int b = F.tid >> 6; float s = F.in[I_BADA][(size_t)l * 6 * D + n0 + F.lane];
#pragma unroll
          for (int w = 0; w < 8; ++w) s += red[(w * 8 + b) * 64 + F.lane];
          mod[((size_t)l * NB + b) * 6 * D + n0 + F.lane] = s; }
        __syncthreads();
    }
}

struct Row { f32x4 v[4]; };
__device__ __forceinline__ Row row_load(const float* p, int lane) { Row r; const f32x4* q = (const f32x4*)p + lane;
#pragma unroll
    for (int j = 0; j < 4; ++j) r.v[j] = q[64 * j]; return r; }
__device__ __forceinline__ void row_store(float* p, int lane, const Row& r) { f32x4* q = (f32x4*)p + lane;
#pragma unroll
    for (int j = 0; j < 4; ++j) q[64 * j] = r.v[j]; }
__device__ __forceinline__ float row_sumsq(const Row& r) { float s = 0.f;
#pragma unroll
    for (int j = 0; j < 4; ++j) s += (r.v[j][0] * r.v[j][0] + r.v[j][1] * r.v[j][1]) + (r.v[j][2] * r.v[j][2] + r.v[j][3] * r.v[j][3]); return wave_sum(s); }
__device__ __forceinline__ Row row_modnorm(const Row& x, const float* g, const float* sc, const float* sh, int lane) {
    const float rs = rsqrtf(row_sumsq(x) * (1.0f / D) + RMS_EPS); Row gg = row_load(g, lane), s1 = row_load(sc, lane), s0 = row_load(sh, lane), h;
#pragma unroll
    for (int j = 0; j < 4; ++j) h.v[j] = x.v[j] * rs * gg.v[j] * (1.0f + s1.v[j]) + s0.v[j]; return h; }
__device__ __forceinline__ void row_store_bf16(bf16* p, int lane, const Row& r) { v2u* q = (v2u*)p + lane;
#pragma unroll
    for (int j = 0; j < 4; ++j) { v2u w; w.x = pk2(r.v[j][0], r.v[j][1]); w.y = pk2(r.v[j][2], r.v[j][3]); q[64 * j] = w; } }

__device__ __forceinline__ void phase_rowA(Frame& F, int gw, int NGW) {
    bf16* H = (bf16*)(F.ws + WS_H);
    for (int m = gw; m < M; m += NGW) { const int b = m / SEQ; Row x = row_load(F.in[I_X] + (size_t)m * D, F.lane);
        Row h = row_modnorm(x, F.in[I_NMPRE], mod_ptr(F, 0, b, 1), mod_ptr(F, 0, b, 0), F.lane); row_store_bf16(H + (size_t)m * D, F.lane, h); }
}

__device__ __forceinline__ void phase_conv(Frame& F, int l) {
    const bf16* Z = (const bf16*)(F.ws + WS_ZC); bf16* UC = (bf16*)(F.ws + WS_UC);
    LAS float* tile = (LAS float*)F.lds;
    const int c = F.tid;
    float w[CKW];
#pragma unroll
    for (int j = 0; j < CKW; ++j) w[j] = F.in[I_CONVW][((size_t)l * CKW + j) * CW + c];
    const float bias = F.in[I_CONVB][l * CW + c];
    for (int ti = F.bid; ti < M / 32; ti += F.G) {
        const int t0 = ti * 32, s0 = t0 % SEQ;
        float u[62];
#pragma unroll
        for (int i = 0; i < 62; ++i) { float val = 0.f; if (s0 - 30 + i >= 0) { const bf16* zr = Z + (size_t)(t0 - 30 + i) * ZCW; val = bf2f(zr[c]) * sigmoidf_(bf2f(zr[CW + c])); } u[i] = val; }
#pragma unroll
        for (int o = 0; o < 32; ++o) { float a = bias;
#pragma unroll
            for (int j = 0; j < CKW; ++j) a += u[o + j] * w[j];
            tile[o * CW + c] = a; }
        __syncthreads();
#pragma unroll
        for (int q = 0; q < 4; ++q) { const int o = 4 * F.wave + q; float v[8]; float s = 0.f;
#pragma unroll
            for (int i = 0; i < 8; ++i) { v[i] = tile[o * CW + F.lane + 64 * i]; s += v[i]; }
            const float mean = wave_sum(s) * (1.0f / CW); float s2 = 0.f;
#pragma unroll
            for (int i = 0; i < 8; ++i) { v[i] -= mean; s2 += v[i] * v[i]; }
            const float rstd = rsqrtf(wave_sum(s2) * (1.0f / CW) + LN_EPS);
#pragma unroll
            for (int i = 0; i < 8; ++i) { const int cc = F.lane + 64 * i; const float y = v[i] * rstd * F.in[I_CLNG][l * CW + cc] + F.in[I_CLNB][l * CW + cc];
                UC[(size_t)(t0 + o) * CW + cc] = (bf16)f2bf(siluf_(y)); } }
        __syncthreads();
    }
}
__device__ __forceinline__ void phase_prep1(Frame& F, int l, int gw, int NGW) {
    const bf16* Z = (const bf16*)(F.ws + WS_ZR); bf16* LIN = (bf16*)(F.ws + WS_LIN);
    const f32x4 mu = *((const f32x4*)(F.in[I_MU] + (size_t)l * COLR + 1536) + F.lane);
    for (int m = gw; m < M; m += NGW) {
        const int s = m % SEQ; const v2u cur = *((const v2u*)(Z + (size_t)m * ZRW + 1536) + F.lane);
        v2u prv; prv.x = 0u; prv.y = 0u; if (s > 0) prv = *((const v2u*)(Z + (size_t)(m - 1) * ZRW + 1536) + F.lane);
        float x[4] = {bflo(cur.x), bfhi(cur.x), bflo(cur.y), bfhi(cur.y)}; const float p[4] = {bflo(prv.x), bfhi(prv.x), bflo(prv.y), bfhi(prv.y)};
#pragma unroll
        for (int i = 0; i < 4; ++i) { x[i] = x[i] + (p[i] - x[i]) * mu[i]; if (F.lane < 16) x[i] = tanhf(x[i]); else if (F.lane >= 32) x[i] = sigmoidf_(x[i]); }
        v2u o; o.x = pk2(x[0], x[1]); o.y = pk2(x[2], x[3]); *((v2u*)(LIN + (size_t)m * KLORA) + F.lane) = o;
    }
}
__device__ __forceinline__ void ld8bf(const bf16* p, float (&o)[8]) { const v4u w = *(const v4u*)p; o[0] = bflo(w.x); o[1] = bfhi(w.x); o[2] = bflo(w.y); o[3] = bfhi(w.y); o[4] = bflo(w.z); o[5] = bfhi(w.z); o[6] = bflo(w.w); o[7] = bfhi(w.w); }
__device__ __forceinline__ void st8bf(bf16* p, const float (&o)[8]) { v4u w; w.x = pk2(o[0], o[1]); w.y = pk2(o[2], o[3]); w.z = pk2(o[4], o[5]); w.w = pk2(o[6], o[7]); *(v4u*)p = w; }
__device__ __forceinline__ void ld8f(const float* p, float (&o)[8]) { const f32x4 a = *(const f32x4*)p, b = *((const f32x4*)p + 1); o[0] = a[0]; o[1] = a[1]; o[2] = a[2]; o[3] = a[3]; o[4] = b[0]; o[5] = b[1]; o[6] = b[2]; o[7] = b[3]; }
__device__ __forceinline__ float grp8_sum(float v) { v += __shfl_xor(v, 1); v += __shfl_xor(v, 2); v += __shfl_xor(v, 4); return v; }
__device__ __forceinline__ void phase_prep2(Frame& F, int l, int gw, int NGW) {
    const bf16* Z = (const bf16*)(F.ws + WS_ZR); const bf16* LOUT = (const bf16*)(F.ws + WS_LOUT);
    bf16* SR = (bf16*)(F.ws + WS_SR); bf16* SKP = (bf16*)(F.ws + WS_SKP); bf16* SV = (bf16*)(F.ws + WS_SV); bf16* SKKN = (bf16*)(F.ws + WS_SKKN); bf16* SKA = (bf16*)(F.ws + WS_SKA);
    float* SDEC = (float*)(F.ws + WS_SDEC); float* BONUS = (float*)(F.ws + WS_BONUS);
    const int c = 8 * F.lane;
    float mur[8], muk[8], muv[8], w0[8], a0[8], kkw[8], kaw[8], rkw[8];
    ld8f(F.in[I_MU] + (size_t)l * COLR + c, mur); ld8f(F.in[I_MU] + (size_t)l * COLR + 512 + c, muk); ld8f(F.in[I_MU] + (size_t)l * COLR + 1024 + c, muv);
    ld8f(F.in[I_W0] + l * RW + c, w0); ld8f(F.in[I_A0] + l * RW + c, a0); ld8f(F.in[I_KK] + l * RW + c, kkw); ld8f(F.in[I_KA] + l * RW + c, kaw); ld8f(F.in[I_RK] + l * RW + c, rkw);
    for (int m = gw; m < M; m += NGW) {
        const int s = m % SEQ; const bf16* zr = Z + (size_t)m * ZRW + c;
        float r[8], k[8], v[8], pr[8], pk[8], pv[8], lw[8], la[8];
        ld8bf(zr, r); ld8bf(zr + 512, k); ld8bf(zr + 1024, v);
        if (s > 0) { ld8bf(zr - ZRW, pr); ld8bf(zr - ZRW + 512, pk); ld8bf(zr - ZRW + 1024, pv); }
        else {
#pragma unroll
            for (int i = 0; i < 8; ++i) { pr[i] = 0.f; pk[i] = 0.f; pv[i] = 0.f; } }
        ld8bf(LOUT + (size_t)m * NLORA + c, lw); ld8bf(LOUT + (size_t)m * NLORA + 512 + c, la);
        float dec[8], kp[8], kk[8], ka[8]; float ss = 0.f, bo = 0.f;
#pragma unroll
        for (int i = 0; i < 8; ++i) {
            r[i] += (pr[i] - r[i]) * mur[i]; k[i] += (pk[i] - k[i]) * muk[i]; v[i] += (pv[i] - v[i]) * muv[i];
            dec[i] = __expf(-0.60653066f * sigmoidf_(w0[i] + lw[i]));
            const float a = sigmoidf_(a0[i] + la[i]);
            kk[i] = k[i] * kkw[i]; kp[i] = k[i] * (1.0f + (a - 1.0f) * kaw[i]); ka[i] = a;
            ss += kk[i] * kk[i]; bo += r[i] * kp[i] * rkw[i];
        }
        ss = grp8_sum(ss); bo = grp8_sum(bo);
        const float inv = rsqrtf(fmaxf(ss, 1e-24f));
#pragma unroll
        for (int i = 0; i < 8; ++i) { kk[i] *= inv; ka[i] *= kk[i]; }
        const size_t o = (size_t)m * RW + c;
        st8bf(SR + o, r); st8bf(SKP + o, kp); st8bf(SV + o, v); st8bf(SKKN + o, kk); st8bf(SKA + o, ka);
        *(f32x4*)(SDEC + o) = (f32x4){dec[0], dec[1], dec[2], dec[3]}; *((f32x4*)(SDEC + o) + 1) = (f32x4){dec[4], dec[5], dec[6], dec[7]};
        if ((F.lane & 7) == 0) BONUS[(size_t)m * NH + (F.lane >> 3)] = bo;
    }
}
__device__ __forceinline__ void phase_scan(Frame& F) {
    const bf16* SR = (const bf16*)(F.ws + WS_SR); const bf16* SKP = (const bf16*)(F.ws + WS_SKP); const bf16* SV = (const bf16*)(F.ws + WS_SV);
    const bf16* SKKN = (const bf16*)(F.ws + WS_SKKN); const bf16* SKA = (const bf16*)(F.ws + WS_SKA); const float* SDEC = (const float*)(F.ws + WS_SDEC);
    float* YS = (float*)(F.ws + WS_YS);
    LAS float* buf = (LAS float*)F.lds;
    const int vr = F.lane >> 3, ke = F.lane & 7, vidx = 8 * F.wave + vr;
    for (int bh = F.bid; bh < NB * NH; bh += F.G) {
        const int b = bh / NH, h = bh % NH; const size_t m0 = (size_t)b * SEQ;
        float S[8];
#pragma unroll
        for (int i = 0; i < 8; ++i) S[i] = 0.f;
        for (int c0 = 0; c0 < SEQ; c0 += 64) {
            __syncthreads();
            for (int idx = F.tid; idx < 64 * 64; idx += NTHREADS) { const int t = idx >> 6, k = idx & 63; const size_t g = (m0 + c0 + t) * RW + h * RH + k; LAS float* d = buf + t * 384 + k;
                d[0] = bf2f(SR[g]); d[64] = SDEC[g]; d[128] = bf2f(SKP[g]); d[192] = bf2f(SKKN[g]); d[256] = bf2f(SKA[g]); d[320] = bf2f(SV[g]); }
            __syncthreads();
            for (int t = 0; t < 64; ++t) {
                const LAS float* d = buf + t * 384 + ke * 8;
                float r[8], dc[8], kp[8], kn[8], ka[8];
#pragma unroll
                for (int i = 0; i < 8; ++i) { r[i] = d[i]; dc[i] = d[64 + i]; kp[i] = d[128 + i]; kn[i] = d[192 + i]; ka[i] = d[256 + i]; }
                const float v = buf[t * 384 + 320 + vidx];
                float sa = 0.f;
#pragma unroll
                for (int i = 0; i < 8; ++i) sa += S[i] * kn[i];
                sa = -grp8_sum(sa);
                float y = 0.f;
#pragma unroll
                for (int i = 0; i < 8; ++i) { S[i] = S[i] * dc[i] + sa * ka[i] + v * kp[i]; y += S[i] * r[i]; }
                y = grp8_sum(y);
                if (ke == 0) YS[(m0 + c0 + t) * RW + h * RH + vidx] = y;
            }
        }
    }
}
constexpr int CS = 72, CBUF = 64 * CS * 2;
__device__ __forceinline__ f32x4 cmm(const LAS bf16* A, const LAS bf16* B, int m0, int n0, int lane, f32x4 acc) {
#pragma unroll
    for (int ks = 0; ks < 2; ++ks) {
        const bf16x8 a = *(const LAS bf16x8*)(A + (m0 + (lane & 15)) * CS + ks * 32 + 8 * (lane >> 4));
        const bf16x8 b = *(const LAS bf16x8*)(B + (n0 + (lane & 15)) * CS + ks * 32 + 8 * (lane >> 4));
        acc = __builtin_amdgcn_mfma_f32_16x16x32_bf16(a, b, acc, 0, 0, 0);
    }
    return acc;
}
__device__ __forceinline__ void cst4(LAS bf16* O, int n, int m, const f32x4 v) { v2u w; w.x = pk2(v[0], v[1]); w.y = pk2(v[2], v[3]); *(LAS v2u*)(O + n * CS + m) = w; }
__device__ __forceinline__ f32x4 cld4(const LAS bf16* O, int n, int m) { const v2u w = *(const LAS v2u*)(O + n * CS + m); return (f32x4){bflo(w.x), bfhi(w.x), bflo(w.y), bfhi(w.y)}; }
__device__ __forceinline__ void phase_chunkprep(Frame& F) {
    const bf16* SR = (const bf16*)(F.ws + WS_SR); const bf16* SKP = (const bf16*)(F.ws + WS_SKP); const bf16* SV = (const bf16*)(F.ws + WS_SV);
    const bf16* SKKN = (const bf16*)(F.ws + WS_SKKN); const bf16* SKA = (const bf16*)(F.ws + WS_SKA); const float* SDEC = (const float*)(F.ws + WS_SDEC);
    float* YS = (float*)(F.ws + WS_YS); bf16* CQ = (bf16*)(F.ws + WS_CQ); bf16* CG = (bf16*)(F.ws + WS_CG); float* CH = (float*)(F.ws + WS_CH);
#define CB(i) ((LAS bf16*)(F.lds + (i) * CBUF))
    LAS float* part = (LAS float*)(F.lds + 14 * CBUF);
    LAS float* pcs = part + 512;
    const int lane = F.lane, w = F.wave, n0 = 16 * (w & 3), mA = 32 * (w >> 2), nn = n0 + (lane & 15), mq = 4 * (lane >> 4);
    for (int pair = F.bid; pair < NB * NH * (SEQ / 64); pair += F.G) {
        const int bh = pair >> 5, c = pair & 31, b = bh >> 3, h = bh & 7; const size_t m0 = (size_t)b * SEQ + c * 64;
        { const size_t g0 = (m0 + 8 * w) * RW + h * RH + lane;
          float dc[8], kn[8], ka[8], kp[8], rr[8], vv[8];
#pragma unroll
          for (int i = 0; i < 8; ++i) { const size_t g = g0 + (size_t)i * RW; dc[i] = SDEC[g]; kn[i] = bf2f(SKKN[g]); ka[i] = bf2f(SKA[g]); kp[i] = bf2f(SKP[g]); rr[i] = bf2f(SR[g]); vv[i] = bf2f(SV[g]); }
          float p[8]; p[0] = dc[0];
#pragma unroll
          for (int i = 1; i < 8; ++i) p[i] = p[i - 1] * dc[i];
          part[w * 64 + lane] = p[7];
          __syncthreads();
          float pre = 1.f, tot = 1.f;
#pragma unroll
          for (int g = 0; g < 8; ++g) { const float q = part[g * 64 + lane]; tot *= q; if (g < w) pre *= q; }
          if (w == 0) pcs[lane] = tot;
          float at[8], bt[8], kt[8], rt[8], bh_[8], kh[8];
#pragma unroll
          for (int i = 0; i < 8; ++i) { const float P = pre * p[i], Pm = (i == 0) ? pre : pre * p[i - 1], inv = 1.0f / P;
              at[i] = -kn[i] * Pm; bt[i] = ka[i] * inv; kt[i] = kp[i] * inv; rt[i] = rr[i] * P; bh_[i] = bt[i] * tot; kh[i] = kt[i] * tot; }
#pragma unroll
          for (int i = 0; i < 8; ++i) { const int o = (8 * w + i) * CS + lane; CB(0)[o] = (bf16)f2bf(at[i]); CB(1)[o] = (bf16)f2bf(bt[i]); CB(2)[o] = (bf16)f2bf(kt[i]); CB(3)[o] = (bf16)f2bf(rt[i]); }
          { const int o = lane * CS + 8 * w; v4u q;
            q.x = pk2(at[0], at[1]); q.y = pk2(at[2], at[3]); q.z = pk2(at[4], at[5]); q.w = pk2(at[6], at[7]); *(LAS v4u*)(CB(4) + o) = q;
            q.x = pk2(bh_[0], bh_[1]); q.y = pk2(bh_[2], bh_[3]); q.z = pk2(bh_[4], bh_[5]); q.w = pk2(bh_[6], bh_[7]); *(LAS v4u*)(CB(5) + o) = q;
            q.x = pk2(kh[0], kh[1]); q.y = pk2(kh[2], kh[3]); q.z = pk2(kh[4], kh[5]); q.w = pk2(kh[6], kh[7]); *(LAS v4u*)(CB(6) + o) = q;
            q.x = pk2(vv[0], vv[1]); q.y = pk2(vv[2], vv[3]); q.z = pk2(vv[4], vv[5]); q.w = pk2(vv[6], vv[7]); *(LAS v4u*)(CB(7) + o) = q; }
        }
        __syncthreads();
        const f32x4 z4 = (f32x4){0.f, 0.f, 0.f, 0.f};
#pragma unroll
        for (int tl = 0; tl < 2; ++tl) { const int m0t = mA + 16 * tl, mm = m0t + mq;
            f32x4 a1 = cmm(CB(1), CB(0), m0t, n0, lane, z4), a2 = cmm(CB(0), CB(1), m0t, n0, lane, z4), a3 = cmm(CB(2), CB(0), m0t, n0, lane, z4);
            f32x4 a4 = cmm(CB(1), CB(3), m0t, n0, lane, z4), a5 = cmm(CB(2), CB(3), m0t, n0, lane, z4), t0;
#pragma unroll
            for (int i = 0; i < 4; ++i) { const int m = mm + i; a1[i] = (m < nn) ? a1[i] : 0.f; a2[i] = (nn < m) ? a2[i] : 0.f; a3[i] = (m < nn) ? a3[i] : 0.f; a4[i] = (m <= nn) ? a4[i] : 0.f; a5[i] = (m <= nn) ? a5[i] : 0.f; t0[i] = a1[i] + ((m == nn) ? 1.f : 0.f); }
            cst4(CB(8), nn, mm, a1); cst4(CB(9), nn, mm, a2); cst4(CB(10), nn, mm, t0); cst4(CB(11), nn, mm, a3); cst4(CB(12), nn, mm, a4); cst4(CB(13), nn, mm, a5); }
        __syncthreads();
#pragma unroll
        for (int tl = 0; tl < 2; ++tl) { const int m0t = mA + 16 * tl, mm = m0t + mq;
            cst4(CB(0), nn, mm, cmm(CB(9), CB(8), m0t, n0, lane, z4)); cst4(CB(1), nn, mm, cmm(CB(8), CB(9), m0t, n0, lane, z4)); cst4(CB(2), nn, mm, cmm(CB(11), CB(7), m0t, n0, lane, z4)); }
        __syncthreads();
#define CSTEP(MP, MPT, MPN, MPTN, TI, TO, DO_MP, DO_MPT) do { _Pragma("unroll") for (int tl = 0; tl < 2; ++tl) { const int m0t = mA + 16 * tl, mm = m0t + mq; \
            if (DO_MP) cst4(CB(MPN), nn, mm, cmm(CB(MPT), CB(MP), m0t, n0, lane, z4)); if (DO_MPT) cst4(CB(MPTN), nn, mm, cmm(CB(MP), CB(MPT), m0t, n0, lane, z4)); \
            cst4(CB(TO), nn, mm, cmm(CB(MPT), CB(TI), m0t, n0, lane, cld4(CB(TI), nn, mm))); } __syncthreads(); } while (0)
        CSTEP(0, 1, 8, 9, 10, 11, true, true);
        CSTEP(8, 9, 0, 1, 11, 10, true, true);
        CSTEP(0, 1, 8, 9, 10, 11, true, true);
        CSTEP(8, 9, 0, 1, 11, 10, false, true);
        CSTEP(0, 1, 8, 9, 10, 11, false, false);
#undef CSTEP
#pragma unroll
        for (int tl = 0; tl < 2; ++tl) { const int m0t = mA + 16 * tl, mm = m0t + mq;
            cst4(CB(8), nn, mm, cmm(CB(11), CB(4), m0t, n0, lane, z4)); cst4(CB(9), nn, mm, cmm(CB(11), CB(2), m0t, n0, lane, z4)); }
        __syncthreads();
#pragma unroll
        for (int tl = 0; tl < 2; ++tl) { const int m0t = mA + 16 * tl, mm = m0t + mq;
            { const f32x4 q = cmm(CB(8), CB(12), m0t, n0, lane, cld4(CB(3), nn, mm)); v2u o; o.x = pk2(q[0], q[1]); o.y = pk2(q[2], q[3]); *(v2u*)(CQ + ((size_t)pair * 64 + nn) * 64 + mm) = o; }
            { const f32x4 y = cmm(CB(7), CB(13), m0t, n0, lane, cmm(CB(9), CB(12), m0t, n0, lane, z4)); *(f32x4*)(YS + (m0 + nn) * RW + h * RH + mm) = y; }
            { f32x4 g = cmm(CB(8), CB(5), m0t, n0, lane, z4);
#pragma unroll
              for (int i = 0; i < 4; ++i) g[i] += (mm + i == nn) ? pcs[nn] : 0.f;
              v2u o; o.x = pk2(g[0], g[1]); o.y = pk2(g[2], g[3]); *(v2u*)(CG + ((size_t)pair * 64 + nn) * 64 + mm) = o; }
            { const f32x4 hh = cmm(CB(7), CB(6), m0t, n0, lane, cmm(CB(9), CB(5), m0t, n0, lane, z4)); *(f32x4*)(CH + ((size_t)pair * 64 + nn) * 64 + mm) = hh; }
        }
        __syncthreads();
    }
#undef CB
}
typedef float f32x16 __attribute__((ext_vector_type(16)));
__device__ __forceinline__ bf16x8 pack_frag(const f32x16& x, int s) {
    v4u w; w.x = pk2(x[8 * s + 0], x[8 * s + 1]); w.y = pk2(x[8 * s + 2], x[8 * s + 3]); w.z = pk2(x[8 * s + 4], x[8 * s + 5]); w.w = pk2(x[8 * s + 6], x[8 * s + 7]);
    return __builtin_bit_cast(bf16x8, w);
}
__device__ __forceinline__ bf16x8 ld_afrag(const bf16* rowp, int kbase, int hh) {
    const v2u lo = *(const v2u*)(rowp + kbase + 4 * hh), hi = *(const v2u*)(rowp + kbase + 8 + 4 * hh); v4u w; w.x = lo.x; w.y = lo.y; w.z = hi.x; w.w = hi.y; return __builtin_bit_cast(bf16x8, w);
}
__device__ __forceinline__ void phase_chunkscan(Frame& F) {
    float* YS = (float*)(F.ws + WS_YS); const bf16* CQ = (const bf16*)(F.ws + WS_CQ); const bf16* CG = (const bf16*)(F.ws + WS_CG); const float* CH = (const float*)(F.ws + WS_CH);
    const int lane = F.lane, r32 = lane & 31, hh = lane >> 5;
    const int per = (F.G >= 128) ? 1 : 2;
    if (F.wave < per)
    for (int item = F.bid * per + F.wave; item < NB * NH * 2; item += F.G * per) {
        const int bh = item >> 1, vh = item & 1, b = bh >> 3, h = bh & 7; const size_t m0 = (size_t)b * SEQ;
        f32x16 X[2];
#pragma unroll
        for (int i = 0; i < 16; ++i) { X[0][i] = 0.f; X[1][i] = 0.f; }
        for (int c = 0; c < SEQ / 64; ++c) {
            const size_t pair = (size_t)bh * 32 + c;
            const bf16* gq = CQ + pair * 4096; const bf16* gg = CG + pair * 4096; const float* gh = CH + pair * 4096;
            bf16x8 xb[2][2];
#pragma unroll
            for (int kt = 0; kt < 2; ++kt)
#pragma unroll
                for (int s = 0; s < 2; ++s) xb[kt][s] = pack_frag(X[kt], s);
            f32x16 Yt[2], Xn[2];
#pragma unroll
            for (int tt = 0; tt < 2; ++tt)
#pragma unroll
                for (int i = 0; i < 16; ++i) { const int row = 32 * tt + (i & 3) + 8 * (i >> 2) + 4 * hh;
                    Yt[tt][i] = YS[(m0 + c * 64 + row) * RW + h * RH + 32 * vh + r32]; Xn[tt][i] = gh[row * 64 + 32 * vh + r32]; }
#pragma unroll
            for (int tt = 0; tt < 2; ++tt)
#pragma unroll
                for (int kt = 0; kt < 2; ++kt)
#pragma unroll
                    for (int s = 0; s < 2; ++s) {
                        Yt[tt] = __builtin_amdgcn_mfma_f32_32x32x16_bf16(ld_afrag(gq + (32 * tt + r32) * 64, 32 * kt + 16 * s, hh), xb[kt][s], Yt[tt], 0, 0, 0);
                        Xn[tt] = __builtin_amdgcn_mfma_f32_32x32x16_bf16(ld_afrag(gg + (32 * tt + r32) * 64, 32 * kt + 16 * s, hh), xb[kt][s], Xn[tt], 0, 0, 0); }
#pragma unroll
            for (int tt = 0; tt < 2; ++tt)
#pragma unroll
                for (int i = 0; i < 16; ++i) { const int row = 32 * tt + (i & 3) + 8 * (i >> 2) + 4 * hh; YS[(m0 + c * 64 + row) * RW + h * RH + 32 * vh + r32] = Yt[tt][i]; }
            X[0] = Xn[0]; X[1] = Xn[1];
        }
    }
}
__device__ __forceinline__ void phase_post(Frame& F, int l, int gw, int NGW) {
    const float* YS = (const float*)(F.ws + WS_YS); const bf16* SV = (const bf16*)(F.ws + WS_SV); const bf16* LOUT = (const bf16*)(F.ws + WS_LOUT); const float* BONUS = (const float*)(F.ws + WS_BONUS);
    bf16* YG = (bf16*)(F.ws + WS_YG);
    const int c = 8 * F.lane; float gg[8], gb[8]; ld8f(F.in[I_GNG] + l * RW + c, gg); ld8f(F.in[I_GNB] + l * RW + c, gb);
    for (int m = gw; m < M; m += NGW) {
        float y[8], v[8], g[8]; ld8f(YS + (size_t)m * RW + c, y); ld8bf(SV + (size_t)m * RW + c, v); ld8bf(LOUT + (size_t)m * NLORA + 1024 + c, g);
        float s = 0.f;
#pragma unroll
        for (int i = 0; i < 8; ++i) s += y[i];
        const float mean = grp8_sum(s) * (1.0f / RH); float s2 = 0.f;
#pragma unroll
        for (int i = 0; i < 8; ++i) { y[i] -= mean; s2 += y[i] * y[i]; }
        const float rstd = rsqrtf(grp8_sum(s2) * (1.0f / RH) + GN_EPS); const float bo = BONUS[(size_t)m * NH + (F.lane >> 3)];
        float o[8];
#pragma unroll
        for (int i = 0; i < 8; ++i) o[i] = (y[i] * rstd * gg[i] + gb[i] + bo * v[i]) * g[i];
        st8bf(YG + (size_t)m * RW + c, o);
    }
}

__device__ __forceinline__ unsigned* cnt_word(const Frame& F, int l, int e) { return (unsigned*)(F.ws + WS_CTL) + CW_CNT + (l * NE + e) * 64; }
__device__ __forceinline__ void phase_rowB(Frame& F, int l, int gw, int NGW) {
    const float* Y = (const float*)(F.ws + WS_Y); bf16* H = (bf16*)(F.ws + WS_H);
    int* LIST = (int*)(F.ws + WS_LIST); float* GW = (float*)(F.ws + WS_GW); int* TOKA = (int*)(F.ws + WS_TOKA);
    const float* xsrc = (l == 0) ? F.in[I_X] : F.out;
    LAS float* hrow = (LAS float*)(F.lds + F.wave * 4096);
    const float* wr = F.in[I_WROUTER] + (size_t)l * D * NE; const float br = F.in[I_BROUTER][l * NE + F.lane];
    for (int m = gw; m < M; m += NGW) {
        const int b = m / SEQ;
        Row y = row_load(Y + (size_t)m * D, F.lane), x = row_load(xsrc + (size_t)m * D, F.lane), gp = row_load(F.in[I_NMPOST] + l * D, F.lane), gt = row_load(mod_ptr(F, l, b, 2), F.lane);
        const float rs = rsqrtf(row_sumsq(y) * (1.0f / D) + RMS_EPS);
#pragma unroll
        for (int j = 0; j < 4; ++j) x.v[j] = x.v[j] + gt.v[j] * (y.v[j] * rs * gp.v[j]);
        row_store(F.out + (size_t)m * D, F.lane, x);
        Row h = row_modnorm(x, F.in[I_NFPRE] + l * D, mod_ptr(F, l, b, 4), mod_ptr(F, l, b, 3), F.lane);
        row_store_bf16(H + (size_t)m * D, F.lane, h);
#pragma unroll
        for (int j = 0; j < 4; ++j) *((LAS f32x4*)hrow + F.lane + 64 * j) = h.v[j];
        LDS_WAIT(); __builtin_amdgcn_wave_barrier();
        float lg = 0.f;
#pragma unroll 4
        for (int k4 = 0; k4 < D / 4; ++k4) { const f32x4 hv = *((const LAS f32x4*)hrow + k4); const float* wp = wr + (size_t)k4 * 4 * NE + F.lane;
            lg += hv[0] * wp[0]; lg += hv[1] * wp[NE]; lg += hv[2] * wp[2 * NE]; lg += hv[3] * wp[3 * NE]; }
        __builtin_amdgcn_wave_barrier();
        const float score = sigmoidf_(lg), biased = score + br;
        int rk = 0;
#pragma unroll
        for (int d = 1; d < 8; ++d) { const float o = __shfl_xor(biased, d); rk += (o > biased || (o == biased && (F.lane ^ d) < F.lane)) ? 1 : 0; }
        const float gs = grp8_sum(rk < 2 ? biased : 0.f);
        const int g = F.lane >> 3; int grk = 0;
#pragma unroll
        for (int d = 1; d < 8; ++d) { const float o = __shfl_xor(gs, d * 8); grk += (o > gs || (o == gs && (g ^ d) < g)) ? 1 : 0; }
        const float masked = (grk < 4) ? biased : -__builtin_inff();
        int rank = 0;
#pragma unroll
        for (int d = 1; d < 64; ++d) { const float o = __shfl_xor(masked, d); rank += (o > masked || (o == masked && (F.lane ^ d) < F.lane)) ? 1 : 0; }
        const bool chosen = rank < TOPK;
        const float ssum = wave_sum(chosen ? score : 0.f);
        if (chosen) { const int e = F.lane; const unsigned pos = __hip_atomic_fetch_add(cnt_word(F, l, e), 1u, RLX_AGENT);
            LIST[(size_t)e * M + pos] = m; GW[(size_t)e * M + pos] = score / ssum * ROUTED_SCALE; TOKA[(size_t)m * TOPK + rank] = e * 65536 + (int)pos; }
        if (F.lane == 0) { LIST[(size_t)NE * M + m] = m; GW[(size_t)NE * M + m] = 1.0f; }
    }
}

struct MoeTab { LAS int* cnt; LAS int* start; LAS int* tstart; LAS int* ntiles; LAS int* tiles; };
__device__ __forceinline__ MoeTab moe_tab(const Frame& F) { MoeTab T; LAS int* p = (LAS int*)(F.lds + LDS_TAB_OFF); T.cnt = p; T.start = p + 80; T.tstart = p + 160; T.ntiles = p + 240; T.tiles = p + 256; return T; }
__device__ __forceinline__ void moe_build(Frame& F, int l, bool with_tiles) {
    MoeTab T = moe_tab(F);
    __syncthreads();
    if (F.tid <= NE) T.cnt[F.tid] = (F.tid < NE) ? (int)__hip_atomic_load(cnt_word(F, l, F.tid), RLX_AGENT) : M;
    __syncthreads();
    if (F.tid <= NE) { int s = 0, ts = 0; for (int e = 0; e < F.tid; ++e) { const int c = T.cnt[e]; s += c; ts += (c + 255) >> 8; } T.start[F.tid] = s; T.tstart[F.tid] = ts;
        if (F.tid == NE) T.ntiles[0] = ts + ((M + 255) >> 8);
        if (with_tiles) { const int c = T.cnt[F.tid]; const int nt = (c + 255) >> 8;
            for (int rt = 0; rt < nt; ++rt) { LAS int* q = T.tiles + (ts + rt) * 4; q[0] = F.tid; q[1] = rt * 256; q[2] = s + rt * 256; q[3] = (c - rt * 256) < 256 ? (c - rt * 256) : 256; } } }
    __syncthreads();
}
struct MoeOrder {
    LAS const int* tiles; int ntiles, npn, nwg, G, c, bstride;
    __device__ bool next(int i, pg8::Unit& u) const {
        const long L = (long)i * G + c; if (L >= nwg) return false;
        int wgid = (int)L; { const int q = nwg / 8, r = nwg % 8, xcd = wgid % 8, off = wgid / 8; wgid = (xcd < r ? xcd * (q + 1) : r * (q + 1) + (xcd - r) * q) + off; }
        const int tile = wgid / npn, pn = wgid % npn; LAS const int* q = tiles + tile * 4;
        u.e = q[0]; u.x0 = u.e * M + q[1]; u.o0 = q[2]; u.nrows = q[3]; u.b0 = u.e * bstride + pn * 256; u.oc0 = pn * 256; u.a0 = q[2]; return true;
    }
};
__device__ __forceinline__ Row row_load_bf16(const bf16* p, int lane) { Row r; const v2u* q = (const v2u*)p + lane;
#pragma unroll
    for (int j = 0; j < 4; ++j) { const v2u w = q[64 * j]; r.v[j] = (f32x4){bflo(w.x), bfhi(w.x), bflo(w.y), bfhi(w.y)}; } return r; }
__device__ __forceinline__ void phase_rowC(Frame& F, int l, int gw, int NGW) {
    const bf16* YEXP = (const bf16*)(F.ws + WS_YEXP); const bf16* YSH = (const bf16*)(F.ws + WS_YSH); const int* TOKA = (const int*)(F.ws + WS_TOKA); bf16* H = (bf16*)(F.ws + WS_H);
    MoeTab T = moe_tab(F);
    for (int m = gw; m < M; m += NGW) {
        const int b = m / SEQ;
        Row y = row_load_bf16(YSH + (size_t)m * D, F.lane);
#pragma unroll
        for (int j8 = 0; j8 < TOPK; ++j8) { const int ep = TOKA[(size_t)m * TOPK + j8]; const int slot = T.start[ep >> 16] + (ep & 65535); const Row t = row_load_bf16(YEXP + (size_t)slot * D, F.lane);
#pragma unroll
            for (int j = 0; j < 4; ++j) y.v[j] += t.v[j]; }
        Row x = row_load(F.out + (size_t)m * D, F.lane), gp = row_load(F.in[I_NFPOST] + l * D, F.lane), gt = row_load(mod_ptr(F, l, b, 5), F.lane);
        const float rs = rsqrtf(row_sumsq(y) * (1.0f / D) + RMS_EPS);
#pragma unroll
        for (int j = 0; j < 4; ++j) x.v[j] = x.v[j] + gt.v[j] * (y.v[j] * rs * gp.v[j]);
        row_store(F.out + (size_t)m * D, F.lane, x);
        if (l + 1 < DEPTH) { Row h = row_modnorm(x, F.in[I_NMPRE] + (l + 1) * D, mod_ptr(F, l + 1, b, 1), mod_ptr(F, l + 1, b, 0), F.lane); row_store_bf16(H + (size_t)m * D, F.lane, h); }
    }
}

__device__ __forceinline__ void phase_begin(Frame& F) { asm volatile("" : "+s"(F.in), "+s"(F.ws), "+s"(F.out), "+s"(F.bid), "+s"(F.G)); asm volatile("" : "+v"(F.tid)); F.lane = F.tid & 63; F.wave = __builtin_amdgcn_readfirstlane(F.tid >> 6); }
constexpr int PH_PER_LAYER = 13, NPH = 2 + DEPTH * PH_PER_LAYER;
__device__ __forceinline__ void bar_launder(XcdBarrier& bar) { asm volatile("" : "+s"(bar.bar)); }
#define IN(k) (phase_begin(F), bar_launder(bar), (lo <= (k) && (k) < hi))
#define SEAM(k) do { if (!MK_PER_PHASE && (k) + 1 < hi) xcd_barrier(bar); } while (0)
template <int L> __device__ __forceinline__ void layer_phases(Frame& F, XcdBarrier& bar, const int lo, const int hi) {
    constexpr int l = L, p0 = 2 + L * PH_PER_LAYER;
#define GW_ const int gw = F.bid * NWAVES + F.wave, NGW = F.G * NWAVES
#define WM_ unsigned char* wm = F.ws + WS_WMIX + (size_t)l * WMIX_STRIDE
    if (IN(p0 + 0)) { WM_;
        { pg8::Gemm g{(const bf16*)(F.ws + WS_H), (const bf16*)(wm + WM_WIN), D, nullptr}; pg8::StaticOrder S; S.init(M, ZCW, F.G, F.bid);
          pg8::EpiBf16 E{(bf16*)(F.ws + WS_ZC), ZCW, nullptr}; pg8::gemm_phase<pg8::EpiBf16, pg8::StaticOrder, false>(F.lds, F.tid, g, S, E); }
        { pg8::Gemm g{(const bf16*)(F.ws + WS_H), (const bf16*)(wm + WM_WIN) + (size_t)ZR0 * D, D, nullptr}; pg8::StaticOrder S; S.init(M, ZRW, F.G, F.bid);
          pg8::EpiBf16 E{(bf16*)(F.ws + WS_ZR), ZRW, nullptr}; pg8::gemm_phase<pg8::EpiBf16, pg8::StaticOrder, false>(F.lds, F.tid, g, S, E); }
        { pg8::Gemm g{(const bf16*)(F.ws + WS_H), (const bf16*)(wm + WM_WIN) + (size_t)ZG0 * D, D, nullptr}; pg8::StaticOrder S; S.init(M, ZGW, F.G, F.bid);
          pg8::EpiBf16 E{(bf16*)(F.ws + WS_ZG), ZGW, nullptr}; pg8::gemm_phase<pg8::EpiBf16, pg8::StaticOrder, false>(F.lds, F.tid, g, S, E); }
        SEAM(p0 + 0); }
    if (IN(p0 + 1)) { GW_; phase_conv(F, l); phase_prep1(F, l, gw, NGW); SEAM(p0 + 1); }
    if (IN(p0 + 2)) { WM_; pg8::Gemm g{(const bf16*)(F.ws + WS_LIN), (const bf16*)(wm + WM_LORA), KLORA, nullptr}; pg8::StaticOrder S; S.init(M, NLORA, F.G, F.bid);
        pg8::EpiBf16 E{(bf16*)(F.ws + WS_LOUT), NLORA, nullptr}; pg8::gemm_phase<pg8::EpiBf16, pg8::StaticOrder, false>(F.lds, F.tid, g, S, E); SEAM(p0 + 2); }
    if (IN(p0 + 3)) { GW_; phase_prep2(F, l, gw, NGW); SEAM(p0 + 3); }
    if (IN(p0 + 4)) { phase_chunkprep(F); SEAM(p0 + 4); }
    if (IN(p0 + 5)) { const int per = (F.G >= 128) ? 1 : 2;
        if (F.wave < per) phase_chunkscan(F); else phase_expert_weights(F, l, F.bid * (NWAVES - per) + F.wave - per, F.G * (NWAVES - per)); SEAM(p0 + 5); }
    if (IN(p0 + 6)) { GW_; phase_post(F, l, gw, NGW); SEAM(p0 + 6); }
    if (IN(p0 + 7)) { WM_; pg8::StaticOrder S; S.init(M, D, F.G, F.bid);
        { pg8::Gemm g{(const bf16*)(F.ws + WS_UC), (const bf16*)(wm + WM_PCONV), CW, nullptr}; pg8::EpiMerge<true> E{(bf16*)(F.ws + WS_MERGED), (const bf16*)(F.ws + WS_ZG), 0};
          pg8::gemm_phase<pg8::EpiMerge<true>, pg8::StaticOrder, false>(F.lds, F.tid, g, S, E); }
        { pg8::Gemm g{(const bf16*)(F.ws + WS_YG), (const bf16*)(wm + WM_PRWKV), RW, nullptr}; pg8::EpiMerge<false> E{(bf16*)(F.ws + WS_MERGED), (const bf16*)(F.ws + WS_ZG), D};
          pg8::gemm_phase<pg8::EpiMerge<false>, pg8::StaticOrder, false>(F.lds, F.tid, g, S, E); }
        SEAM(p0 + 7); }
    if (IN(p0 + 8)) { WM_; pg8::Gemm g{(const bf16*)(F.ws + WS_MERGED), (const bf16*)(wm + WM_WO), D, nullptr}; pg8::StaticOrder S; S.init(M, D, F.G, F.bid);
        pg8::EpiF32 E{(float*)(F.ws + WS_Y), D}; pg8::gemm_phase<pg8::EpiF32, pg8::StaticOrder, false>(F.lds, F.tid, g, S, E); SEAM(p0 + 8); }
    if (IN(p0 + 9)) { GW_; phase_rowB(F, l, gw, NGW); SEAM(p0 + 9); }
    if (IN(p0 + 10)) { moe_build(F, l, true); MoeTab T = moe_tab(F);
        MoeOrder S{T.tiles, T.ntiles[0], 2, T.ntiles[0] * 2, F.G, F.bid, 512};
        pg8::Gemm g{(const bf16*)(F.ws + WS_H), (const bf16*)(F.ws + WS_WGU), D, (const int*)(F.ws + WS_LIST)};
        pg8::EpiSwiGLU E{(bf16*)(F.ws + WS_ACT)}; pg8::gemm_phase<pg8::EpiSwiGLU, MoeOrder, true>(F.lds, F.tid, g, S, E); SEAM(p0 + 10); }
    if (IN(p0 + 11)) { moe_build(F, l, true); MoeTab T = moe_tab(F);
        MoeOrder S{T.tiles, T.ntiles[0], 4, T.ntiles[0] * 4, F.G, F.bid, 1024};
        pg8::Gemm g{(const bf16*)(F.ws + WS_ACT), (const bf16*)(F.ws + WS_WDN), DE, nullptr};
        pg8::EpiBf16 E{(bf16*)(F.ws + WS_YEXP), D, (const float*)(F.ws + WS_GW)}; pg8::gemm_phase<pg8::EpiBf16, MoeOrder, false>(F.lds, F.tid, g, S, E); SEAM(p0 + 11); }
    if (IN(p0 + 12)) { GW_; moe_build(F, l, false); phase_rowC(F, l, gw, NGW); SEAM(p0 + 12); }
}
__global__ void __launch_bounds__(NTHREADS, 2) mk_fwd(Args args) {
    extern __shared__ __attribute__((aligned(16))) unsigned char lds_raw[];
    Frame F; F.lds = (LAS unsigned char*)lds_raw; F.tid = threadIdx.x; F.lane = F.tid & 63; F.wave = __builtin_amdgcn_readfirstlane(F.tid >> 6);
    F.G = gridDim.x; F.bid = blockIdx.x; F.in = (const float* const __attribute__((address_space(4)))*)__builtin_amdgcn_kernarg_segment_ptr(); F.out = args.out; F.ws = args.ws;
    volatile LAS unsigned* MISC = (volatile LAS unsigned*)(F.lds + MISC_OFF);
    if (F.tid < 64) MISC[F.tid] = 0u;
    __syncthreads();
    XcdBarrier bar; bar.bar = (unsigned*)(F.ws + WS_CTL) + CW_BAR; bar.x = 0; bar.st = nullptr;
    if (!MK_PER_PHASE) bar = xcd_barrier_post((unsigned*)(F.ws + WS_CTL) + CW_BAR, MISC + 8);
    const int lo = args.ph_lo, hi = (args.ph_hi < MK_LAST_PHASE + 1) ? args.ph_hi : MK_LAST_PHASE + 1;
    if (IN(0)) { GW_; phase_ada(F); phase_mix_weights(F, gw, NGW); SEAM(0); }
    if (IN(1)) { GW_; phase_rowA(F, gw, NGW); SEAM(1); }
    layer_phases<0>(F, bar, lo, hi);
    layer_phases<1>(F, bar, lo, hi);
    if (MK_LAST_PHASE < 2 + 9 && args.ph_hi == NPH) { phase_begin(F); for (size_t i = (size_t)F.bid * NTHREADS + F.tid; i < (size_t)M * D / 4; i += (size_t)F.G * NTHREADS) ((f32x4*)F.out)[i] = ((const f32x4*)F.in[I_X])[i]; }
}
#undef IN
#undef SEAM
#undef GW_
#undef WM_

extern "C" void kernel_launch(void* const* d_in, const int* in_sizes, int n_in, void* d_out, int out_size, void* d_ws, size_t ws_size, hipStream_t stream) {
    static int grid = 0;
    if (grid == 0) {
        if (n_in != N_IN || out_size != M * D) { fprintf(stderr, "kernel_launch: unexpected shapes (n_in %d out %d ws %zu need %zu)\n", n_in, out_size, ws_size, (size_t)WS_END); grid = -1; return; }
        if (ws_size < WS_END) { fprintf(stderr, "kernel_launch: ws too small %zu < %zu\n", ws_size, (size_t)WS_END); grid = -2; }
        int dev = 0, cus = 0;
        if (hipGetDevice(&dev) != hipSuccess || hipDeviceGetAttribute(&cus, hipDeviceAttributeMultiprocessorCount, dev) != hipSuccess) { grid = -1; return; }
        if (hipFuncSetAttribute((const void*)mk_fwd, hipFuncAttributeMaxDynamicSharedMemorySize, LDS_BYTES) != hipSuccess) { fprintf(stderr, "kernel_launch: hipFuncSetAttribute failed\n"); grid = -1; return; }
        (void)hipGetLastError();
        grid = cus;
    }
    if (grid == -2) { (void)hipMemsetAsync(d_out, 0, (size_t)out_size * 4, stream); return; }
    if (grid < 0) return;
    (void)hipMemsetAsync((char*)d_ws + WS_CTL, 0, CTL_ZERO_BYTES, stream);
    Args a{};
    for (int i = 0; i < N_IN; ++i) a.in[i] = (const float*)d_in[i];
    a.out = (float*)d_out; a.ws = (unsigned char*)d_ws;
#if MK_PER_PHASE
    for (int p = 0; p < NPH && p <= MK_LAST_PHASE; ++p) { a.ph_lo = p; a.ph_hi = p + 1; hipLaunchKernelGGL(mk_fwd, dim3(grid), dim3(NTHREADS), LDS_BYTES, stream, a); }
#else
    a.ph_lo = 0; a.ph_hi = NPH;
    hipLaunchKernelGGL(mk_fwd, dim3(grid), dim3(NTHREADS), LDS_BYTES, stream, a);
#endif
}
```

```cpp
#include <hip/hip_runtime.h>
#include <cstdio>
#include <cstdint>

#ifndef MK_PER_PHASE
#define MK_PER_PHASE 0
#endif
#ifndef MK_REPEAT
#define MK_REPEAT -1
#endif
#ifndef MK_TIME_MASK
#define MK_TIME_MASK 0
#endif
#ifndef MK_RB_LEVEL
#define MK_RB_LEVEL 3
#endif
#ifndef MK_LAST_PHASE
#define MK_LAST_PHASE 9999
#endif

#define GAS __attribute__((address_space(1)))
#define LAS __attribute__((address_space(3)))
typedef unsigned short bf16;
typedef unsigned v4u __attribute__((ext_vector_type(4)));
typedef unsigned v2u __attribute__((ext_vector_type(2)));
typedef float f32x4 __attribute__((ext_vector_type(4)));
typedef float f32x2 __attribute__((ext_vector_type(2)));
typedef short bf16x8 __attribute__((ext_vector_type(8)));
typedef GAS unsigned gu32;
#define RLX_AGENT __ATOMIC_RELAXED, __HIP_MEMORY_SCOPE_AGENT
#define LDS_WAIT() asm volatile("s_waitcnt lgkmcnt(0)" ::: "memory")
#define VM_WAIT() asm volatile("s_waitcnt vmcnt(0)" ::: "memory")

constexpr int NB = 8, SEQ = 2048, D = 1024, M = NB * SEQ, DEPTH = 2;
constexpr int CW = 512, CKW = 31, RW = 512, RH = 64, NH = 8, LW = 64, LA = 64, LG = 128;
constexpr int NE = 64, TOPK = 8, DE = 256;
constexpr int DIN = 4864, ZR0 = 1024, ZG0 = 2816, COLR = 1792;
constexpr int NLORA = 1536, KLORA = 256;
constexpr float RMS_EPS = 1e-6f, LN_EPS = 1e-5f, GN_EPS = 64e-5f, ROUTED_SCALE = 2.5f;
constexpr int NWAVES = 8, NTHREADS = 512;

enum { I_X = 0, I_C, I_WADA, I_BADA, I_NMPRE, I_NMPOST, I_NFPRE, I_NFPOST, I_WIN, I_MU, I_CONVW, I_CONVB, I_CLNG, I_CLNB, I_PCONV,
       I_W0, I_W2, I_A0, I_A2, I_G2, I_KK, I_KA, I_RK, I_GNG, I_GNB, I_PRWKV, I_WO, I_WROUTER, I_BROUTER, I_WEG, I_WEU, I_WED, I_WSG, I_WSU, I_WSD, N_IN };

constexpr size_t MiB = 1u << 20;
constexpr size_t WS_CTL = 0, CTL_ZERO_BYTES = 1 * MiB;
constexpr size_t WS_MOD = 1 * MiB;
constexpr size_t WS_BONUS = 1 * MiB + 512 * 1024;
constexpr size_t WS_WMIX = 2 * MiB;
constexpr size_t WMIX_STRIDE = 15 * MiB;
constexpr size_t WM_WIN = 0, WM_PCONV = (size_t)DIN * D * 2, WM_PRWKV = WM_PCONV + (size_t)D * CW * 2, WM_WO = WM_PRWKV + (size_t)D * RW * 2, WM_LORA = WM_WO + (size_t)D * D * 2;
static_assert(WM_LORA + (size_t)NLORA * KLORA * 2 <= WMIX_STRIDE, "wmix");
constexpr size_t WS_WGU = 32 * MiB;
constexpr size_t WS_WDN = 97 * MiB;
constexpr size_t WS_H = 130 * MiB;
constexpr size_t WS_LIST = 162 * MiB;
constexpr size_t WS_GW = 167 * MiB;
constexpr size_t WS_TOKA = 172 * MiB;
constexpr size_t WS_S = 173 * MiB;
constexpr size_t WS_ZC = WS_S;
constexpr size_t WS_ZR = WS_S + 32 * MiB;
constexpr size_t WS_ZG = WS_S + 88 * MiB;
constexpr size_t WS_CQ = WS_S;
constexpr size_t WS_CG = WS_S + 16 * MiB;
constexpr size_t WS_CH = WS_S + 32 * MiB;
constexpr int ZCW = 1024, ZRW = 1792, ZGW = 2048;
static_assert(WS_ZR == WS_ZC + (size_t)NB * SEQ * 1024 * 2 && WS_ZG == WS_ZR + (size_t)NB * SEQ * 1792 * 2, "ZC | ZR | ZG adjacent");
constexpr size_t WS_LIN = WS_S + 152 * MiB;
constexpr size_t WS_LOUT = WS_S + 160 * MiB;
constexpr size_t WS_SR = WS_S + 208 * MiB;
constexpr size_t WS_SKP = WS_SR + 16 * MiB, WS_SV = WS_SR + 32 * MiB, WS_SKKN = WS_SR + 48 * MiB, WS_SKA = WS_SR + 64 * MiB;
constexpr size_t WS_SDEC = WS_SR + 80 * MiB;
constexpr size_t WS_YS = WS_SDEC + 32 * MiB;
constexpr size_t WS_UC = WS_S + 352 * MiB;
constexpr size_t WS_YG = WS_UC;
constexpr size_t WS_MERGED = WS_SKKN;
constexpr size_t WS_Y = WS_SDEC;
constexpr size_t WS_ACT = WS_S;
constexpr size_t WS_YEXP = WS_S + 74 * MiB;
constexpr size_t WS_YSH = WS_S + 330 * MiB;
static_assert(WS_YSH == WS_YEXP + (size_t)M * TOPK * D * 2, "YSH follows YEXP");
constexpr size_t WS_END = WS_S + 384 * MiB;
constexpr int CW_BAR = 4096;
constexpr int CW_CNT = 16384;
constexpr int RING_BYTES = 131072, LDS_TAB_OFF = RING_BYTES, LDS_TAB_BYTES = 11264, LDS_ROWTAB_OFF = LDS_TAB_OFF + LDS_TAB_BYTES, LDS_GWTAB_OFF = LDS_ROWTAB_OFF + 2048, MISC_OFF = LDS_GWTAB_OFF + 2048, LDS_BYTES = 147456;
static_assert(MISC_OFF + 256 <= LDS_BYTES, "lds");

__device__ __forceinline__ unsigned f2bf(float f) { unsigned u = __builtin_bit_cast(unsigned, f); return (u + 0x7fffu + ((u >> 16) & 1u)) >> 16; }
typedef __bf16 bf16x2_t __attribute__((ext_vector_type(2)));
__device__ __forceinline__ unsigned pk2(float lo, float hi) { const f32x2 f = {lo, hi}; return __builtin_bit_cast(unsigned, __builtin_convertvector(f, bf16x2_t)); }
__device__ __forceinline__ float bf2f(unsigned b) { return __builtin_bit_cast(float, b << 16); }
__device__ __forceinline__ float bflo(unsigned w) { return __builtin_bit_cast(float, w << 16); }
__device__ __forceinline__ float bfhi(unsigned w) { return __builtin_bit_cast(float, w & 0xffff0000u); }
__device__ __forceinline__ float sigmoidf_(float x) { return __builtin_amdgcn_rcpf(1.0f + __expf(-x)); }
__device__ __forceinline__ float siluf_(float x) { return x * __builtin_amdgcn_rcpf(1.0f + __expf(-x)); }
__device__ __forceinline__ float wave_sum(float v) {
#pragma unroll
    for (int o = 1; o < 64; o <<= 1) v += __shfl_xor(v, o);
    return v;
}

namespace pg8 {
constexpr int BM = 256, BK = 64, HALF = 128, HTB = HALF * BK * 2, STAGE_BYTES = 8 * HTB, NXCD = 8, WGM = 8;
__host__ __device__ __forceinline__ int lds_byte(int r, int c) { const int st = (r >> 4) * 2 + (c >> 5), rr = r & 15, cc = c & 31, ob = rr * 64 + cc * 2; return st * 1024 + (ob ^ (((ob >> 9) & 1) << 5)); }
__host__ __device__ __forceinline__ void stage_rc(int b, int& R, int& C) { const int st = b / 1024, sb = b % 1024, swz = sb ^ (((sb >> 9) & 1) << 5); R = (st >> 1) * 16 + swz / 64; C = (st & 1) * 32 + (swz % 64) / 2; }
__host__ __device__ __forceinline__ int perm32(int rho) { const int n = rho >> 4, i = rho & 15; return 8 * (i >> 2) + 4 * n + (i & 3); }

struct Unit { int a0, b0, o0, oc0, nrows, e, x0; };
struct Gemm { const bf16* A; const bf16* Bt; int K; const int* list; };

struct StaticOrder {
    int nM, nN, nwg, G, c;
    __device__ void init(int M_, int N_, int G_, int c_) { nM = M_ / BM; nN = N_ / BM; nwg = nM * nN; G = G_; c = c_; }
    __device__ bool next(int i, Unit& u) const {
        const long L = (long)i * G + c; if (L >= nwg) return false;
        int wgid = (int)L; { const int q = nwg / NXCD, r = nwg % NXCD, xcd = wgid % NXCD, off = wgid / NXCD; wgid = (xcd < r ? xcd * (q + 1) : r * (q + 1) + (xcd - r) * q) + off; }
        const int nig = WGM * nN, gid = wgid / nig, fm = gid * WGM, gsz = (nM - fm) < WGM ? (nM - fm) : WGM;
        const int pm = fm + ((wgid % nig) % gsz), pn = (wgid % nig) / gsz;
        u.a0 = pm * BM; u.b0 = pn * BM; u.o0 = pm * BM; u.oc0 = pn * BM; u.nrows = BM; u.e = 0; u.x0 = 0; return true;
    }
};

__device__ __forceinline__ unsigned cvt_pk_bf16(float lo, float hi) { unsigned r; asm volatile("v_cvt_pk_bf16_f32 %0, %1, %2" : "=v"(r) : "v"(lo), "v"(hi)); return r; }

struct EpiF32 {
    static constexpr bool PERM = false, HAS_MID = false;
    float* C; int ldc;
    __device__ __forceinline__ void operator()(const f32x4 (&acc)[2][2][4][2], const Unit& u, int wr, int wc, int fr, int fq) const {
        const int row0 = wr * 64 + fr, col0 = u.oc0 + wc * 32 + 4 * fq;
#pragma unroll
        for (int ai = 0; ai < 2; ++ai)
#pragma unroll
            for (int m = 0; m < 4; ++m) { const int r = row0 + ai * HALF + m * 16; if (r < u.nrows) { float* rowp = C + (size_t)(u.o0 + r) * ldc + col0;
#pragma unroll
                for (int bj = 0; bj < 2; ++bj)
#pragma unroll
                    for (int n = 0; n < 2; ++n) *(f32x4*)(rowp + bj * HALF + n * 16) = acc[ai][bj][m][n]; } }
    }
};
struct EpiBf16 {
    static constexpr bool PERM = true, HAS_MID = false;
    bf16* O; int ldc;
    __device__ __forceinline__ void operator()(const f32x4 (&acc)[2][2][4][2], const Unit& u, int wr, int wc, int fr, int fq) const {
        const int row0 = wr * 64 + fr, col0 = u.oc0 + wc * 32 + 8 * fq;
#pragma unroll
        for (int ai = 0; ai < 2; ++ai)
#pragma unroll
            for (int m = 0; m < 4; ++m) { const int r = row0 + ai * HALF + m * 16; if (r < u.nrows) { bf16* rowp = O + (size_t)(u.o0 + r) * ldc + col0;
#pragma unroll
                for (int bj = 0; bj < 2; ++bj) { const f32x4 v0 = acc[ai][bj][m][0], v1 = acc[ai][bj][m][1];
                    v4u w; w.x = cvt_pk_bf16(v0[0], v0[1]); w.y = cvt_pk_bf16(v0[2], v0[3]); w.z = cvt_pk_bf16(v1[0], v1[1]); w.w = cvt_pk_bf16(v1[2], v1[3]);
                    *(v4u*)(rowp + bj * HALF) = w; } } }
    }
};
struct EpiZ {
    static constexpr bool PERM = true, HAS_MID = false;
    bf16* ZC;
    __device__ __forceinline__ void operator()(const f32x4 (&acc)[2][2][4][2], const Unit& u, int wr, int wc, int fr, int fq) const {
        const int seg = (u.oc0 < 1024) ? 0 : (u.oc0 < 2816) ? 1 : 2;
        const int ldc = (seg == 0) ? 1024 : (seg == 1) ? 1792 : 2048, c0 = u.oc0 - ((seg == 0) ? 0 : (seg == 1) ? 1024 : 2816);
        bf16* O = ZC + ((seg == 0) ? (size_t)0 : (seg == 1) ? (size_t)M * 1024 : (size_t)M * (1024 + 1792));
        const int row0 = u.o0 + wr * 64 + fr, col0 = c0 + wc * 32 + 8 * fq;
#pragma unroll
        for (int ai = 0; ai < 2; ++ai)
#pragma unroll
            for (int m = 0; m < 4; ++m) { bf16* rowp = O + (size_t)(row0 + ai * HALF + m * 16) * ldc + col0;
#pragma unroll
                for (int bj = 0; bj < 2; ++bj) { const f32x4 v0 = acc[ai][bj][m][0], v1 = acc[ai][bj][m][1];
                    v4u w; w.x = cvt_pk_bf16(v0[0], v0[1]); w.y = cvt_pk_bf16(v0[2], v0[3]); w.z = cvt_pk_bf16(v1[0], v1[1]); w.w = cvt_pk_bf16(v1[2], v1[3]);
                    *(v4u*)(rowp + bj * HALF) = w; } }
    }
};
template <bool FIRST> struct EpiMerge {
    static constexpr bool PERM = true, HAS_MID = false;
    bf16* O; const bf16* Z; int gcol0;
    __device__ __forceinline__ void operator()(const f32x4 (&acc)[2][2][4][2], const Unit& u, int wr, int wc, int fr, int fq) const {
        const int row0 = u.o0 + wr * 64 + fr, col0 = u.oc0 + wc * 32 + 8 * fq;
#pragma unroll
        for (int ai = 0; ai < 2; ++ai)
#pragma unroll
            for (int m = 0; m < 4; ++m) { const int r = row0 + ai * HALF + m * 16; bf16* rowp = O + (size_t)r * D + col0; const bf16* zp = Z + (size_t)r * 2048 + gcol0 + col0;
#pragma unroll
                for (int bj = 0; bj < 2; ++bj) { const v4u g = *(const v4u*)(zp + bj * HALF); const f32x4 a0 = acc[ai][bj][m][0], a1 = acc[ai][bj][m][1];
                    float o[8];
                    o[0] = a0[0] * sigmoidf_(bflo(g.x)); o[1] = a0[1] * sigmoidf_(bfhi(g.x)); o[2] = a0[2] * sigmoidf_(bflo(g.y)); o[3] = a0[3] * sigmoidf_(bfhi(g.y));
                    o[4] = a1[0] * sigmoidf_(bflo(g.z)); o[5] = a1[1] * sigmoidf_(bfhi(g.z)); o[6] = a1[2] * sigmoidf_(bflo(g.w)); o[7] = a1[3] * sigmoidf_(bfhi(g.w));
                    if (!FIRST) { const v4u p = *(const v4u*)(rowp + bj * HALF);
                        o[0] += bflo(p.x); o[1] += bfhi(p.x); o[2] += bflo(p.y); o[3] += bfhi(p.y); o[4] += bflo(p.z); o[5] += bfhi(p.z); o[6] += bflo(p.w); o[7] += bfhi(p.w); }
                    v4u w; w.x = cvt_pk_bf16(o[0], o[1]); w.y = cvt_pk_bf16(o[2], o[3]); w.z = cvt_pk_bf16(o[4], o[5]); w.w = cvt_pk_bf16(o[6], o[7]);
                    *(v4u*)(rowp + bj * HALF) = w; } }
    }
};
struct EpiMerge2 {
    static constexpr bool PERM = true, HAS_MID = true;
    bf16* O; const bf16* ZG;
    __device__ __forceinline__ void mid(f32x4 (&acc)[2][2][4][2], const Unit& u, int wr, int wc, int fr, int fq) const {
        const int row0 = u.o0 + wr * 64 + fr, col0 = u.oc0 + wc * 32 + 8 * fq;
#pragma unroll
        for (int ai = 0; ai < 2; ++ai)
#pragma unroll
            for (int m = 0; m < 4; ++m) { const bf16* zp = ZG + (size_t)(row0 + ai * HALF + m * 16) * 2048 + col0;
#pragma unroll
                for (int bj = 0; bj < 2; ++bj) { const v4u g1 = *(const v4u*)(zp + bj * HALF), g2 = *(const v4u*)(zp + 1024 + bj * HALF);
#define RT_(a, b) ((1.0f + __expf(-(b))) * __builtin_amdgcn_rcpf(1.0f + __expf(-(a))))
                    acc[ai][bj][m][0][0] *= RT_(bflo(g1.x), bflo(g2.x)); acc[ai][bj][m][0][1] *= RT_(bfhi(g1.x), bfhi(g2.x)); acc[ai][bj][m][0][2] *= RT_(bflo(g1.y), bflo(g2.y)); acc[ai][bj][m][0][3] *= RT_(bfhi(g1.y), bfhi(g2.y));
                    acc[ai][bj][m][1][0] *= RT_(bflo(g1.z), bflo(g2.z)); acc[ai][bj][m][1][1] *= RT_(bfhi(g1.z), bfhi(g2.z)); acc[ai][bj][m][1][2] *= RT_(bflo(g1.w), bflo(g2.w)); acc[ai][bj][m][1][3] *= RT_(bfhi(g1.w), bfhi(g2.w));
#undef RT_
                } }
    }
    __device__ __forceinline__ void operator()(const f32x4 (&acc)[2][2][4][2], const Unit& u, int wr, int wc, int fr, int fq) const {
        const int row0 = u.o0 + wr * 64 + fr, col0 = u.oc0 + wc * 32 + 8 * fq;
#pragma unroll
        for (int ai = 0; ai < 2; ++ai)
#pragma unroll
            for (int m = 0; m < 4; ++m) { const int r = row0 + ai * HALF + m * 16; bf16* rowp = O + (size_t)r * D + col0; const bf16* zp = ZG + (size_t)r * 2048 + 1024 + col0;
#pragma unroll
                for (int bj = 0; bj < 2; ++bj) { const v4u g = *(const v4u*)(zp + bj * HALF); const f32x4 a0 = acc[ai][bj][m][0], a1 = acc[ai][bj][m][1];
                    v4u w; w.x = cvt_pk_bf16(a0[0] * sigmoidf_(bflo(g.x)), a0[1] * sigmoidf_(bfhi(g.x))); w.y = cvt_pk_bf16(a0[2] * sigmoidf_(bflo(g.y)), a0[3] * sigmoidf_(bfhi(g.y)));
                    w.z = cvt_pk_bf16(a1[0] * sigmoidf_(bflo(g.z)), a1[1] * sigmoidf_(bfhi(g.z))); w.w = cvt_pk_bf16(a1[2] * sigmoidf_(bflo(g.w)), a1[3] * sigmoidf_(bfhi(g.w)));
                    *(v4u*)(rowp + bj * HALF) = w; } }
    }
};
struct EpiSwiGLU {
    static constexpr bool PERM = true, HAS_MID = false;
    bf16* O;
    __device__ __forceinline__ void operator()(const f32x4 (&acc)[2][2][4][2], const Unit& u, int wr, int wc, int fr, int fq) const {
        const int row0 = wr * 64 + fr, col0 = (u.oc0 >> 1) + wc * 32 + 8 * fq;
#pragma unroll
        for (int ai = 0; ai < 2; ++ai)
#pragma unroll
            for (int m = 0; m < 4; ++m) { const int r = row0 + ai * HALF + m * 16; if (r < u.nrows) { bf16* rowp = O + (size_t)(u.o0 + r) * DE + col0;
                const f32x4 g0 = acc[ai][0][m][0], g1 = acc[ai][0][m][1], u0 = acc[ai][1][m][0], u1 = acc[ai][1][m][1];
                v4u w; w.x = cvt_pk_bf16(siluf_(g0[0]) * u0[0], siluf_(g0[1]) * u0[1]); w.y = cvt_pk_bf16(siluf_(g0[2]) * u0[2], siluf_(g0[3]) * u0[3]);
                w.z = cvt_pk_bf16(siluf_(g1[0]) * u1[0], siluf_(g1[1]) * u1[1]); w.w = cvt_pk_bf16(siluf_(g1[2]) * u1[2], siluf_(g1[3]) * u1[3]);
                *(v4u*)rowp = w; } }
    }
};

constexpr int ROWTAB_OFF = 131072 + 11264, GWTAB_OFF = ROWTAB_OFF + 2048;
template <class Epi, class Sched, bool GATHER>
__device__ __forceinline__ void gemm_phase(LAS unsigned char* lds, const int tid, const Gemm g, const Sched& S, const Epi& E) {
    const int wid = __builtin_amdgcn_readfirstlane(tid >> 6), lane = tid & 63, wr = wid >> 2, wc = wid & 3, fr = lane & 15, fq = lane >> 4;
    const int K = g.K, nt = K / BK;
    int sR, sC; stage_rc(tid * 16, sR, sC);
    const unsigned voffA = (unsigned)(sR * K + sC) * 2u;
    const unsigned voffB = (unsigned)((Epi::PERM ? ((sR & ~31) + perm32(sR & 31)) : sR) * K + sC) * 2u;
    const size_t kstep = (size_t)(BK * 2);
    const size_t pstep = (size_t)64 * K * 2;
    const size_t hstep = (size_t)HALF * K * 2;
    const unsigned ldsw = (unsigned)wid * 1024u;
    const int aoff = lds_byte(wr * 64 + fr, fq * 8), boff = lds_byte(wc * 32 + fr, fq * 8);
    LAS unsigned* rowtab = (LAS unsigned*)(lds + ROWTAB_OFF);
#define PG8_SA(b, h) (((b) * 2 + (h)) * HTB)
#define PG8_SB(b, h) ((4 + (b) * 2 + (h)) * HTB)
#define PG8_STAGE(bufoff, gbase, voff) do { _Pragma("unroll") for (int _i = 0; _i < 2; ++_i) { const char* _gb = (const char*)(gbase) + _i * pstep; asm volatile("" : "+s"(_gb));   \
        __builtin_amdgcn_global_load_lds((const unsigned*)(_gb + (voff)), (LAS unsigned*)(lds + (bufoff) + ldsw + _i * 8192), 16, 0, 0); } } while (0)
#define PG8_STAGE_G(bufoff, kb, sel, h) do { _Pragma("unroll") for (int _i = 0; _i < 2; ++_i) { const unsigned _ro = rowtab[(sel) * 256 + (h) * HALF + sR + 64 * _i] + (unsigned)(sC * 2); const char* _gb = (const char*)(kb); asm volatile("" : "+s"(_gb)); \
        __builtin_amdgcn_global_load_lds((const unsigned*)(_gb + _ro), (LAS unsigned*)(lds + (bufoff) + ldsw + _i * 8192), 16, 0, 0); } } while (0)
#define PG8_STAGE_A(bufoff, basep, kb, sel, h) do { if constexpr (GATHER) PG8_STAGE_G(bufoff, (const char*)g.A + (kb), sel, h); else PG8_STAGE(bufoff, (basep) + (kb) + (h) * hstep, voffA); } while (0)
#define PG8_ROWTAB(sel, u) do { if (tid < 256) { const int _rr = tid < (u).nrows ? tid : (u).nrows - 1; rowtab[(sel) * 256 + tid] = (unsigned)g.list[(u).x0 + _rr] * (unsigned)(K * 2); } } while (0)
#define PG8_LDA(dst, b, h) do { _Pragma("unroll") for (int m = 0; m < 4; ++m) _Pragma("unroll") for (int k = 0; k < 2; ++k) dst[m][k] = *(const LAS bf16x8*)(lds + PG8_SA(b, h) + aoff + m * 2048 + k * 1024); } while (0)
#define PG8_LDB(dst, b, h) do { _Pragma("unroll") for (int n = 0; n < 2; ++n) _Pragma("unroll") for (int k = 0; k < 2; ++k) dst[n][k] = *(const LAS bf16x8*)(lds + PG8_SB(b, h) + boff + n * 2048 + k * 1024); } while (0)
#define PG8_MMA(ai, bj, At, Bt) do { __builtin_amdgcn_s_setprio(1); _Pragma("unroll") for (int m = 0; m < 4; ++m) _Pragma("unroll") for (int n = 0; n < 2; ++n) _Pragma("unroll") for (int k = 0; k < 2; ++k) \
        acc[ai][bj][m][n] = __builtin_amdgcn_mfma_f32_16x16x32_bf16(Bt[n][k], At[m][k], acc[ai][bj][m][n], 0, 0, 0); __builtin_amdgcn_s_setprio(0); } while (0)
#define PG8_WAIT_V(n) asm volatile("s_waitcnt vmcnt(" #n ")" ::: "memory")
#define PG8_WAIT_L(n) asm volatile("s_waitcnt lgkmcnt(" #n ")" ::: "memory")
#define PG8_BAR __builtin_amdgcn_s_barrier()
#define PG8_SCHED __builtin_amdgcn_sched_barrier(0)
    Unit cur, nxt; int ui = 0;
    if (!S.next(0, cur)) return;
    f32x4 acc[2][2][4][2];
#pragma unroll
    for (int a = 0; a < 2; ++a)
#pragma unroll
        for (int b = 0; b < 2; ++b)
#pragma unroll
            for (int m = 0; m < 4; ++m)
#pragma unroll
                for (int n = 0; n < 2; ++n) acc[a][b][m][n] = (f32x4){0.f, 0.f, 0.f, 0.f};
    bf16x8 At[4][2], B0[2][2], B1[2][2];
    int par = 0;
    if constexpr (GATHER) { PG8_ROWTAB(0, cur); asm volatile("s_waitcnt vmcnt(0) lgkmcnt(0)" ::: "memory"); __syncthreads(); }
    const char* cA = (const char*)g.A + (size_t)cur.a0 * K * 2;
    const char* cB = (const char*)g.Bt + (size_t)cur.b0 * K * 2;
    PG8_STAGE(PG8_SB(0, 0), cB, voffB); PG8_STAGE(PG8_SB(0, 1), cB + hstep, voffB); PG8_STAGE_A(PG8_SA(0, 0), cA, 0, 0, 0); PG8_STAGE_A(PG8_SA(0, 1), cA, 0, 0, 1);
    if (wr == 1) PG8_BAR;
    PG8_WAIT_V(2); PG8_BAR;
    PG8_STAGE(PG8_SB(1, 0), cB + kstep, voffB); PG8_STAGE_A(PG8_SA(1, 0), cA, kstep, 0, 0); PG8_STAGE(PG8_SB(1, 1), cB + hstep + kstep, voffB);
    PG8_WAIT_V(6); PG8_BAR;
    for (;;) {
        const bool has_next = S.next(ui + 1, nxt);
        if constexpr (GATHER) { if (has_next) { PG8_ROWTAB(par ^ 1, nxt); asm volatile("s_waitcnt vmcnt(0) lgkmcnt(0)" ::: "memory"); } }
        const char* nA = has_next ? (const char*)g.A + (size_t)nxt.a0 * K * 2 : cA;
        const char* nB = has_next ? (const char*)g.Bt + (size_t)nxt.b0 * K * 2 : cB;
        const int npar = has_next ? (par ^ 1) : par;
        for (int t = 0; t < nt; t += 2) {
            if constexpr (Epi::HAS_MID) { if (t == nt / 2) E.mid(acc, cur, wr, wc, fr, fq); }
            const bool last = (t == nt - 2);
            const size_t k1 = (size_t)(t + 1) * kstep;
            const char* a2 = last ? nA : cA; const size_t k2 = last ? 0 : (size_t)(t + 2) * kstep; const char* b2 = last ? nB : cB + (size_t)(t + 2) * kstep;
            const size_t k3 = k2 + kstep; const char* b3 = b2 + kstep;
            const int p2 = last ? npar : par;
            PG8_LDB(B0, 0, 0); PG8_LDB(B1, 0, 1); PG8_SCHED; PG8_LDA(At, 0, 0); PG8_STAGE_A(PG8_SA(1, 1), cA, k1, par, 1);
            PG8_WAIT_V(8); PG8_WAIT_L(0); PG8_BAR; PG8_MMA(0, 0, At, B0); PG8_MMA(0, 1, At, B1); PG8_BAR; PG8_SCHED;
            PG8_LDA(At, 0, 1); PG8_STAGE(PG8_SB(0, 0), b2, voffB); PG8_STAGE(PG8_SB(0, 1), b2 + hstep, voffB); PG8_STAGE_A(PG8_SA(0, 0), a2, k2, p2, 0);
            PG8_WAIT_V(8); PG8_WAIT_L(0); PG8_BAR; PG8_MMA(1, 0, At, B0); PG8_MMA(1, 1, At, B1); PG8_BAR; PG8_SCHED;
            PG8_LDB(B0, 1, 0); PG8_LDB(B1, 1, 1); PG8_SCHED; PG8_LDA(At, 1, 0); PG8_STAGE_A(PG8_SA(0, 1), a2, k2, p2, 1);
            PG8_WAIT_V(8); PG8_WAIT_L(0); PG8_BAR; PG8_MMA(0, 0, At, B0); PG8_MMA(0, 1, At, B1); PG8_BAR; PG8_SCHED;
            PG8_LDA(At, 1, 1); PG8_STAGE(PG8_SB(1, 0), b3, voffB); PG8_STAGE(PG8_SB(1, 1), b3 + hstep, voffB); PG8_STAGE_A(PG8_SA(1, 0), a2, k3, p2, 0);
            PG8_WAIT_V(8); PG8_WAIT_L(0); PG8_BAR; PG8_MMA(1, 0, At, B0); PG8_MMA(1, 1, At, B1); PG8_BAR; PG8_SCHED;
        }
        if (wr == 0) PG8_BAR;
        E(acc, cur, wr, wc, fr, fq);
        if (!has_next) break;
#pragma unroll
        for (int a = 0; a < 2; ++a)
#pragma unroll
            for (int b = 0; b < 2; ++b)
#pragma unroll
                for (int m = 0; m < 4; ++m)
#pragma unroll
                    for (int n = 0; n < 2; ++n) acc[a][b][m][n] = (f32x4){0.f, 0.f, 0.f, 0.f};
        cur = nxt; cA = nA; cB = nB; par = npar; ++ui;
        if (wr == 1) PG8_BAR;
    }
    PG8_WAIT_V(0);
    PG8_BAR;
#undef PG8_SA
#undef PG8_SB
#undef PG8_STAGE
#undef PG8_STAGE_G
#undef PG8_STAGE_A
#undef PG8_ROWTAB
#undef PG8_LDA
#undef PG8_LDB
#undef PG8_MMA
#undef PG8_WAIT_V
#undef PG8_WAIT_L
#undef PG8_BAR
#undef PG8_SCHED
}
}

#define XB_TMO      128
#define XB_XCNT(j)  (256  + 64 * (j))
#define XB_XSUB(j)  (1280 + 64 * (j))
#define XB_XGEN(j)  (2304 + 64 * (j))
#define XB_TOP      3328
#define XB_TOPGEN   3392
#define XCD_BAR_WORDS 3456
#define XB_SPIN_CAP (1u << 18)
__device__ __forceinline__ unsigned xb_ld(unsigned* p)              { return __hip_atomic_load(p, __ATOMIC_RELAXED, __HIP_MEMORY_SCOPE_AGENT); }
__device__ __forceinline__ unsigned xb_add(unsigned* p, unsigned v) { return __hip_atomic_fetch_add(p, v, __ATOMIC_RELAXED, __HIP_MEMORY_SCOPE_AGENT); }
__device__ __forceinline__ unsigned xb_xcc_id() { return (unsigned)__builtin_amdgcn_s_getreg((3 << 11) | 20) & 0xFu; }
#define XB_SPIN(cond, bar) do { unsigned _sp = 0; while (cond) { __builtin_amdgcn_s_sleep(1); \
    if ((++_sp & 255u) == 0u) { if (xb_ld(&(bar)[XB_TMO])) break; if (_sp > XB_SPIN_CAP) { atomicAdd(&(bar)[XB_TMO], 1u); break; } } } } while (0)
struct XcdBarrier { unsigned* bar; unsigned x; volatile LAS unsigned* st; };
__device__ __forceinline__ XcdBarrier xcd_barrier_post(unsigned* bar, volatile LAS unsigned* st) {
    XcdBarrier b; b.bar = bar; b.x = xb_xcc_id(); b.st = st;
    if (threadIdx.x == 0) (void)xb_add(&bar[XB_XCNT(b.x)], 1u);
    return b;
}
__device__ __forceinline__ void xcd_barrier_complete(unsigned* bar, unsigned x, unsigned& nloc, unsigned& nx) {
    const unsigned G = gridDim.x * gridDim.y * gridDim.z;
    unsigned sum, cnt, mine, sp = 0u;
    for (;;) {
        sum = 0u; cnt = 0u; mine = 0u;
#pragma unroll
        for (unsigned j = 0; j < 16; ++j) { const unsigned c = xb_ld(&bar[XB_XCNT(j)]); sum += c; cnt += (c > 0u) ? 1u : 0u; mine = (j == x) ? c : mine; }
        if (sum == G) break;
        __builtin_amdgcn_s_sleep(1);
        if ((++sp & 255u) == 0u) { if (xb_ld(&bar[XB_TMO])) break; if (sp > XB_SPIN_CAP) { atomicAdd(&bar[XB_TMO], 1u); break; } }
    }
    nloc = mine > 0u ? mine : 1u; nx = cnt > 0u ? cnt : 1u;
}
__device__ __forceinline__ void xcd_barrier(const XcdBarrier& b, const int tid) {
    asm volatile("s_waitcnt vmcnt(0)" ::: "memory");
    __syncthreads();
    if (tid == 0) {
        unsigned* bar = b.bar;
        __builtin_amdgcn_s_waitcnt(0);
        unsigned nloc = b.st[0], nx = b.st[1];
        if (nloc == 0u) { xcd_barrier_complete(bar, b.x, nloc, nx); b.st[0] = nloc; b.st[1] = nx; }
        const unsigned old = xb_add(&bar[XB_XSUB(b.x)], 1u);
        const unsigned gen = old / nloc;
        if (old + 1u == (gen + 1u) * nloc) {
            __builtin_amdgcn_fence(__ATOMIC_RELEASE, "agent");
            asm volatile("s_waitcnt vmcnt(0)" ::: "memory");
            const unsigned og = xb_add(&bar[XB_TOP], 1u);
            const unsigned tg = og / nx;
            if (og + 1u == (tg + 1u) * nx) xb_add(&bar[XB_TOPGEN], 1u);
            else XB_SPIN(xb_ld(&bar[XB_TOPGEN]) == tg, bar);
            __builtin_amdgcn_fence(__ATOMIC_ACQUIRE, "agent");
            xb_add(&bar[XB_XGEN(b.x)], 1u);
            asm volatile("s_waitcnt vmcnt(0)" ::: "memory");
        } else {
            XB_SPIN(xb_ld(&bar[XB_XGEN(b.x)]) == gen, bar);
            __builtin_amdgcn_fence(__ATOMIC_ACQUIRE, "agent");
            asm volatile("s_waitcnt vmcnt(0)" ::: "memory");
        }
    }
    __syncthreads();
}

struct Args { const float* in[N_IN]; float* out; unsigned char* ws; int ph_lo, ph_hi; };
struct Frame {
    LAS unsigned char* lds;
    int tid, lane, wave, G, bid;
    const float* const __attribute__((address_space(4)))* in; float* out; unsigned char* ws;
};
__device__ __forceinline__ const float* mod_ptr(const Frame& F, int l, int b, int part) { return (const float*)(F.ws + WS_MOD) + ((size_t)(l * NB + b) * 6 + part) * D; }

__device__ __forceinline__ void transpose_item(const float* W, int N, int k0, int n0, bf16* WT, int ldo, int drow0, int dcol0, LAS float* scr, int lane) {
    float tv[32];
#pragma unroll
    for (int i = 0; i < 32; ++i) tv[i] = W[(size_t)(k0 + 2 * i + (lane >> 5)) * N + n0 + (lane & 31)];
#pragma unroll
    for (int i = 0; i < 32; ++i) scr[(2 * i + (lane >> 5)) * 33 + (lane & 31)] = tv[i];
    LDS_WAIT(); asm volatile("" ::: "memory");
    const int c = lane & 7;
#pragma unroll
    for (int j = 0; j < 4; ++j) { const int n = (lane >> 3) + 8 * j; const LAS float* s = scr + (8 * c) * 33 + n;
        v4u o; o.x = pk2(s[0 * 33], s[1 * 33]); o.y = pk2(s[2 * 33], s[3 * 33]); o.z = pk2(s[4 * 33], s[5 * 33]); o.w = pk2(s[6 * 33], s[7 * 33]);
        *(GAS v4u*)(WT + (size_t)(drow0 + n) * ldo + dcol0 + k0 + 8 * c) = o; }
    LDS_WAIT(); asm volatile("" ::: "memory");
}
__device__ __forceinline__ int titems(int K, int N) { return (K / 64) * (N / 32); }
__device__ __forceinline__ void tdo(const float* W, int K, int N, int item, bf16* WT, int ldo, int drow0, LAS float* scr, int lane) {
    const int nblk = N / 32, kb = item / nblk, nb = item % nblk; transpose_item(W, N, 64 * kb, 32 * nb, WT, ldo, drow0 + 32 * nb, 0, scr, lane);
}

__device__ __forceinline__ void phase_mix_weights(Frame& F, int gw, int NGW) {
    LAS float* scr = (LAS float*)(F.lds + 65536 + F.wave * 8704);
    constexpr int T_WIN = (D / 64) * (DIN / 32), T_PC = (CW / 64) * (D / 32), T_PR = (RW / 64) * (D / 32), T_WO = (D / 64) * (D / 32), T_L = T_WIN + T_PC + T_PR + T_WO;
    for (int it = gw; it < DEPTH * T_L; it += NGW) {
        const int l = it / T_L; int r = it % T_L; unsigned char* wm = F.ws + WS_WMIX + (size_t)l * WMIX_STRIDE;
        if (r < T_WIN) { tdo(F.in[I_WIN] + (size_t)l * D * DIN, D, DIN, r, (bf16*)(wm + WM_WIN), D, 0, scr, F.lane); continue; } r -= T_WIN;
        if (r < T_PC) { tdo(F.in[I_PCONV] + (size_t)l * CW * D, CW, D, r, (bf16*)(wm + WM_PCONV), D, 0, scr, F.lane); continue; } r -= T_PC;
        if (r < T_PR) { tdo(F.in[I_PRWKV] + (size_t)l * RW * D, RW, D, r, (bf16*)(wm + WM_PCONV) + CW, D, 0, scr, F.lane); continue; } r -= T_PR;
        tdo(F.in[I_WO] + (size_t)l * D * D, D, D, r, (bf16*)(wm + WM_WO), D, 0, scr, F.lane);
    }
    for (int i = gw * 64 + F.lane; i < DEPTH * NLORA * KLORA; i += NGW * 64) {
        const int l = i / (NLORA * KLORA), r = i % (NLORA * KLORA), n = r / KLORA, k = r % KLORA; float v = 0.f;
        if (n < 512) { if (k < 64) v = F.in[I_W2][((size_t)l * LW + k) * RW + n]; }
        else if (n < 1024) { if (k >= 64 && k < 128) v = F.in[I_A2][((size_t)l * LA + (k - 64)) * RW + (n - 512)]; }
        else { if (k >= 128) v = F.in[I_G2][((size_t)l * LG + (k - 128)) * RW + (n - 1024)]; }
        ((bf16*)(F.ws + WS_WMIX + (size_t)l * WMIX_STRIDE + WM_LORA))[r] = (bf16)f2bf(v);
    }
}
__device__ __forceinline__ void phase_expert_weights(Frame& F, int l, int gw, int NGW) {
    LAS float* scr = (LAS float*)(F.lds + 65536 + F.wave * 8704);
    bf16* WGU = (bf16*)(F.ws + WS_WGU); bf16* WDN = (bf16*)(F.ws + WS_WDN);
    constexpr int T_G = (D / 64) * (DE / 32), T_D = (DE / 64) * (D / 32), T_E = 2 * T_G + T_D;
    for (int it = gw; it < (NE + 1) * T_E; it += NGW) {
        const int e = it / T_E; int r = it % T_E;
        if (r < 2 * T_G) { const int up = r >= T_G; if (up) r -= T_G;
            const float* W = (e < NE) ? (up ? F.in[I_WEU] : F.in[I_WEG]) + ((size_t)l * NE + e) * D * DE : (up ? F.in[I_WSU] : F.in[I_WSG]) + (size_t)l * D * DE;
            const int nblk = DE / 32, kb = r / nblk, nb = r % nblk, n0 = 32 * nb;
            const int drow0 = e * 512 + (n0 >> 7) * 256 + (up ? 128 : 0) + (n0 & 127);
            transpose_item(W, DE, 64 * kb, n0, WGU, D, drow0, 0, scr, F.lane);
        } else { r -= 2 * T_G;
            const float* W = (e < NE) ? F.in[I_WED] + ((size_t)l * NE + e) * DE * D : F.in[I_WSD] + (size_t)l * DE * D;
            tdo(W, DE, D, r, WDN, DE, e * D, scr, F.lane);
        }
    }
}
__device__ __forceinline__ void phase_ada(Frame& F) {
    LAS float* sc = (LAS float*)F.lds;
    LAS float* red = (LAS float*)(F.lds + 32768);
    for (int i = F.tid; i < NB * D; i += NTHREADS) { const int b = i / D, k = i % D; sc[k * 8 + b] = siluf_(F.in[I_C][i]); }
    __syncthreads();
    float* mod = (float*)(F.ws + WS_MOD);
    for (int it = F.bid; it < DEPTH * 96; it += F.G) {
        const int l = it / 96, n0 = (it % 96) * 64;
        float acc[8];
#pragma unroll
        for (int b = 0; b < 8; ++b) acc[b] = 0.f;
        const float* wp = F.in[I_WADA] + ((size_t)l * D + F.wave * 128) * (6 * D) + n0 + F.lane;
#pragma unroll 4
        for (int k = 0; k < 128; ++k) { const float wv = wp[(size_t)k * (6 * D)]; const LAS f32x4* s = (const LAS f32x4*)(sc + (F.wave * 128 + k) * 8); const f32x4 s0 = s[0], s1 = s[1];
            acc[0] += s0[0] * wv; acc[1] += s0[1] * wv; acc[2] += s0[2] * wv; acc[3] += s0[3] * wv; acc[4] += s1[0] * wv; acc[5] += s1[1] * wv; acc[6] += s1[2] * wv; acc[7] += s1[3] * wv; }
#pragma unroll
        for (int b = 0; b < 8; ++b) red[(F.wave * 8 + b) * 64 + F.lane] = acc[b];
        __syncthreads();
        { const int b = F.tid >> 6; float s = F.in[I_BADA][(size_t)l * 6 * D + n0 + F.lane];
#pragma unroll
          for (int w = 0; w < 8; ++w) s += red[(w * 8 + b) * 64 + F.lane];
          mod[((size_t)l * NB + b) * 6 * D + n0 + F.lane] = s; }
        __syncthreads();
    }
}

struct Row { f32x4 v[4]; };
__device__ __forceinline__ Row row_load(const float* p, int lane) { Row r; const f32x4* q = (const f32x4*)p + lane;
#pragma unroll
    for (int j = 0; j < 4; ++j) r.v[j] = q[64 * j]; return r; }
__device__ __forceinline__ void row_store(float* p, int lane, const Row& r) { f32x4* q = (f32x4*)p + lane;
#pragma unroll
    for (int j = 0; j < 4; ++j) q[64 * j] = r.v[j]; }
__device__ __forceinline__ float row_sumsq(const Row& r) { float s = 0.f;
#pragma unroll
    for (int j = 0; j < 4; ++j) s += (r.v[j][0] * r.v[j][0] + r.v[j][1] * r.v[j][1]) + (r.v[j][2] * r.v[j][2] + r.v[j][3] * r.v[j][3]); return wave_sum(s); }
__device__ __forceinline__ Row row_modnorm(const Row& x, const float* g, const float* sc, const float* sh, int lane) {
    const float rs = rsqrtf(row_sumsq(x) * (1.0f / D) + RMS_EPS); Row gg = row_load(g, lane), s1 = row_load(sc, lane), s0 = row_load(sh, lane), h;
#pragma unroll
    for (int j = 0; j < 4; ++j) h.v[j] = x.v[j] * rs * gg.v[j] * (1.0f + s1.v[j]) + s0.v[j]; return h; }
__device__ __forceinline__ void row_store_bf16(bf16* p, int lane, const Row& r) { v2u* q = (v2u*)p + lane;
#pragma unroll
    for (int j = 0; j < 4; ++j) { v2u w; w.x = pk2(r.v[j][0], r.v[j][1]); w.y = pk2(r.v[j][2], r.v[j][3]); q[64 * j] = w; } }

__device__ __forceinline__ Row row_load_bf16(const bf16* p, int lane) { Row r; const v2u* q = (const v2u*)p + lane;
#pragma unroll
    for (int j = 0; j < 4; ++j) { const v2u w = q[64 * j]; r.v[j] = (f32x4){bflo(w.x), bfhi(w.x), bflo(w.y), bfhi(w.y)}; } return r; }
__device__ __forceinline__ void phase_rowA(Frame& F, int gw, int NGW) {
    bf16* H = (bf16*)(F.ws + WS_H);
    for (int m = gw; m < M; m += NGW) { const int b = m / SEQ; Row x = row_load(F.in[I_X] + (size_t)m * D, F.lane);
        Row h = row_modnorm(x, F.in[I_NMPRE], mod_ptr(F, 0, b, 1), mod_ptr(F, 0, b, 0), F.lane); row_store_bf16(H + (size_t)m * D, F.lane, h); }
}

__device__ __forceinline__ void phase_conv(Frame& F, int l) {
    const bf16* Z = (const bf16*)(F.ws + WS_ZC); bf16* UC = (bf16*)(F.ws + WS_UC);
    LAS float* tile = (LAS float*)F.lds;
    const int c = F.tid;
    float w[CKW];
#pragma unroll
    for (int j = 0; j < CKW; ++j) w[j] = F.in[I_CONVW][((size_t)l * CKW + j) * CW + c];
    const float bias = F.in[I_CONVB][l * CW + c];
    for (int ti = F.bid; ti < M / 32; ti += F.G) {
        const int t0 = ti * 32, s0 = t0 % SEQ;
        float u[62];
#pragma unroll
        for (int i = 0; i < 62; ++i) { const bool ok = (s0 - 30 + i >= 0); const bf16* zr = Z + (size_t)(ok ? t0 - 30 + i : t0) * ZCW;
            const float a = bf2f(zr[c]), gt_ = bf2f(zr[CW + c]); u[i] = ok ? a * sigmoidf_(gt_) : 0.f; }
#pragma unroll
        for (int o = 0; o < 32; ++o) { float a = bias;
#pragma unroll
            for (int j = 0; j < CKW; ++j) a += u[o + j] * w[j];
            tile[o * CW + c] = a; }
        __syncthreads();
#pragma unroll
        for (int q = 0; q < 4; ++q) { const int o = 4 * F.wave + q; float v[8]; float s = 0.f;
#pragma unroll
            for (int i = 0; i < 8; ++i) { v[i] = tile[o * CW + F.lane + 64 * i]; s += v[i]; }
            const float mean = wave_sum(s) * (1.0f / CW); float s2 = 0.f;
#pragma unroll
            for (int i = 0; i < 8; ++i) { v[i] -= mean; s2 += v[i] * v[i]; }
            const float rstd = rsqrtf(wave_sum(s2) * (1.0f / CW) + LN_EPS);
#pragma unroll
            for (int i = 0; i < 8; ++i) { const int cc = F.lane + 64 * i; const float y = v[i] * rstd * F.in[I_CLNG][l * CW + cc] + F.in[I_CLNB][l * CW + cc];
                UC[(size_t)(t0 + o) * D + cc] = (bf16)f2bf(siluf_(y)); } }
        __syncthreads();
    }
}
__device__ __forceinline__ void phase_prep1(Frame& F, int l, int gw, int NGW) {
    const bf16* Z = (const bf16*)(F.ws + WS_ZR); bf16* LIN = (bf16*)(F.ws + WS_LIN);
    const f32x4 mu = *((const f32x4*)(F.in[I_MU] + (size_t)l * COLR + 1536) + F.lane);
    for (int m = gw; m < M; m += NGW) {
        const int s = m % SEQ; const v2u cur = *((const v2u*)(Z + (size_t)m * ZRW + 1536) + F.lane);
        v2u prv = *((const v2u*)(Z + (size_t)(s > 0 ? m - 1 : m) * ZRW + 1536) + F.lane); if (s == 0) { prv.x = 0u; prv.y = 0u; }
        float x[4] = {bflo(cur.x), bfhi(cur.x), bflo(cur.y), bfhi(cur.y)}; const float p[4] = {bflo(prv.x), bfhi(prv.x), bflo(prv.y), bfhi(prv.y)};
#pragma unroll
        for (int i = 0; i < 4; ++i) { x[i] = x[i] + (p[i] - x[i]) * mu[i]; if (F.lane < 16) x[i] = tanhf(x[i]); else if (F.lane >= 32) x[i] = sigmoidf_(x[i]); }
        v2u o; o.x = pk2(x[0], x[1]); o.y = pk2(x[2], x[3]); *((v2u*)(LIN + (size_t)m * KLORA) + F.lane) = o;
    }
}
__device__ __forceinline__ void ld8bf(const bf16* p, float (&o)[8]) { const v4u w = *(const v4u*)p; o[0] = bflo(w.x); o[1] = bfhi(w.x); o[2] = bflo(w.y); o[3] = bfhi(w.y); o[4] = bflo(w.z); o[5] = bfhi(w.z); o[6] = bflo(w.w); o[7] = bfhi(w.w); }
__device__ __forceinline__ void st8bf(bf16* p, const float (&o)[8]) { v4u w; w.x = pk2(o[0], o[1]); w.y = pk2(o[2], o[3]); w.z = pk2(o[4], o[5]); w.w = pk2(o[6], o[7]); *(v4u*)p = w; }
__device__ __forceinline__ void ld8f(const float* p, float (&o)[8]) { const f32x4 a = *(const f32x4*)p, b = *((const f32x4*)p + 1); o[0] = a[0]; o[1] = a[1]; o[2] = a[2]; o[3] = a[3]; o[4] = b[0]; o[5] = b[1]; o[6] = b[2]; o[7] = b[3]; }
__device__ __forceinline__ float grp8_sum(float v) { v += __shfl_xor(v, 1); v += __shfl_xor(v, 2); v += __shfl_xor(v, 4); return v; }
__device__ __forceinline__ void phase_prep2(Frame& F, int l, int gw, int NGW) {
    const bf16* Z = (const bf16*)(F.ws + WS_ZR); const bf16* LOUT = (const bf16*)(F.ws + WS_LOUT);
    bf16* SR = (bf16*)(F.ws + WS_SR); bf16* SKP = (bf16*)(F.ws + WS_SKP); bf16* SV = (bf16*)(F.ws + WS_SV); bf16* SKKN = (bf16*)(F.ws + WS_SKKN); bf16* SKA = (bf16*)(F.ws + WS_SKA);
    float* SDEC = (float*)(F.ws + WS_SDEC); float* BONUS = (float*)(F.ws + WS_BONUS);
    const int c = 8 * F.lane;
    float mur[8], muk[8], muv[8], w0[8], a0[8], kkw[8], kaw[8], rkw[8];
    ld8f(F.in[I_MU] + (size_t)l * COLR + c, mur); ld8f(F.in[I_MU] + (size_t)l * COLR + 512 + c, muk); ld8f(F.in[I_MU] + (size_t)l * COLR + 1024 + c, muv);
    ld8f(F.in[I_W0] + l * RW + c, w0); ld8f(F.in[I_A0] + l * RW + c, a0); ld8f(F.in[I_KK] + l * RW + c, kkw); ld8f(F.in[I_KA] + l * RW + c, kaw); ld8f(F.in[I_RK] + l * RW + c, rkw);
    for (int m = gw; m < M; m += NGW) {
        const int s = m % SEQ; const bf16* zr = Z + (size_t)m * ZRW + c;
        float r[8], k[8], v[8], pr[8], pk[8], pv[8], lw[8], la[8];
        ld8bf(zr, r); ld8bf(zr + 512, k); ld8bf(zr + 1024, v);
        { const bf16* zp = (s > 0) ? zr - ZRW : zr; ld8bf(zp, pr); ld8bf(zp + 512, pk); ld8bf(zp + 1024, pv); }
        if (s == 0) {
#pragma unroll
            for (int i = 0; i < 8; ++i) { pr[i] = 0.f; pk[i] = 0.f; pv[i] = 0.f; } }
        ld8bf(LOUT + (size_t)m * NLORA + c, lw); ld8bf(LOUT + (size_t)m * NLORA + 512 + c, la);
        float dec[8], kp[8], kk[8], ka[8]; float ss = 0.f, bo = 0.f;
#pragma unroll
        for (int i = 0; i < 8; ++i) {
            r[i] += (pr[i] - r[i]) * mur[i]; k[i] += (pk[i] - k[i]) * muk[i]; v[i] += (pv[i] - v[i]) * muv[i];
            dec[i] = __expf(-0.60653066f * sigmoidf_(w0[i] + lw[i]));
            const float a = sigmoidf_(a0[i] + la[i]);
            kk[i] = k[i] * kkw[i]; kp[i] = k[i] * (1.0f + (a - 1.0f) * kaw[i]); ka[i] = a;
            ss += kk[i] * kk[i]; bo += r[i] * kp[i] * rkw[i];
        }
        ss = grp8_sum(ss); bo = grp8_sum(bo);
        const float inv = rsqrtf(fmaxf(ss, 1e-24f));
#pragma unroll
        for (int i = 0; i < 8; ++i) { kk[i] *= inv; ka[i] *= kk[i]; }
        const size_t o = (size_t)m * RW + c;
        st8bf(SR + o, r); st8bf(SKP + o, kp); st8bf(SV + o, v); st8bf(SKKN + o, kk); st8bf(SKA + o, ka);
        *(f32x4*)(SDEC + o) = (f32x4){dec[0], dec[1], dec[2], dec[3]}; *((f32x4*)(SDEC + o) + 1) = (f32x4){dec[4], dec[5], dec[6], dec[7]};
        if ((F.lane & 7) == 0) BONUS[(size_t)m * NH + (F.lane >> 3)] = bo;
    }
}
__device__ __forceinline__ void phase_scan(Frame& F) {
    const bf16* SR = (const bf16*)(F.ws + WS_SR); const bf16* SKP = (const bf16*)(F.ws + WS_SKP); const bf16* SV = (const bf16*)(F.ws + WS_SV);
    const bf16* SKKN = (const bf16*)(F.ws + WS_SKKN); const bf16* SKA = (const bf16*)(F.ws + WS_SKA); const float* SDEC = (const float*)(F.ws + WS_SDEC);
    float* YS = (float*)(F.ws + WS_YS);
    LAS float* buf = (LAS float*)F.lds;
    const int vr = F.lane >> 3, ke = F.lane & 7, vidx = 8 * F.wave + vr;
    for (int bh = F.bid; bh < NB * NH; bh += F.G) {
        const int b = bh / NH, h = bh % NH; const size_t m0 = (size_t)b * SEQ;
        float S[8];
#pragma unroll
        for (int i = 0; i < 8; ++i) S[i] = 0.f;
        for (int c0 = 0; c0 < SEQ; c0 += 64) {
            __syncthreads();
            for (int idx = F.tid; idx < 64 * 64; idx += NTHREADS) { const int t = idx >> 6, k = idx & 63; const size_t g = (m0 + c0 + t) * RW + h * RH + k; LAS float* d = buf + t * 384 + k;
                d[0] = bf2f(SR[g]); d[64] = SDEC[g]; d[128] = bf2f(SKP[g]); d[192] = bf2f(SKKN[g]); d[256] = bf2f(SKA[g]); d[320] = bf2f(SV[g]); }
            __syncthreads();
            for (int t = 0; t < 64; ++t) {
                const LAS float* d = buf + t * 384 + ke * 8;
                float r[8], dc[8], kp[8], kn[8], ka[8];
#pragma unroll
                for (int i = 0; i < 8; ++i) { r[i] = d[i]; dc[i] = d[64 + i]; kp[i] = d[128 + i]; kn[i] = d[192 + i]; ka[i] = d[256 + i]; }
                const float v = buf[t * 384 + 320 + vidx];
                float sa = 0.f;
#pragma unroll
                for (int i = 0; i < 8; ++i) sa += S[i] * kn[i];
                sa = -grp8_sum(sa);
                float y = 0.f;
#pragma unroll
                for (int i = 0; i < 8; ++i) { S[i] = S[i] * dc[i] + sa * ka[i] + v * kp[i]; y += S[i] * r[i]; }
                y = grp8_sum(y);
                if (ke == 0) YS[(m0 + c0 + t) * RW + h * RH + vidx] = y;
            }
        }
    }
}
constexpr int CS = 72, CBUF = 64 * CS * 2;
__device__ __forceinline__ f32x4 cmm(const LAS bf16* A, const LAS bf16* B, int m0, int n0, int lane, f32x4 acc) {
#pragma unroll
    for (int ks = 0; ks < 2; ++ks) {
        const bf16x8 a = *(const LAS bf16x8*)(A + (m0 + (lane & 15)) * CS + ks * 32 + 8 * (lane >> 4));
        const bf16x8 b = *(const LAS bf16x8*)(B + (n0 + (lane & 15)) * CS + ks * 32 + 8 * (lane >> 4));
        acc = __builtin_amdgcn_mfma_f32_16x16x32_bf16(a, b, acc, 0, 0, 0);
    }
    return acc;
}
__device__ __forceinline__ void cst4(LAS bf16* O, int n, int m, const f32x4 v) { v2u w; w.x = pk2(v[0], v[1]); w.y = pk2(v[2], v[3]); *(LAS v2u*)(O + n * CS + m) = w; }
__device__ __forceinline__ f32x4 cld4(const LAS bf16* O, int n, int m) { const v2u w = *(const LAS v2u*)(O + n * CS + m); return (f32x4){bflo(w.x), bfhi(w.x), bflo(w.y), bfhi(w.y)}; }
__device__ __forceinline__ void phase_chunkprep(Frame& F) {
    const bf16* SR = (const bf16*)(F.ws + WS_SR); const bf16* SKP = (const bf16*)(F.ws + WS_SKP); const bf16* SV = (const bf16*)(F.ws + WS_SV);
    const bf16* SKKN = (const bf16*)(F.ws + WS_SKKN); const bf16* SKA = (const bf16*)(F.ws + WS_SKA); const float* SDEC = (const float*)(F.ws + WS_SDEC);
    float* YS = (float*)(F.ws + WS_YS); bf16* CQ = (bf16*)(F.ws + WS_CQ); bf16* CG = (bf16*)(F.ws + WS_CG); float* CH = (float*)(F.ws + WS_CH);
#define CB(i) ((LAS bf16*)(F.lds + (i) * CBUF))
    LAS float* part = (LAS float*)(F.lds + 14 * CBUF);
    LAS float* pcs = part + 512;
    const int lane = F.lane, w = F.wave, n0 = 16 * (w & 3), mA = 32 * (w >> 2), nn = n0 + (lane & 15), mq = 4 * (lane >> 4);
    float dc[8]; unsigned short kn_[8], ka_[8], kp_[8], rr_[8], vv_[8];
#define CP_LOAD(PAIR) do { const int bh_ = (PAIR) >> 5, c_ = (PAIR) & 31; const size_t g0_ = ((size_t)(bh_ >> 3) * SEQ + c_ * 64 + 8 * w) * RW + (bh_ & 7) * RH + lane; \
        _Pragma("unroll") for (int i = 0; i < 8; ++i) { const size_t g = g0_ + (size_t)i * RW; dc[i] = SDEC[g]; kn_[i] = SKKN[g]; ka_[i] = SKA[g]; kp_[i] = SKP[g]; rr_[i] = SR[g]; vv_[i] = SV[g]; } } while (0)
    if (F.bid < NB * NH * (SEQ / 64)) CP_LOAD(F.bid);
    for (int pair = F.bid; pair < NB * NH * (SEQ / 64); pair += F.G) {
        const int bh = pair >> 5, c = pair & 31, b = bh >> 3, h = bh & 7; const size_t m0 = (size_t)b * SEQ + c * 64;
        {
          float kn[8], ka[8], kp[8], rr[8], vv[8];
#pragma unroll
          for (int i = 0; i < 8; ++i) { kn[i] = bf2f(kn_[i]); ka[i] = bf2f(ka_[i]); kp[i] = bf2f(kp_[i]); rr[i] = bf2f(rr_[i]); vv[i] = bf2f(vv_[i]); }
          float p[8]; p[0] = dc[0];
#pragma unroll
          for (int i = 1; i < 8; ++i) p[i] = p[i - 1] * dc[i];
          part[w * 64 + lane] = p[7];
          __syncthreads();
          float pre = 1.f, tot = 1.f;
#pragma unroll
          for (int g = 0; g < 8; ++g) { const float q = part[g * 64 + lane]; tot *= q; if (g < w) pre *= q; }
          if (w == 0) pcs[lane] = tot;
          float at[8], bt[8], kt[8], rt[8], bh_[8], kh[8];
#pragma unroll
          for (int i = 0; i < 8; ++i) { const float P = pre * p[i], Pm = (i == 0) ? pre : pre * p[i - 1], inv = 1.0f / P;
              at[i] = -kn[i] * Pm; bt[i] = ka[i] * inv; kt[i] = kp[i] * inv; rt[i] = rr[i] * P; bh_[i] = bt[i] * tot; kh[i] = kt[i] * tot; }
#pragma unroll
          for (int i = 0; i < 8; ++i) { const int o = (8 * w + i) * CS + lane; CB(0)[o] = (bf16)f2bf(at[i]); CB(1)[o] = (bf16)f2bf(bt[i]); CB(2)[o] = (bf16)f2bf(kt[i]); CB(3)[o] = (bf16)f2bf(rt[i]); }
          { const int o = lane * CS + 8 * w; v4u q;
            q.x = pk2(at[0], at[1]); q.y = pk2(at[2], at[3]); q.z = pk2(at[4], at[5]); q.w = pk2(at[6], at[7]); *(LAS v4u*)(CB(4) + o) = q;
            q.x = pk2(bh_[0], bh_[1]); q.y = pk2(bh_[2], bh_[3]); q.z = pk2(bh_[4], bh_[5]); q.w = pk2(bh_[6], bh_[7]); *(LAS v4u*)(CB(5) + o) = q;
            q.x = pk2(kh[0], kh[1]); q.y = pk2(kh[2], kh[3]); q.z = pk2(kh[4], kh[5]); q.w = pk2(kh[6], kh[7]); *(LAS v4u*)(CB(6) + o) = q;
            q.x = pk2(vv[0], vv[1]); q.y = pk2(vv[2], vv[3]); q.z = pk2(vv[4], vv[5]); q.w = pk2(vv[6], vv[7]); *(LAS v4u*)(CB(7) + o) = q; }
        }
        if (pair + F.G < NB * NH * (SEQ / 64)) CP_LOAD(pair + F.G);
        __syncthreads();
        const f32x4 z4 = (f32x4){0.f, 0.f, 0.f, 0.f};
#pragma unroll
        for (int tl = 0; tl < 2; ++tl) { const int m0t = mA + 16 * tl, mm = m0t + mq;
            f32x4 a1 = cmm(CB(1), CB(0), m0t, n0, lane, z4), a2 = cmm(CB(0), CB(1), m0t, n0, lane, z4), a3 = cmm(CB(2), CB(0), m0t, n0, lane, z4);
            f32x4 a4 = cmm(CB(1), CB(3), m0t, n0, lane, z4), a5 = cmm(CB(2), CB(3), m0t, n0, lane, z4), t0;
#pragma unroll
            for (int i = 0; i < 4; ++i) { const int m = mm + i; a1[i] = (m < nn) ? a1[i] : 0.f; a2[i] = (nn < m) ? a2[i] : 0.f; a3[i] = (m < nn) ? a3[i] : 0.f; a4[i] = (m <= nn) ? a4[i] : 0.f; a5[i] = (m <= nn) ? a5[i] : 0.f; t0[i] = a1[i] + ((m == nn) ? 1.f : 0.f); }
            cst4(CB(8), nn, mm, a1); cst4(CB(9), nn, mm, a2); cst4(CB(10), nn, mm, t0); cst4(CB(11), nn, mm, a3); cst4(CB(12), nn, mm, a4); cst4(CB(13), nn, mm, a5); }
        __syncthreads();
#pragma unroll
        for (int tl = 0; tl < 2; ++tl) { const int m0t = mA + 16 * tl, mm = m0t + mq;
            cst4(CB(0), nn, mm, cmm(CB(9), CB(8), m0t, n0, lane, z4)); cst4(CB(1), nn, mm, cmm(CB(8), CB(9), m0t, n0, lane, z4)); cst4(CB(2), nn, mm, cmm(CB(11), CB(7), m0t, n0, lane, z4)); }
        __syncthreads();
#define CSTEP(MP, MPT, MPN, MPTN, TI, TO, DO_MP, DO_MPT) do { _Pragma("unroll") for (int tl = 0; tl < 2; ++tl) { const int m0t = mA + 16 * tl, mm = m0t + mq; \
            if (DO_MP) cst4(CB(MPN), nn, mm, cmm(CB(MPT), CB(MP), m0t, n0, lane, z4)); if (DO_MPT) cst4(CB(MPTN), nn, mm, cmm(CB(MP), CB(MPT), m0t, n0, lane, z4)); \
            cst4(CB(TO), nn, mm, cmm(CB(MPT), CB(TI), m0t, n0, lane, cld4(CB(TI), nn, mm))); } __syncthreads(); } while (0)
        CSTEP(0, 1, 8, 9, 10, 11, true, true);
        CSTEP(8, 9, 0, 1, 11, 10, true, true);
        CSTEP(0, 1, 8, 9, 10, 11, true, true);
        CSTEP(8, 9, 0, 1, 11, 10, false, true);
        CSTEP(0, 1, 8, 9, 10, 11, false, false);
#undef CSTEP
#pragma unroll
        for (int tl = 0; tl < 2; ++tl) { const int m0t = mA + 16 * tl, mm = m0t + mq;
            cst4(CB(8), nn, mm, cmm(CB(11), CB(4), m0t, n0, lane, z4)); cst4(CB(9), nn, mm, cmm(CB(11), CB(2), m0t, n0, lane, z4)); }
        __syncthreads();
#pragma unroll
        for (int tl = 0; tl < 2; ++tl) { const int m0t = mA + 16 * tl, mm = m0t + mq;
            { const f32x4 q = cmm(CB(8), CB(12), m0t, n0, lane, cld4(CB(3), nn, mm)); v2u o; o.x = pk2(q[0], q[1]); o.y = pk2(q[2], q[3]); *(v2u*)(CQ + ((size_t)pair * 64 + nn) * 64 + mm) = o; }
            { const f32x4 y = cmm(CB(7), CB(13), m0t, n0, lane, cmm(CB(9), CB(12), m0t, n0, lane, z4)); *(f32x4*)(YS + (m0 + nn) * RW + h * RH + mm) = y; }
            { f32x4 g = cmm(CB(8), CB(5), m0t, n0, lane, z4);
#pragma unroll
              for (int i = 0; i < 4; ++i) g[i] += (mm + i == nn) ? pcs[nn] : 0.f;
              v2u o; o.x = pk2(g[0], g[1]); o.y = pk2(g[2], g[3]); *(v2u*)(CG + ((size_t)pair * 64 + nn) * 64 + mm) = o; }
            { const f32x4 hh = cmm(CB(7), CB(6), m0t, n0, lane, cmm(CB(9), CB(5), m0t, n0, lane, z4)); *(f32x4*)(CH + ((size_t)pair * 64 + nn) * 64 + mm) = hh; }
        }
        __syncthreads();
    }
#undef CB
#undef CP_LOAD
}
typedef float f32x16 __attribute__((ext_vector_type(16)));
__device__ __forceinline__ bf16x8 pack_frag(const f32x16& x, int s) {
    v4u w; w.x = pk2(x[8 * s + 0], x[8 * s + 1]); w.y = pk2(x[8 * s + 2], x[8 * s + 3]); w.z = pk2(x[8 * s + 4], x[8 * s + 5]); w.w = pk2(x[8 * s + 6], x[8 * s + 7]);
    return __builtin_bit_cast(bf16x8, w);
}
__device__ __forceinline__ bf16x8 ld_afrag(const bf16* rowp, int kbase, int hh) {
    const v2u lo = *(const v2u*)(rowp + kbase + 4 * hh), hi = *(const v2u*)(rowp + kbase + 8 + 4 * hh); v4u w; w.x = lo.x; w.y = lo.y; w.z = hi.x; w.w = hi.y; return __builtin_bit_cast(bf16x8, w);
}
__device__ __forceinline__ bf16x8 ld_afrag_lds(const LAS unsigned char* img, int row, int kbase, int hh) {
    const int k0 = kbase + 4 * hh, k1 = k0 + 8;
    const v2u lo = *(const LAS v2u*)(img + row * 128 + (((k0 >> 3) ^ (row & 7)) << 4) + ((k0 & 7) << 1));
    const v2u hi = *(const LAS v2u*)(img + row * 128 + (((k1 >> 3) ^ (row & 7)) << 4) + ((k1 & 7) << 1));
    v4u w; w.x = lo.x; w.y = lo.y; w.z = hi.x; w.w = hi.y; return __builtin_bit_cast(bf16x8, w);
}
__device__ __forceinline__ void phase_chunkscan(Frame& F) {
    float* YS = (float*)(F.ws + WS_YS); const bf16* CQ = (const bf16*)(F.ws + WS_CQ); const bf16* CG = (const bf16*)(F.ws + WS_CG); const float* CH = (const float*)(F.ws + WS_CH);
    const int lane = F.lane, r32 = lane & 31, hh = lane >> 5;
    const int per = (F.G >= 128) ? 1 : 2;
    LAS unsigned char* ring = F.lds + F.wave * 65536;
    const int drow = lane >> 3, dch = lane & 7, dsw = dch ^ drow;
    if (F.wave < per)
    for (int item = F.bid * per + F.wave; item < NB * NH * 2; item += F.G * per) {
        const int bh = item >> 1, vh = item & 1, b = bh >> 3, h = bh & 7; const size_t m0 = (size_t)b * SEQ;
#define CS_ISSUE(C, BUF) do { const size_t pr_ = (size_t)bh * 32 + (C); LAS unsigned char* d_ = ring + (BUF) * 32768; \
        const char* gq_ = (const char*)(CQ + pr_ * 4096) + drow * 128 + dsw * 16; const char* gg_ = (const char*)(CG + pr_ * 4096) + drow * 128 + dsw * 16; \
        const char* gh_ = (const char*)(CH + pr_ * 4096 + 32 * vh) + drow * 256 + dch * 16; const char* gy_ = (const char*)(YS + (m0 + (C) * 64) * RW + h * RH + 32 * vh) + (size_t)drow * (RW * 4) + dch * 16; \
        _Pragma("unroll") for (int i_ = 0; i_ < 8; ++i_) { \
            __builtin_amdgcn_global_load_lds((const unsigned*)(gq_ + i_ * 1024), (LAS unsigned*)(d_ + i_ * 1024), 16, 0, 0); \
            __builtin_amdgcn_global_load_lds((const unsigned*)(gg_ + i_ * 1024), (LAS unsigned*)(d_ + 8192 + i_ * 1024), 16, 0, 0); \
            __builtin_amdgcn_global_load_lds((const unsigned*)(gh_ + i_ * 2048), (LAS unsigned*)(d_ + 16384 + i_ * 1024), 16, 0, 0); \
            __builtin_amdgcn_global_load_lds((const unsigned*)(gy_ + (size_t)i_ * (8 * RW * 4)), (LAS unsigned*)(d_ + 24576 + i_ * 1024), 16, 0, 0); } } while (0)
        f32x16 X[2], Yh[2];
#pragma unroll
        for (int i = 0; i < 16; ++i) { X[0][i] = 0.f; X[1][i] = 0.f; Yh[0][i] = 0.f; Yh[1][i] = 0.f; }
        CS_ISSUE(0, 0);
        for (int c = 0; c < SEQ / 64; ++c) {
            asm volatile("s_waitcnt vmcnt(0)" ::: "memory"); __builtin_amdgcn_sched_barrier(0);
            if (c + 1 < SEQ / 64) CS_ISSUE(c + 1, (c + 1) & 1);
            if (c > 0) {
#pragma unroll
                for (int tt = 0; tt < 2; ++tt)
#pragma unroll
                    for (int i = 0; i < 16; ++i) { const int row = 32 * tt + (i & 3) + 8 * (i >> 2) + 4 * hh; YS[(m0 + (c - 1) * 64 + row) * RW + h * RH + 32 * vh + r32] = Yh[tt][i]; } }
            const LAS unsigned char* d = ring + (c & 1) * 32768;
            bf16x8 xb[2][2];
#pragma unroll
            for (int kt = 0; kt < 2; ++kt)
#pragma unroll
                for (int s2 = 0; s2 < 2; ++s2) xb[kt][s2] = pack_frag(X[kt], s2);
#pragma unroll
            for (int tt = 0; tt < 2; ++tt) {
                f32x16 Yt;
#pragma unroll
                for (int i = 0; i < 16; ++i) { const int row = 32 * tt + (i & 3) + 8 * (i >> 2) + 4 * hh; Yt[i] = *(const LAS float*)(d + 24576 + row * 128 + r32 * 4); }
#pragma unroll
                for (int kt = 0; kt < 2; ++kt)
#pragma unroll
                    for (int s2 = 0; s2 < 2; ++s2) Yt = __builtin_amdgcn_mfma_f32_32x32x16_bf16(ld_afrag_lds(d, 32 * tt + r32, 32 * kt + 16 * s2, hh), xb[kt][s2], Yt, 0, 0, 0);
                Yh[tt] = Yt;
            }
            f32x16 Xn[2];
#pragma unroll
            for (int tt = 0; tt < 2; ++tt) {
#pragma unroll
                for (int i = 0; i < 16; ++i) { const int row = 32 * tt + (i & 3) + 8 * (i >> 2) + 4 * hh; Xn[tt][i] = *(const LAS float*)(d + 16384 + row * 128 + r32 * 4); }
#pragma unroll
                for (int kt = 0; kt < 2; ++kt)
#pragma unroll
                    for (int s2 = 0; s2 < 2; ++s2) Xn[tt] = __builtin_amdgcn_mfma_f32_32x32x16_bf16(ld_afrag_lds(d + 8192, 32 * tt + r32, 32 * kt + 16 * s2, hh), xb[kt][s2], Xn[tt], 0, 0, 0);
            }
            X[0] = Xn[0]; X[1] = Xn[1];
        }
#pragma unroll
        for (int tt = 0; tt < 2; ++tt)
#pragma unroll
            for (int i = 0; i < 16; ++i) { const int row = 32 * tt + (i & 3) + 8 * (i >> 2) + 4 * hh; YS[(m0 + (SEQ / 64 - 1) * 64 + row) * RW + h * RH + 32 * vh + r32] = Yh[tt][i]; }
#undef CS_ISSUE
    }
}
__device__ __forceinline__ void phase_post(Frame& F, int l, int gw, int NGW) {
    const float* YS = (const float*)(F.ws + WS_YS); const bf16* SV = (const bf16*)(F.ws + WS_SV); const bf16* LOUT = (const bf16*)(F.ws + WS_LOUT); const float* BONUS = (const float*)(F.ws + WS_BONUS);
    bf16* YG = (bf16*)(F.ws + WS_YG);
    const int c = 8 * F.lane; float gg[8], gb[8]; ld8f(F.in[I_GNG] + l * RW + c, gg); ld8f(F.in[I_GNB] + l * RW + c, gb);
    for (int m = gw; m < M; m += NGW) {
        float y[8], v[8], g[8]; ld8f(YS + (size_t)m * RW + c, y); ld8bf(SV + (size_t)m * RW + c, v); ld8bf(LOUT + (size_t)m * NLORA + 1024 + c, g);
        float s = 0.f;
#pragma unroll
        for (int i = 0; i < 8; ++i) s += y[i];
        const float mean = grp8_sum(s) * (1.0f / RH); float s2 = 0.f;
#pragma unroll
        for (int i = 0; i < 8; ++i) { y[i] -= mean; s2 += y[i] * y[i]; }
        const float rstd = rsqrtf(grp8_sum(s2) * (1.0f / RH) + GN_EPS); const float bo = BONUS[(size_t)m * NH + (F.lane >> 3)];
        float o[8];
#pragma unroll
        for (int i = 0; i < 8; ++i) o[i] = (y[i] * rstd * gg[i] + gb[i] + bo * v[i]) * g[i];
        st8bf(YG + (size_t)m * D + RW + c, o);
    }
}

__device__ __forceinline__ unsigned* cnt_word(const Frame& F, int l, int e) { return (unsigned*)(F.ws + WS_CTL) + CW_CNT + (l * NE + e) * 64; }
constexpr int HT_STRIDE = 1040;
__device__ __forceinline__ void phase_rowB(Frame& F, int l, const bool dummy) {
    const bf16* Y = (const bf16*)(F.ws + WS_Y); bf16* H = (bf16*)(F.ws + (dummy ? WS_YEXP + 64 * MiB : WS_H));
    int* LIST = (int*)(F.ws + (dummy ? WS_YEXP + 96 * MiB : WS_LIST)); float* GW = (float*)(F.ws + (dummy ? WS_YEXP + 104 * MiB : WS_GW)); int* TOKA = (int*)(F.ws + (dummy ? WS_YEXP + 112 * MiB : WS_TOKA));
    float* xout = dummy ? (float*)(F.ws + WS_YEXP) : F.out; const int lc = dummy ? l + 2 : l;
    const float* xsrc = (l == 0) ? F.in[I_X] : F.out;
    LAS float* htile = (LAS float*)F.lds;
    LAS float* part = (LAS float*)(F.lds + 16 * HT_STRIDE * 4);
    LAS float* logit = part + 8 * 16 * 64;
    LAS int* cntl = (LAS int*)(logit + 1024 + 8 * 80);
    LAS int* asg = cntl + 128;
    if (F.tid < 128) cntl[F.tid] = 0;
    __syncthreads();
    int it = 0;
    const int lane = F.lane, w = F.wave, g4 = lane >> 4, j16 = lane & 15, kbase = 128 * w + 32 * g4;
    const float* wr = F.in[I_WROUTER] + (size_t)l * D * NE; const float br = F.in[I_BROUTER][l * NE + lane];
    v2u yq[2][4]; Row xq[2];
    if (F.bid < M / 16) {
#pragma unroll
        for (int rr = 0; rr < 2; ++rr) { const int m = F.bid * 16 + 2 * w + rr;
#pragma unroll
            for (int j = 0; j < 4; ++j) yq[rr][j] = *((const v2u*)(Y + (size_t)m * D) + lane + 64 * j);
            xq[rr] = row_load(xsrc + (size_t)m * D, lane); } }
    for (int tile = F.bid; tile < M / 16; tile += F.G, ++it) {
#pragma unroll
        for (int rr = 0; rr < 2; ++rr) {
            const int r = 2 * w + rr, m = tile * 16 + r, b = m / SEQ;
            Row y, x = xq[rr], gp = row_load(F.in[I_NMPOST] + l * D, lane), gt = row_load(mod_ptr(F, l, b, 2), lane);
#pragma unroll
            for (int j = 0; j < 4; ++j) y.v[j] = (f32x4){bflo(yq[rr][j].x), bfhi(yq[rr][j].x), bflo(yq[rr][j].y), bfhi(yq[rr][j].y)};
            const float rs = rsqrtf(row_sumsq(y) * (1.0f / D) + RMS_EPS);
#pragma unroll
            for (int j = 0; j < 4; ++j) x.v[j] = x.v[j] + gt.v[j] * (y.v[j] * rs * gp.v[j]);
            row_store(xout + (size_t)m * D, lane, x);
            Row h = row_modnorm(x, F.in[I_NFPRE] + l * D, mod_ptr(F, l, b, 4), mod_ptr(F, l, b, 3), lane);
            row_store_bf16(H + (size_t)m * D, lane, h);
#pragma unroll
            for (int j = 0; j < 4; ++j) *((LAS f32x4*)(htile + r * HT_STRIDE) + lane + 64 * j) = h.v[j];
        }
        if (tile + F.G < M / 16) {
#pragma unroll
            for (int rr = 0; rr < 2; ++rr) { const int m = (tile + F.G) * 16 + 2 * w + rr;
#pragma unroll
                for (int j = 0; j < 4; ++j) yq[rr][j] = *((const v2u*)(Y + (size_t)m * D) + lane + 64 * j);
                xq[rr] = row_load(xsrc + (size_t)m * D, lane); } }
        __syncthreads();
        if (dummy && MK_RB_LEVEL < 2) continue;
#pragma unroll 1
        for (int eq = 0; eq < 4; ++eq) {
            asm volatile("" : "+s"(wr));
            float Bw[32];
#pragma unroll
            for (int sidx = 0; sidx < 32; ++sidx) Bw[sidx] = wr[(size_t)(kbase + sidx) * NE + 16 * eq + j16];
            f32x4 acc = (f32x4){0.f, 0.f, 0.f, 0.f};
#pragma unroll
            for (int q = 0; q < 8; ++q) { const f32x4 a4 = *(const LAS f32x4*)(htile + j16 * HT_STRIDE + kbase + 4 * q);
#pragma unroll
                for (int i = 0; i < 4; ++i) acc = __builtin_amdgcn_mfma_f32_16x16x4f32(a4[i], Bw[4 * q + i], acc, 0, 0, 0); }
#pragma unroll
            for (int i = 0; i < 4; ++i) part[(w * 16 + 4 * g4 + i) * 64 + 16 * eq + j16] = acc[i];
        }
        __syncthreads();
#pragma unroll
        for (int o = 0; o < 2; ++o) { const int idx = F.tid + 512 * o; float sum = 0.f;
#pragma unroll
            for (int ww = 0; ww < 8; ++ww) sum += part[ww * 1024 + idx];
            logit[idx] = sum; }
        __syncthreads();
        if (dummy && MK_RB_LEVEL < 3) continue;
#pragma unroll 1
        for (int rr = 0; rr < 2; ++rr) {
            const int r = 2 * w + rr, m = tile * 16 + r;
            const float score = sigmoidf_(logit[r * 64 + lane]), biased = score + br;
            LAS float* wb = logit + 1024 + w * 80;
            wb[lane] = biased; LDS_WAIT();
            const int g = lane >> 3;
            float gs;
            { const f32x4 ga = *(const LAS f32x4*)(wb + 8 * g), gb = *(const LAS f32x4*)(wb + 8 * g + 4); float m1 = ga[0], m2 = -__builtin_inff();
#define T2(v) do { const float v_ = (v); if (v_ > m1) { m2 = m1; m1 = v_; } else if (v_ > m2) m2 = v_; } while (0)
              T2(ga[1]); T2(ga[2]); T2(ga[3]); T2(gb[0]); T2(gb[1]); T2(gb[2]); T2(gb[3]);
#undef T2
              gs = m1 + m2; }
            if ((lane & 7) == 0) wb[64 + g] = gs;
            LDS_WAIT();
            int grk = 0;
            { const f32x4 s0 = *(const LAS f32x4*)(wb + 64), s1 = *(const LAS f32x4*)(wb + 68);
#pragma unroll
              for (int q = 0; q < 8; ++q) { const float o = (q < 4) ? s0[q & 3] : s1[q & 3]; grk += (o > gs || (o == gs && q < g)) ? 1 : 0; } }
            const float masked = (grk < 4) ? biased : -__builtin_inff();
            wb[lane] = masked; LDS_WAIT();
            int rank = 0;
#pragma unroll
            for (int q = 0; q < 16; ++q) { const f32x4 o = *(const LAS f32x4*)(wb + 4 * q);
#pragma unroll
                for (int i = 0; i < 4; ++i) rank += (o[i] > masked || (o[i] == masked && (4 * q + i) < lane)) ? 1 : 0; }
            LDS_WAIT();
            const bool chosen = rank < TOPK;
            const float ssum = wave_sum(chosen ? score : 0.f);
            if (chosen) { const int lp = __hip_atomic_fetch_add((LAS int*)cntl + lane, 1, __ATOMIC_RELAXED, __HIP_MEMORY_SCOPE_WORKGROUP);
                LAS int* q = asg + ((it * 16 + r) * TOPK + rank) * 2; q[0] = lane * 65536 + lp; q[1] = __builtin_bit_cast(int, score / ssum * ROUTED_SCALE); }
            if (lane == 0) LIST[(size_t)NE * M + m] = m;
        }
    }
    if (dummy && MK_RB_LEVEL < 3) return;
    __syncthreads();
    if (F.tid < NE) cntl[NE + F.tid] = (int)__hip_atomic_fetch_add(cnt_word(F, lc, F.tid), (unsigned)cntl[F.tid], RLX_AGENT);
    __syncthreads();
    for (int idx = F.tid; idx < it * 16 * TOPK; idx += NTHREADS) {
        const int itl = idx / (16 * TOPK), r = (idx / TOPK) % 16, m = (F.bid + itl * F.G) * 16 + r; const int ep = asg[idx * 2], e = ep >> 16, pos = cntl[NE + e] + (ep & 65535);
        LIST[(size_t)e * M + pos] = m; TOKA[((size_t)m * TOPK + (idx % TOPK)) * 2] = e * 65536 + pos; TOKA[((size_t)m * TOPK + (idx % TOPK)) * 2 + 1] = asg[idx * 2 + 1]; }
}

struct MoeTab { LAS int* cnt; LAS int* start; LAS int* tstart; LAS int* ntiles; LAS int* tiles; };
__device__ __forceinline__ MoeTab moe_tab(const Frame& F) { MoeTab T; LAS int* p = (LAS int*)(F.lds + LDS_TAB_OFF); T.cnt = p; T.start = p + 80; T.tstart = p + 160; T.ntiles = p + 240; T.tiles = p + 256; return T; }
__device__ __forceinline__ void moe_build(Frame& F, int l, bool with_tiles) {
    MoeTab T = moe_tab(F);
    __syncthreads();
    if (F.tid <= NE) T.cnt[F.tid] = (F.tid < NE) ? (int)__hip_atomic_load(cnt_word(F, l, F.tid), RLX_AGENT) : M;
    __syncthreads();
    if (F.tid <= NE) { int s = 0, ts = 0; for (int e = 0; e < F.tid; ++e) { const int c = T.cnt[e]; s += c; ts += (c + 255) >> 8; } T.start[F.tid] = s; T.tstart[F.tid] = ts;
        if (F.tid == NE) T.ntiles[0] = ts + ((M + 255) >> 8);
        if (with_tiles) { const int c = T.cnt[F.tid]; const int nt = (c + 255) >> 8;
            for (int rt = 0; rt < nt; ++rt) { LAS int* q = T.tiles + (ts + rt) * 4; q[0] = F.tid; q[1] = rt * 256; q[2] = s + rt * 256; q[3] = (c - rt * 256) < 256 ? (c - rt * 256) : 256; } } }
    __syncthreads();
}
struct MoeOrder {
    LAS const int* tiles; int ntiles, npn, nwg, G, c, bstride;
    __device__ bool next(int i, pg8::Unit& u) const {
        const long L = (long)i * G + c; if (L >= nwg) return false;
        int wgid = (int)L; { const int q = nwg / 8, r = nwg % 8, xcd = wgid % 8, off = wgid / 8; wgid = (xcd < r ? xcd * (q + 1) : r * (q + 1) + (xcd - r) * q) + off; }
        const int tile = wgid / npn, pn = wgid % npn; LAS const int* q = tiles + tile * 4;
        const int q0 = __builtin_amdgcn_readfirstlane(q[0]), q1 = __builtin_amdgcn_readfirstlane(q[1]), q2 = __builtin_amdgcn_readfirstlane(q[2]), q3 = __builtin_amdgcn_readfirstlane(q[3]);
        u.e = q0; u.x0 = q0 * M + q1; u.o0 = q2; u.nrows = q3; u.b0 = q0 * bstride + pn * 256; u.oc0 = pn * 256; u.a0 = q2; return true;
    }
};
__device__ __forceinline__ void phase_rowC(Frame& F, int l, int gw, int NGW, const bool dummy) {
    const bf16* YEXP = (const bf16*)(F.ws + WS_YEXP); const bf16* YSH = (const bf16*)(F.ws + WS_YSH); const int* TOKA = (const int*)(F.ws + WS_TOKA); bf16* H = (bf16*)(F.ws + (dummy ? WS_S : WS_H));
    float* xout = dummy ? (float*)(F.ws + WS_S) : F.out;
    MoeTab T = moe_tab(F);
    for (int m = gw; m < M; m += NGW) {
        const int b = m / SEQ;
        Row y = row_load_bf16(YSH + (size_t)m * D, F.lane);
#pragma unroll
        for (int j8 = 0; j8 < TOPK; ++j8) { const int ep = TOKA[((size_t)m * TOPK + j8) * 2]; const float gt_ = __builtin_bit_cast(float, TOKA[((size_t)m * TOPK + j8) * 2 + 1]);
            const int slot = T.start[ep >> 16] + (ep & 65535); const Row t = row_load_bf16(YEXP + (size_t)slot * D, F.lane);
#pragma unroll
            for (int j = 0; j < 4; ++j) y.v[j] += gt_ * t.v[j]; }
        Row x = row_load(F.out + (size_t)m * D, F.lane), gp = row_load(F.in[I_NFPOST] + l * D, F.lane), gt = row_load(mod_ptr(F, l, b, 5), F.lane);
        const float rs = rsqrtf(row_sumsq(y) * (1.0f / D) + RMS_EPS);
#pragma unroll
        for (int j = 0; j < 4; ++j) x.v[j] = x.v[j] + gt.v[j] * (y.v[j] * rs * gp.v[j]);
        row_store(xout + (size_t)m * D, F.lane, x);
        if (l + 1 < DEPTH) { Row h = row_modnorm(x, F.in[I_NMPRE] + (l + 1) * D, mod_ptr(F, l + 1, b, 1), mod_ptr(F, l + 1, b, 0), F.lane); row_store_bf16(H + (size_t)m * D, F.lane, h); }
    }
}

__device__ __forceinline__ void phase_begin(Frame& F) { asm volatile("" : "+s"(F.in), "+s"(F.ws), "+s"(F.out), "+s"(F.bid), "+s"(F.G), "+s"(F.wave));
    F.lane = (int)__builtin_amdgcn_mbcnt_hi(~0u, __builtin_amdgcn_mbcnt_lo(~0u, 0u)); asm volatile("" : "+v"(F.lane)); F.tid = F.wave * 64 + F.lane; }
constexpr int PH_PER_LAYER = 13, NPH = 2 + DEPTH * PH_PER_LAYER;
__device__ __forceinline__ void bar_launder(XcdBarrier& bar) { asm volatile("" : "+s"(bar.bar)); }
#define TBIT(k) ((k) == 0 ? 13 : (k) == 1 ? 14 : ((k) - 2) % PH_PER_LAYER)
#define IN(k) (phase_begin(F), bar_launder(bar), t_ph = (((MK_TIME_MASK >> TBIT(k)) & 1) ? __builtin_amdgcn_s_memrealtime() : 0ull), (lo <= (k) && (k) < hi))
#define SEAM(k) do { if (!MK_PER_PHASE && (k) + 1 < hi) { xcd_barrier(bar, F.tid); if ((MK_TIME_MASK >> TBIT(k)) & 1) t_acc += __builtin_amdgcn_s_memrealtime() - t_ph; if (MK_REPEAT == -3) { bar_launder(bar); xcd_barrier(bar, F.tid); } } } while (0)
template <int L> __device__ __forceinline__ void layer_phases(Frame& F, XcdBarrier& bar, const int lo, const int hi, unsigned long long& t_acc) {
    constexpr int l = L, p0 = 2 + L * PH_PER_LAYER; unsigned long long t_ph = 0;
#define GW_ const int gw = F.bid * NWAVES + F.wave, NGW = F.G * NWAVES
#define WM_ unsigned char* wm = F.ws + WS_WMIX + (size_t)l * WMIX_STRIDE
    if (IN(p0 + 0)) { for (int rep_ = 0; rep_ < ((MK_REPEAT == 0) ? 2 : 1); ++rep_) { phase_begin(F); bar_launder(bar); WM_;
        pg8::Gemm g{(const bf16*)(F.ws + WS_H), (const bf16*)(wm + WM_WIN), D, nullptr}; pg8::StaticOrder S; S.init(M, DIN, F.G, F.bid);
        pg8::EpiZ E{(bf16*)(F.ws + WS_ZC)}; pg8::gemm_phase<pg8::EpiZ, pg8::StaticOrder, false>(F.lds, F.tid, g, S, E); } SEAM(p0 + 0); }
    if (IN(p0 + 1)) { for (int rep_ = 0; rep_ < ((MK_REPEAT == 1) ? 2 : 1); ++rep_) { phase_begin(F); bar_launder(bar); GW_; phase_conv(F, l); if (MK_REPEAT == 101) phase_conv(F, l); phase_prep1(F, l, gw, NGW); if (MK_REPEAT == 102) phase_prep1(F, l, gw, NGW); } SEAM(p0 + 1); }
    if (IN(p0 + 2)) { for (int rep_ = 0; rep_ < ((MK_REPEAT == 2) ? 2 : 1); ++rep_) { phase_begin(F); bar_launder(bar); WM_; pg8::Gemm g{(const bf16*)(F.ws + WS_LIN), (const bf16*)(wm + WM_LORA), KLORA, nullptr}; pg8::StaticOrder S; S.init(M, NLORA, F.G, F.bid);
        pg8::EpiBf16 E{(bf16*)(F.ws + WS_LOUT), NLORA}; pg8::gemm_phase<pg8::EpiBf16, pg8::StaticOrder, false>(F.lds, F.tid, g, S, E); } SEAM(p0 + 2); }
    if (IN(p0 + 3)) { for (int rep_ = 0; rep_ < ((MK_REPEAT == 3) ? 2 : 1); ++rep_) { phase_begin(F); bar_launder(bar); GW_; phase_prep2(F, l, gw, NGW); } SEAM(p0 + 3); }
    if (IN(p0 + 4)) { for (int rep_ = 0; rep_ < ((MK_REPEAT == 4) ? 2 : 1); ++rep_) { phase_begin(F); bar_launder(bar); phase_chunkprep(F); } SEAM(p0 + 4); }
    if (IN(p0 + 5)) { for (int rep_ = 0; rep_ < ((MK_REPEAT == 5) ? 2 : 1); ++rep_) { phase_begin(F); bar_launder(bar); const int per = (F.G >= 128) ? 1 : 2;
        if (F.wave < per) { if (rep_ == 0) phase_chunkscan(F); } else phase_expert_weights(F, l, F.bid * (NWAVES - per) + F.wave - per, F.G * (NWAVES - per)); } SEAM(p0 + 5); }
    if (IN(p0 + 6)) { for (int rep_ = 0; rep_ < ((MK_REPEAT == 6) ? 2 : 1); ++rep_) { phase_begin(F); bar_launder(bar); GW_; phase_post(F, l, gw, NGW); } SEAM(p0 + 6); }
    if (IN(p0 + 7)) { for (int rep_ = 0; rep_ < ((MK_REPEAT == 7) ? 2 : 1); ++rep_) { phase_begin(F); bar_launder(bar); WM_; pg8::StaticOrder S; S.init(M, D, F.G, F.bid);
        pg8::Gemm g{(const bf16*)(F.ws + WS_UC), (const bf16*)(wm + WM_PCONV), D, nullptr}; pg8::EpiMerge2 E{(bf16*)(F.ws + WS_MERGED), (const bf16*)(F.ws + WS_ZG)};
        pg8::gemm_phase<pg8::EpiMerge2, pg8::StaticOrder, false>(F.lds, F.tid, g, S, E); } SEAM(p0 + 7); }
    if (IN(p0 + 8)) { for (int rep_ = 0; rep_ < ((MK_REPEAT == 8) ? 2 : 1); ++rep_) { phase_begin(F); bar_launder(bar); WM_; pg8::Gemm g{(const bf16*)(F.ws + WS_MERGED), (const bf16*)(wm + WM_WO), D, nullptr}; pg8::StaticOrder S; S.init(M, D, F.G, F.bid);
        pg8::EpiBf16 E{(bf16*)(F.ws + WS_Y), D}; pg8::gemm_phase<pg8::EpiBf16, pg8::StaticOrder, false>(F.lds, F.tid, g, S, E); } SEAM(p0 + 8); }
    if (IN(p0 + 9)) { for (int rep_ = 0; rep_ < ((MK_REPEAT == 9) ? 2 : 1); ++rep_) { phase_begin(F); bar_launder(bar); phase_rowB(F, l, (MK_REPEAT == 9) && rep_ == 0); } SEAM(p0 + 9); }
    if (IN(p0 + 10)) { for (int rep_ = 0; rep_ < ((MK_REPEAT == 10) ? 2 : 1); ++rep_) { phase_begin(F); bar_launder(bar); moe_build(F, l, true); MoeTab T = moe_tab(F);
        const int ntl = __builtin_amdgcn_readfirstlane(T.ntiles[0]); MoeOrder S{T.tiles, ntl, 2, ntl * 2, F.G, F.bid, 512};
        pg8::Gemm g{(const bf16*)(F.ws + WS_H), (const bf16*)(F.ws + WS_WGU), D, (const int*)(F.ws + WS_LIST)};
        pg8::EpiSwiGLU E{(bf16*)(F.ws + WS_ACT)}; pg8::gemm_phase<pg8::EpiSwiGLU, MoeOrder, true>(F.lds, F.tid, g, S, E); } SEAM(p0 + 10); }
    if (IN(p0 + 11)) { for (int rep_ = 0; rep_ < ((MK_REPEAT == 11) ? 2 : 1); ++rep_) { phase_begin(F); bar_launder(bar); moe_build(F, l, true); MoeTab T = moe_tab(F);
        const int ntl = __builtin_amdgcn_readfirstlane(T.ntiles[0]); MoeOrder S{T.tiles, ntl, 4, ntl * 4, F.G, F.bid, 1024};
        pg8::Gemm g{(const bf16*)(F.ws + WS_ACT), (const bf16*)(F.ws + WS_WDN), DE, nullptr};
        pg8::EpiBf16 E{(bf16*)(F.ws + WS_YEXP), D}; pg8::gemm_phase<pg8::EpiBf16, MoeOrder, false>(F.lds, F.tid, g, S, E); } SEAM(p0 + 11); }
    if (IN(p0 + 12)) { for (int rep_ = 0; rep_ < ((MK_REPEAT == 12) ? 2 : 1); ++rep_) { phase_begin(F); bar_launder(bar); GW_; moe_build(F, l, false); phase_rowC(F, l, gw, NGW, (MK_REPEAT == 12) && rep_ == 0); } SEAM(p0 + 12); }
}
__global__ void __launch_bounds__(NTHREADS, 2) mk_fwd(Args args) {
    extern __shared__ __attribute__((aligned(16))) unsigned char lds_raw[];
    Frame F; F.lds = (LAS unsigned char*)lds_raw; F.tid = threadIdx.x; F.lane = F.tid & 63; F.wave = __builtin_amdgcn_readfirstlane(F.tid >> 6);
    F.G = gridDim.x; F.bid = blockIdx.x; F.in = (const float* const __attribute__((address_space(4)))*)__builtin_amdgcn_kernarg_segment_ptr(); F.out = args.out; F.ws = args.ws;
    volatile LAS unsigned* MISC = (volatile LAS unsigned*)(F.lds + MISC_OFF);
    if (F.tid < 64) MISC[F.tid] = 0u;
    __syncthreads();
    XcdBarrier bar; bar.bar = (unsigned*)(F.ws + WS_CTL) + CW_BAR; bar.x = 0; bar.st = nullptr;
    if (!MK_PER_PHASE) bar = xcd_barrier_post((unsigned*)(F.ws + WS_CTL) + CW_BAR, MISC + 8);
    const int lo = args.ph_lo, hi = (args.ph_hi < MK_LAST_PHASE + 1) ? args.ph_hi : MK_LAST_PHASE + 1;
    unsigned long long t_acc = 0, t_ph = 0;
    if (IN(0)) { for (int rep_ = 0; rep_ < ((MK_REPEAT == -2) ? 2 : 1); ++rep_) { phase_begin(F); bar_launder(bar); GW_; phase_ada(F); phase_mix_weights(F, gw, NGW); } SEAM(0); }
    if (IN(1)) { GW_; phase_rowA(F, gw, NGW); SEAM(1); }
    layer_phases<0>(F, bar, lo, hi, t_acc);
    layer_phases<1>(F, bar, lo, hi, t_acc);
    if (MK_TIME_MASK != 0 && F.bid == 0) { const unsigned long long te = __builtin_amdgcn_s_memrealtime() + t_acc; while (__builtin_amdgcn_s_memrealtime() < te) __builtin_amdgcn_s_sleep(8); }
    if (MK_LAST_PHASE < 2 + 9 && args.ph_hi == NPH) { phase_begin(F); for (size_t i = (size_t)F.bid * NTHREADS + F.tid; i < (size_t)M * D / 4; i += (size_t)F.G * NTHREADS) ((f32x4*)F.out)[i] = ((const f32x4*)F.in[I_X])[i]; }
}
#undef IN
#undef SEAM
#undef GW_
#undef WM_

extern "C" void kernel_launch(void* const* d_in, const int* in_sizes, int n_in, void* d_out, int out_size, void* d_ws, size_t ws_size, hipStream_t stream) {
    static int grid = 0;
    if (grid == 0) {
        if (n_in != N_IN || out_size != M * D) { fprintf(stderr, "kernel_launch: unexpected shapes (n_in %d out %d ws %zu need %zu)\n", n_in, out_size, ws_size, (size_t)WS_END); grid = -1; return; }
        if (ws_size < WS_END) { fprintf(stderr, "kernel_launch: ws too small %zu < %zu\n", ws_size, (size_t)WS_END); grid = -2; }
        int dev = 0, cus = 0;
        if (hipGetDevice(&dev) != hipSuccess || hipDeviceGetAttribute(&cus, hipDeviceAttributeMultiprocessorCount, dev) != hipSuccess) { grid = -1; return; }
        if (hipFuncSetAttribute((const void*)mk_fwd, hipFuncAttributeMaxDynamicSharedMemorySize, LDS_BYTES) != hipSuccess) { fprintf(stderr, "kernel_launch: hipFuncSetAttribute failed\n"); grid = -1; return; }
        (void)hipGetLastError();
        grid = cus;
    }
    if (grid == -2) { (void)hipMemsetAsync(d_out, 0, (size_t)out_size * 4, stream); return; }
    if (grid < 0) return;
    (void)hipMemsetAsync((char*)d_ws + WS_CTL, 0, CTL_ZERO_BYTES, stream);
    Args a{};
    for (int i = 0; i < N_IN; ++i) a.in[i] = (const float*)d_in[i];
    a.out = (float*)d_out; a.ws = (unsigned char*)d_ws;
#if MK_PER_PHASE
    for (int p = 0; p < NPH && p <= MK_LAST_PHASE; ++p) { a.ph_lo = p; a.ph_hi = p + 1; hipLaunchKernelGGL(mk_fwd, dim3(grid), dim3(NTHREADS), LDS_BYTES, stream, a); }
#else
    a.ph_lo = 0; a.ph_hi = NPH;
    hipLaunchKernelGGL(mk_fwd, dim3(grid), dim3(NTHREADS), LDS_BYTES, stream, a);
#endif
}
```

```cpp
#include <hip/hip_runtime.h>
#include <cstdio>
#include <cstdint>

#ifndef MK_PER_PHASE
#define MK_PER_PHASE 0
#endif
#ifndef MK_REPEAT
#define MK_REPEAT -1
#endif
#ifndef MK_TIME_MASK
#define MK_TIME_MASK 0
#endif
#ifndef MK_RB_LEVEL
#define MK_RB_LEVEL 3
#endif
#ifndef MK_LAST_PHASE
#define MK_LAST_PHASE 9999
#endif

#define GAS __attribute__((address_space(1)))
#define LAS __attribute__((address_space(3)))
typedef unsigned short bf16;
typedef unsigned v4u __attribute__((ext_vector_type(4)));
typedef unsigned v2u __attribute__((ext_vector_type(2)));
typedef float f32x4 __attribute__((ext_vector_type(4)));
typedef float f32x2 __attribute__((ext_vector_type(2)));
typedef short bf16x8 __attribute__((ext_vector_type(8)));
typedef GAS unsigned gu32;
#define RLX_AGENT __ATOMIC_RELAXED, __HIP_MEMORY_SCOPE_AGENT
#define LDS_WAIT() asm volatile("s_waitcnt lgkmcnt(0)" ::: "memory")
#define VM_WAIT() asm volatile("s_waitcnt vmcnt(0)" ::: "memory")

constexpr int NB = 8, SEQ = 2048, D = 1024, M = NB * SEQ, DEPTH = 2;
constexpr int CW = 512, CKW = 31, RW = 512, RH = 64, NH = 8, LW = 64, LA = 64, LG = 128;
constexpr int NE = 64, TOPK = 8, DE = 256;
constexpr int DIN = 4864, ZR0 = 1024, ZG0 = 2816, COLR = 1792;
constexpr int NLORA = 1536, KLORA = 256;
constexpr float RMS_EPS = 1e-6f, LN_EPS = 1e-5f, GN_EPS = 64e-5f, ROUTED_SCALE = 2.5f;
constexpr int NWAVES = 8, NTHREADS = 512;

enum { I_X = 0, I_C, I_WADA, I_BADA, I_NMPRE, I_NMPOST, I_NFPRE, I_NFPOST, I_WIN, I_MU, I_CONVW, I_CONVB, I_CLNG, I_CLNB, I_PCONV,
       I_W0, I_W2, I_A0, I_A2, I_G2, I_KK, I_KA, I_RK, I_GNG, I_GNB, I_PRWKV, I_WO, I_WROUTER, I_BROUTER, I_WEG, I_WEU, I_WED, I_WSG, I_WSU, I_WSD, N_IN };

constexpr size_t MiB = 1u << 20;
constexpr size_t WS_CTL = 0, CTL_ZERO_BYTES = 1 * MiB;
constexpr size_t WS_MOD = 1 * MiB;
constexpr size_t WS_BONUS = 1 * MiB + 512 * 1024;
constexpr size_t WS_WMIX = 2 * MiB;
constexpr size_t WMIX_STRIDE = 15 * MiB;
constexpr size_t WM_WIN = 0, WM_PCONV = (size_t)DIN * D * 2, WM_PRWKV = WM_PCONV + (size_t)D * CW * 2, WM_WO = WM_PRWKV + (size_t)D * RW * 2, WM_LORA = WM_WO + (size_t)D * D * 2;
static_assert(WM_LORA + (size_t)NLORA * KLORA * 2 <= WMIX_STRIDE, "wmix");
constexpr size_t WS_WGU = 32 * MiB;
constexpr size_t WS_WDN = 97 * MiB;
constexpr size_t WS_H = 130 * MiB;
constexpr size_t WS_LIST = 162 * MiB;
constexpr size_t WS_GW = 167 * MiB;
constexpr size_t WS_TOKA = 172 * MiB;
constexpr size_t WS_S = 173 * MiB;
constexpr size_t WS_ZC = WS_S;
constexpr size_t WS_ZR = WS_S + 32 * MiB;
constexpr size_t WS_ZG = WS_S + 88 * MiB;
constexpr size_t WS_CQ = WS_S;
constexpr size_t WS_CG = WS_S + 16 * MiB;
constexpr size_t WS_CH = WS_S + 32 * MiB;
constexpr int ZCW = 1024, ZRW = 1792, ZGW = 2048;
static_assert(WS_ZR == WS_ZC + (size_t)NB * SEQ * 1024 * 2 && WS_ZG == WS_ZR + (size_t)NB * SEQ * 1792 * 2, "ZC | ZR | ZG adjacent");
constexpr size_t WS_LIN = WS_S + 152 * MiB;
constexpr size_t WS_LOUT = WS_S + 160 * MiB;
constexpr size_t WS_SR = WS_S + 208 * MiB;
constexpr size_t WS_SKP = WS_SR + 16 * MiB, WS_SV = WS_SR + 32 * MiB, WS_SKKN = WS_SR + 48 * MiB, WS_SKA = WS_SR + 64 * MiB;
constexpr size_t WS_SDEC = WS_SR + 80 * MiB;
constexpr size_t WS_YS = WS_SDEC + 32 * MiB;
constexpr size_t WS_UC = WS_S + 352 * MiB;
constexpr size_t WS_YG = WS_UC;
constexpr size_t WS_MERGED = WS_SKKN;
constexpr size_t WS_Y = WS_SDEC;
constexpr size_t WS_ACT = WS_S;
constexpr size_t WS_YEXP = WS_S + 74 * MiB;
constexpr size_t WS_YSH = WS_S + 330 * MiB;
constexpr size_t WS_END = WS_S + 384 * MiB;
constexpr int CW_BAR = 4096;
constexpr int CW_CNT = 16384;
constexpr int RING_BYTES = 131072, LDS_TAB_OFF = RING_BYTES, LDS_TAB_BYTES = 11264, LDS_ROWTAB_OFF = LDS_TAB_OFF + LDS_TAB_BYTES, LDS_GWTAB_OFF = LDS_ROWTAB_OFF + 2048, MISC_OFF = LDS_GWTAB_OFF + 2048, LDS_BYTES = 147456;
static_assert(MISC_OFF + 256 <= LDS_BYTES, "lds");

__device__ __forceinline__ unsigned f2bf(float f) { unsigned u = __builtin_bit_cast(unsigned, f); return (u + 0x7fffu + ((u >> 16) & 1u)) >> 16; }
typedef __bf16 bf16x2_t __attribute__((ext_vector_type(2)));
__device__ __forceinline__ unsigned pk2(float lo, float hi) { const f32x2 f = {lo, hi}; return __builtin_bit_cast(unsigned, __builtin_convertvector(f, bf16x2_t)); }
__device__ __forceinline__ float bf2f(unsigned b) { return __builtin_bit_cast(float, b << 16); }
__device__ __forceinline__ float bflo(unsigned w) { return __builtin_bit_cast(float, w << 16); }
__device__ __forceinline__ float bfhi(unsigned w) { return __builtin_bit_cast(float, w & 0xffff0000u); }
__device__ __forceinline__ float sigmoidf_(float x) { return __builtin_amdgcn_rcpf(1.0f + __expf(-x)); }
__device__ __forceinline__ float siluf_(float x) { return x * __builtin_amdgcn_rcpf(1.0f + __expf(-x)); }
__device__ __forceinline__ float wave_sum(float v) {
#pragma unroll
    for (int o = 1; o < 64; o <<= 1) v += __shfl_xor(v, o);
    return v;
}

namespace pg8 {
constexpr int BM = 256, BK = 64, HALF = 128, HTB = HALF * BK * 2, STAGE_BYTES = 8 * HTB, NXCD = 8, WGM = 8;
__host__ __device__ __forceinline__ int lds_byte(int r, int c) { const int st = (r >> 4) * 2 + (c >> 5), rr = r & 15, cc = c & 31, ob = rr * 64 + cc * 2; return st * 1024 + (ob ^ (((ob >> 9) & 1) << 5)); }
__host__ __device__ __forceinline__ void stage_rc(int b, int& R, int& C) { const int st = b / 1024, sb = b % 1024, swz = sb ^ (((sb >> 9) & 1) << 5); R = (st >> 1) * 16 + swz / 64; C = (st & 1) * 32 + (swz % 64) / 2; }
__host__ __device__ __forceinline__ int perm32(int rho) { const int n = rho >> 4, i = rho & 15; return 8 * (i >> 2) + 4 * n + (i & 3); }

struct Unit { int a0, b0, o0, oc0, nrows, e, x0; };
struct Gemm { const bf16* A; const bf16* Bt; int K; const int* list; };

struct StaticOrder {
    int nM, nN, nwg, G, c;
    __device__ void init(int M_, int N_, int G_, int c_) { nM = M_ / BM; nN = N_ / BM; nwg = nM * nN; G = G_; c = c_; }
    __device__ bool next(int i, Unit& u) const {
        const long L = (long)i * G + c; if (L >= nwg) return false;
        int wgid = (int)L; { const int q = nwg / NXCD, r = nwg % NXCD, xcd = wgid % NXCD, off = wgid / NXCD; wgid = (xcd < r ? xcd * (q + 1) : r * (q + 1) + (xcd - r) * q) + off; }
        const int nig = WGM * nN, gid = wgid / nig, fm = gid * WGM, gsz = (nM - fm) < WGM ? (nM - fm) : WGM;
        const int pm = fm + ((wgid % nig) % gsz), pn = (wgid % nig) / gsz;
        u.a0 = pm * BM; u.b0 = pn * BM; u.o0 = pm * BM; u.oc0 = pn * BM; u.nrows = BM; u.e = 0; u.x0 = 0; return true;
    }
};

__device__ __forceinline__ unsigned cvt_pk_bf16(float lo, float hi) { unsigned r; asm volatile("v_cvt_pk_bf16_f32 %0, %1, %2" : "=v"(r) : "v"(lo), "v"(hi)); return r; }

struct EpiF32 {
    static constexpr bool PERM = false, HAS_MID = false;
    float* C; int ldc;
    __device__ __forceinline__ void operator()(const f32x4 (&acc)[2][2][4][2], const Unit& u, int wr, int wc, int fr, int fq) const {
        const int row0 = wr * 64 + fr, col0 = u.oc0 + wc * 32 + 4 * fq;
#pragma unroll
        for (int ai = 0; ai < 2; ++ai)
#pragma unroll
            for (int m = 0; m < 4; ++m) { const int r = row0 + ai * HALF + m * 16; if (r < u.nrows) { float* rowp = C + (size_t)(u.o0 + r) * ldc + col0;
#pragma unroll
                for (int bj = 0; bj < 2; ++bj)
#pragma unroll
                    for (int n = 0; n < 2; ++n) *(f32x4*)(rowp + bj * HALF + n * 16) = acc[ai][bj][m][n]; } }
    }
};
struct EpiBf16 {
    static constexpr bool PERM = true, HAS_MID = false;
    bf16* O; int ldc;
    __device__ __forceinline__ void operator()(const f32x4 (&acc)[2][2][4][2], const Unit& u, int wr, int wc, int fr, int fq) const {
        const int row0 = wr * 64 + fr, col0 = u.oc0 + wc * 32 + 8 * fq;
#pragma unroll
        for (int ai = 0; ai < 2; ++ai)
#pragma unroll
            for (int m = 0; m < 4; ++m) { const int r = row0 + ai * HALF + m * 16; if (r < u.nrows) { bf16* rowp = O + (size_t)(u.o0 + r) * ldc + col0;
#pragma unroll
                for (int bj = 0; bj < 2; ++bj) { const f32x4 v0 = acc[ai][bj][m][0], v1 = acc[ai][bj][m][1];
                    v4u w; w.x = cvt_pk_bf16(v0[0], v0[1]); w.y = cvt_pk_bf16(v0[2], v0[3]); w.z = cvt_pk_bf16(v1[0], v1[1]); w.w = cvt_pk_bf16(v1[2], v1[3]);
                    *(v4u*)(rowp + bj * HALF) = w; } } }
    }
};
struct EpiZ {
    static constexpr bool PERM = true, HAS_MID = false;
    bf16* ZC;
    __device__ __forceinline__ void operator()(const f32x4 (&acc)[2][2][4][2], const Unit& u, int wr, int wc, int fr, int fq) const {
        const int seg = (u.oc0 < 1024) ? 0 : (u.oc0 < 2816) ? 1 : 2;
        const int ldc = (seg == 0) ? 1024 : (seg == 1) ? 1792 : 2048, c0 = u.oc0 - ((seg == 0) ? 0 : (seg == 1) ? 1024 : 2816);
        bf16* O = ZC + ((seg == 0) ? (size_t)0 : (seg == 1) ? (size_t)M * 1024 : (size_t)M * (1024 + 1792));
        const int row0 = u.o0 + wr * 64 + fr, col0 = c0 + wc * 32 + 8 * fq;
#pragma unroll
        for (int ai = 0; ai < 2; ++ai)
#pragma unroll
            for (int m = 0; m < 4; ++m) { bf16* rowp = O + (size_t)(row0 + ai * HALF + m * 16) * ldc + col0;
#pragma unroll
                for (int bj = 0; bj < 2; ++bj) { const f32x4 v0 = acc[ai][bj][m][0], v1 = acc[ai][bj][m][1];
                    v4u w; w.x = cvt_pk_bf16(v0[0], v0[1]); w.y = cvt_pk_bf16(v0[2], v0[3]); w.z = cvt_pk_bf16(v1[0], v1[1]); w.w = cvt_pk_bf16(v1[2], v1[3]);
                    *(v4u*)(rowp + bj * HALF) = w; } }
    }
};
template <bool FIRST> struct EpiMerge {
    static constexpr bool PERM = true, HAS_MID = false;
    bf16* O; const bf16* Z; int gcol0;
    __device__ __forceinline__ void operator()(const f32x4 (&acc)[2][2][4][2], const Unit& u, int wr, int wc, int fr, int fq) const {
        const int row0 = u.o0 + wr * 64 + fr, col0 = u.oc0 + wc * 32 + 8 * fq;
#pragma unroll
        for (int ai = 0; ai < 2; ++ai)
#pragma unroll
            for (int m = 0; m < 4; ++m) { const int r = row0 + ai * HALF + m * 16; bf16* rowp = O + (size_t)r * D + col0; const bf16* zp = Z + (size_t)r * 2048 + gcol0 + col0;
#pragma unroll
                for (int bj = 0; bj < 2; ++bj) { const v4u g = *(const v4u*)(zp + bj * HALF); const f32x4 a0 = acc[ai][bj][m][0], a1 = acc[ai][bj][m][1];
                    float o[8];
                    o[0] = a0[0] * sigmoidf_(bflo(g.x)); o[1] = a0[1] * sigmoidf_(bfhi(g.x)); o[2] = a0[2] * sigmoidf_(bflo(g.y)); o[3] = a0[3] * sigmoidf_(bfhi(g.y));
                    o[4] = a1[0] * sigmoidf_(bflo(g.z)); o[5] = a1[1] * sigmoidf_(bfhi(g.z)); o[6] = a1[2] * sigmoidf_(bflo(g.w)); o[7] = a1[3] * sigmoidf_(bfhi(g.w));
                    if (!FIRST) { const v4u p = *(const v4u*)(rowp + bj * HALF);
                        o[0] += bflo(p.x); o[1] += bfhi(p.x); o[2] += bflo(p.y); o[3] += bfhi(p.y); o[4] += bflo(p.z); o[5] += bfhi(p.z); o[6] += bflo(p.w); o[7] += bfhi(p.w); }
                    v4u w; w.x = cvt_pk_bf16(o[0], o[1]); w.y = cvt_pk_bf16(o[2], o[3]); w.z = cvt_pk_bf16(o[4], o[5]); w.w = cvt_pk_bf16(o[6], o[7]);
                    *(v4u*)(rowp + bj * HALF) = w; } }
    }
};
struct EpiMerge2 {
    static constexpr bool PERM = true, HAS_MID = true;
    bf16* O; const bf16* ZG;
    __device__ __forceinline__ void mid(f32x4 (&acc)[2][2][4][2], const Unit& u, int wr, int wc, int fr, int fq) const {
        const int row0 = u.o0 + wr * 64 + fr, col0 = u.oc0 + wc * 32 + 8 * fq;
#pragma unroll
        for (int ai = 0; ai < 2; ++ai)
#pragma unroll
            for (int m = 0; m < 4; ++m) { const bf16* zp = ZG + (size_t)(row0 + ai * HALF + m * 16) * 2048 + col0;
#pragma unroll
                for (int bj = 0; bj < 2; ++bj) { const v4u g1 = *(const v4u*)(zp + bj * HALF), g2 = *(const v4u*)(zp + 1024 + bj * HALF);
#define RT_(a, b) ((1.0f + __expf(-(b))) * __builtin_amdgcn_rcpf(1.0f + __expf(-(a))))
                    acc[ai][bj][m][0][0] *= RT_(bflo(g1.x), bflo(g2.x)); acc[ai][bj][m][0][1] *= RT_(bfhi(g1.x), bfhi(g2.x)); acc[ai][bj][m][0][2] *= RT_(bflo(g1.y), bflo(g2.y)); acc[ai][bj][m][0][3] *= RT_(bfhi(g1.y), bfhi(g2.y));
                    acc[ai][bj][m][1][0] *= RT_(bflo(g1.z), bflo(g2.z)); acc[ai][bj][m][1][1] *= RT_(bfhi(g1.z), bfhi(g2.z)); acc[ai][bj][m][1][2] *= RT_(bflo(g1.w), bflo(g2.w)); acc[ai][bj][m][1][3] *= RT_(bfhi(g1.w), bfhi(g2.w));
#undef RT_
                } }
    }
    __device__ __forceinline__ void operator()(const f32x4 (&acc)[2][2][4][2], const Unit& u, int wr, int wc, int fr, int fq) const {
        const int row0 = u.o0 + wr * 64 + fr, col0 = u.oc0 + wc * 32 + 8 * fq;
#pragma unroll
        for (int ai = 0; ai < 2; ++ai)
#pragma unroll
            for (int m = 0; m < 4; ++m) { const int r = row0 + ai * HALF + m * 16; bf16* rowp = O + (size_t)r * D + col0; const bf16* zp = ZG + (size_t)r * 2048 + 1024 + col0;
#pragma unroll
                for (int bj = 0; bj < 2; ++bj) { const v4u g = *(const v4u*)(zp + bj * HALF); const f32x4 a0 = acc[ai][bj][m][0], a1 = acc[ai][bj][m][1];
                    v4u w; w.x = cvt_pk_bf16(a0[0] * sigmoidf_(bflo(g.x)), a0[1] * sigmoidf_(bfhi(g.x))); w.y = cvt_pk_bf16(a0[2] * sigmoidf_(bflo(g.y)), a0[3] * sigmoidf_(bfhi(g.y)));
                    w.z = cvt_pk_bf16(a1[0] * sigmoidf_(bflo(g.z)), a1[1] * sigmoidf_(bfhi(g.z))); w.w = cvt_pk_bf16(a1[2] * sigmoidf_(bflo(g.w)), a1[3] * sigmoidf_(bfhi(g.w)));
                    *(v4u*)(rowp + bj * HALF) = w; } }
    }
};
struct EpiFp8 {
    static constexpr bool PERM = true, HAS_MID = false;
    unsigned char* O; int ldc;
    __device__ __forceinline__ void operator()(const f32x4 (&acc)[2][2][4][2], const Unit& u, int wr, int wc, int fr, int fq) const {
        const int row0 = wr * 64 + fr, col0 = u.oc0 + wc * 32 + 8 * fq;
#pragma unroll
        for (int ai = 0; ai < 2; ++ai)
#pragma unroll
            for (int m = 0; m < 4; ++m) { const int r = row0 + ai * HALF + m * 16; if (r < u.nrows) { unsigned char* rowp = O + (size_t)(u.o0 + r) * ldc + col0;
#pragma unroll
                for (int bj = 0; bj < 2; ++bj) { const f32x4 v0 = acc[ai][bj][m][0], v1 = acc[ai][bj][m][1]; int w0 = 0, w1 = 0;
                    w0 = __builtin_amdgcn_cvt_pk_fp8_f32(v0[0], v0[1], w0, false); w0 = __builtin_amdgcn_cvt_pk_fp8_f32(v0[2], v0[3], w0, true);
                    w1 = __builtin_amdgcn_cvt_pk_fp8_f32(v1[0], v1[1], w1, false); w1 = __builtin_amdgcn_cvt_pk_fp8_f32(v1[2], v1[3], w1, true);
                    v2u w; w.x = (unsigned)w0; w.y = (unsigned)w1; *(v2u*)(rowp + bj * HALF) = w; } } }
    }
};
struct EpiSwiGLU {
    static constexpr bool PERM = true, HAS_MID = false;
    bf16* O;
    __device__ __forceinline__ void operator()(const f32x4 (&acc)[2][2][4][2], const Unit& u, int wr, int wc, int fr, int fq) const {
        const int row0 = wr * 64 + fr, col0 = (u.oc0 >> 1) + wc * 32 + 8 * fq;
#pragma unroll
        for (int ai = 0; ai < 2; ++ai)
#pragma unroll
            for (int m = 0; m < 4; ++m) { const int r = row0 + ai * HALF + m * 16; if (r < u.nrows) { bf16* rowp = O + (size_t)(u.o0 + r) * DE + col0;
                const f32x4 g0 = acc[ai][0][m][0], g1 = acc[ai][0][m][1], u0 = acc[ai][1][m][0], u1 = acc[ai][1][m][1];
                v4u w; w.x = cvt_pk_bf16(siluf_(g0[0]) * u0[0], siluf_(g0[1]) * u0[1]); w.y = cvt_pk_bf16(siluf_(g0[2]) * u0[2], siluf_(g0[3]) * u0[3]);
                w.z = cvt_pk_bf16(siluf_(g1[0]) * u1[0], siluf_(g1[1]) * u1[1]); w.w = cvt_pk_bf16(siluf_(g1[2]) * u1[2], siluf_(g1[3]) * u1[3]);
                *(v4u*)rowp = w; } }
    }
};

constexpr int ROWTAB_OFF = 131072 + 11264, GWTAB_OFF = ROWTAB_OFF + 2048;
template <class Epi, class Sched, bool GATHER>
__device__ __forceinline__ void gemm_phase(LAS unsigned char* lds, const int tid, const Gemm g, const Sched& S, const Epi& E) {
    const int wid = __builtin_amdgcn_readfirstlane(tid >> 6), lane = tid & 63, wr = wid >> 2, wc = wid & 3, fr = lane & 15, fq = lane >> 4;
    const int K = g.K, nt = K / BK;
    int sR, sC; stage_rc(tid * 16, sR, sC);
    const unsigned voffA = (unsigned)(sR * K + sC) * 2u;
    const unsigned voffB = (unsigned)((Epi::PERM ? ((sR & ~31) + perm32(sR & 31)) : sR) * K + sC) * 2u;
    const size_t kstep = (size_t)(BK * 2);
    const size_t pstep = (size_t)64 * K * 2;
    const size_t hstep = (size_t)HALF * K * 2;
    const unsigned ldsw = (unsigned)wid * 1024u;
    const int aoff = lds_byte(wr * 64 + fr, fq * 8), boff = lds_byte(wc * 32 + fr, fq * 8);
    LAS unsigned* rowtab = (LAS unsigned*)(lds + ROWTAB_OFF);
#define PG8_SA(b, h) (((b) * 2 + (h)) * HTB)
#define PG8_SB(b, h) ((4 + (b) * 2 + (h)) * HTB)
#define PG8_STAGE(bufoff, gbase, voff) do { _Pragma("unroll") for (int _i = 0; _i < 2; ++_i) { const char* _gb = (const char*)(gbase) + _i * pstep; asm volatile("" : "+s"(_gb));   \
        __builtin_amdgcn_global_load_lds((const unsigned*)(_gb + (voff)), (LAS unsigned*)(lds + (bufoff) + ldsw + _i * 8192), 16, 0, 0); } } while (0)
#define PG8_STAGE_G(bufoff, kb, sel, h) do { _Pragma("unroll") for (int _i = 0; _i < 2; ++_i) { const unsigned _ro = rowtab[(sel) * 256 + (h) * HALF + sR + 64 * _i] + (unsigned)(sC * 2); const char* _gb = (const char*)(kb); asm volatile("" : "+s"(_gb)); \
        __builtin_amdgcn_global_load_lds((const unsigned*)(_gb + _ro), (LAS unsigned*)(lds + (bufoff) + ldsw + _i * 8192), 16, 0, 0); } } while (0)
#define PG8_STAGE_A(bufoff, basep, kb, sel, h) do { if constexpr (GATHER) PG8_STAGE_G(bufoff, (const char*)g.A + (kb), sel, h); else PG8_STAGE(bufoff, (basep) + (kb) + (h) * hstep, voffA); } while (0)
#define PG8_ROWTAB(sel, u) do { if (tid < 256) { const int _rr = tid < (u).nrows ? tid : (u).nrows - 1; rowtab[(sel) * 256 + tid] = (unsigned)g.list[(u).x0 + _rr] * (unsigned)(K * 2); } } while (0)
#define PG8_LDA(dst, b, h) do { _Pragma("unroll") for (int m = 0; m < 4; ++m) _Pragma("unroll") for (int k = 0; k < 2; ++k) dst[m][k] = *(const LAS bf16x8*)(lds + PG8_SA(b, h) + aoff + m * 2048 + k * 1024); } while (0)
#define PG8_LDB(dst, b, h) do { _Pragma("unroll") for (int n = 0; n < 2; ++n) _Pragma("unroll") for (int k = 0; k < 2; ++k) dst[n][k] = *(const LAS bf16x8*)(lds + PG8_SB(b, h) + boff + n * 2048 + k * 1024); } while (0)
#define PG8_MMA(ai, bj, At, Bt) do { __builtin_amdgcn_s_setprio(1); _Pragma("unroll") for (int m = 0; m < 4; ++m) _Pragma("unroll") for (int n = 0; n < 2; ++n) _Pragma("unroll") for (int k = 0; k < 2; ++k) \
        acc[ai][bj][m][n] = __builtin_amdgcn_mfma_f32_16x16x32_bf16(Bt[n][k], At[m][k], acc[ai][bj][m][n], 0, 0, 0); __builtin_amdgcn_s_setprio(0); } while (0)
#define PG8_WAIT_V(n) asm volatile("s_waitcnt vmcnt(" #n ")" ::: "memory")
#define PG8_WAIT_L(n) asm volatile("s_waitcnt lgkmcnt(" #n ")" ::: "memory")
#define PG8_BAR __builtin_amdgcn_s_barrier()
#define PG8_SCHED __builtin_amdgcn_sched_barrier(0)
    Unit cur, nxt; int ui = 0;
    if (!S.next(0, cur)) return;
    f32x4 acc[2][2][4][2];
#pragma unroll
    for (int a = 0; a < 2; ++a)
#pragma unroll
        for (int b = 0; b < 2; ++b)
#pragma unroll
            for (int m = 0; m < 4; ++m)
#pragma unroll
                for (int n = 0; n < 2; ++n) acc[a][b][m][n] = (f32x4){0.f, 0.f, 0.f, 0.f};
    bf16x8 At[4][2], B0[2][2], B1[2][2];
    int par = 0;
    if constexpr (GATHER) { PG8_ROWTAB(0, cur); asm volatile("s_waitcnt vmcnt(0) lgkmcnt(0)" ::: "memory"); __syncthreads(); }
    const char* cA = (const char*)g.A + (size_t)cur.a0 * K * 2;
    const char* cB = (const char*)g.Bt + (size_t)cur.b0 * K * 2;
    PG8_STAGE(PG8_SB(0, 0), cB, voffB); PG8_STAGE(PG8_SB(0, 1), cB + hstep, voffB); PG8_STAGE_A(PG8_SA(0, 0), cA, 0, 0, 0); PG8_STAGE_A(PG8_SA(0, 1), cA, 0, 0, 1);
    if (wr == 1) PG8_BAR;
    PG8_WAIT_V(2); PG8_BAR;
    PG8_STAGE(PG8_SB(1, 0), cB + kstep, voffB); PG8_STAGE_A(PG8_SA(1, 0), cA, kstep, 0, 0); PG8_STAGE(PG8_SB(1, 1), cB + hstep + kstep, voffB);
    PG8_WAIT_V(6); PG8_BAR;
    for (;;) {
        const bool has_next = S.next(ui + 1, nxt);
        if constexpr (GATHER) { if (has_next) { PG8_ROWTAB(par ^ 1, nxt); asm volatile("s_waitcnt vmcnt(0) lgkmcnt(0)" ::: "memory"); } }
        const char* nA = has_next ? (const char*)g.A + (size_t)nxt.a0 * K * 2 : cA;
        const char* nB = has_next ? (const char*)g.Bt + (size_t)nxt.b0 * K * 2 : cB;
        const int npar = has_next ? (par ^ 1) : par;
        for (int t = 0; t < nt; t += 2) {
            if constexpr (Epi::HAS_MID) { if (t == nt / 2) E.mid(acc, cur, wr, wc, fr, fq); }
            const bool last = (t == nt - 2);
            const size_t k1 = (size_t)(t + 1) * kstep;
            const char* a2 = last ? nA : cA; const size_t k2 = last ? 0 : (size_t)(t + 2) * kstep; const char* b2 = last ? nB : cB + (size_t)(t + 2) * kstep;
            const size_t k3 = k2 + kstep; const char* b3 = b2 + kstep;
            const int p2 = last ? npar : par;
            PG8_LDB(B0, 0, 0); PG8_LDB(B1, 0, 1); PG8_SCHED; PG8_LDA(At, 0, 0); PG8_STAGE_A(PG8_SA(1, 1), cA, k1, par, 1);
            PG8_WAIT_V(8); PG8_WAIT_L(0); PG8_BAR; PG8_MMA(0, 0, At, B0); PG8_MMA(0, 1, At, B1); PG8_BAR; PG8_SCHED;
            PG8_LDA(At, 0, 1); PG8_STAGE(PG8_SB(0, 0), b2, voffB); PG8_STAGE(PG8_SB(0, 1), b2 + hstep, voffB); PG8_STAGE_A(PG8_SA(0, 0), a2, k2, p2, 0);
            PG8_WAIT_V(8); PG8_WAIT_L(0); PG8_BAR; PG8_MMA(1, 0, At, B0); PG8_MMA(1, 1, At, B1); PG8_BAR; PG8_SCHED;
            PG8_LDB(B0, 1, 0); PG8_LDB(B1, 1, 1); PG8_SCHED; PG8_LDA(At, 1, 0); PG8_STAGE_A(PG8_SA(0, 1), a2, k2, p2, 1);
            PG8_WAIT_V(8); PG8_WAIT_L(0); PG8_BAR; PG8_MMA(0, 0, At, B0); PG8_MMA(0, 1, At, B1); PG8_BAR; PG8_SCHED;
            PG8_LDA(At, 1, 1); PG8_STAGE(PG8_SB(1, 0), b3, voffB); PG8_STAGE(PG8_SB(1, 1), b3 + hstep, voffB); PG8_STAGE_A(PG8_SA(1, 0), a2, k3, p2, 0);
            PG8_WAIT_V(8); PG8_WAIT_L(0); PG8_BAR; PG8_MMA(1, 0, At, B0); PG8_MMA(1, 1, At, B1); PG8_BAR; PG8_SCHED;
        }
        if (wr == 0) PG8_BAR;
        E(acc, cur, wr, wc, fr, fq);
        if (!has_next) break;
#pragma unroll
        for (int a = 0; a < 2; ++a)
#pragma unroll
            for (int b = 0; b < 2; ++b)
#pragma unroll
                for (int m = 0; m < 4; ++m)
#pragma unroll
                    for (int n = 0; n < 2; ++n) acc[a][b][m][n] = (f32x4){0.f, 0.f, 0.f, 0.f};
        cur = nxt; cA = nA; cB = nB; par = npar; ++ui;
        if (wr == 1) PG8_BAR;
    }
    PG8_WAIT_V(0);
    PG8_BAR;
#undef PG8_SA
#undef PG8_SB
#undef PG8_STAGE
#undef PG8_STAGE_G
#undef PG8_STAGE_A
#undef PG8_ROWTAB
#undef PG8_LDA
#undef PG8_LDB
#undef PG8_MMA
#undef PG8_WAIT_V
#undef PG8_WAIT_L
#undef PG8_BAR
#undef PG8_SCHED
}
}

#define XB_TMO      128
#define XB_XCNT(j)  (256  + 64 * (j))
#define XB_XSUB(j)  (1280 + 64 * (j))
#define XB_XGEN(j)  (2304 + 64 * (j))
#define XB_TOP      3328
#define XB_TOPGEN   3392
#define XCD_BAR_WORDS 3456
#define XB_SPIN_CAP (1u << 18)
__device__ __forceinline__ unsigned xb_ld(unsigned* p)              { return __hip_atomic_load(p, __ATOMIC_RELAXED, __HIP_MEMORY_SCOPE_AGENT); }
__device__ __forceinline__ unsigned xb_add(unsigned* p, unsigned v) { return __hip_atomic_fetch_add(p, v, __ATOMIC_RELAXED, __HIP_MEMORY_SCOPE_AGENT); }
__device__ __forceinline__ unsigned xb_xcc_id() { return (unsigned)__builtin_amdgcn_s_getreg((3 << 11) | 20) & 0xFu; }
#define XB_SPIN(cond, bar) do { unsigned _sp = 0; while (cond) { __builtin_amdgcn_s_sleep(1); \
    if ((++_sp & 255u) == 0u) { if (xb_ld(&(bar)[XB_TMO])) break; if (_sp > XB_SPIN_CAP) { atomicAdd(&(bar)[XB_TMO], 1u); break; } } } } while (0)
struct XcdBarrier { unsigned* bar; unsigned x; volatile LAS unsigned* st; };
__device__ __forceinline__ XcdBarrier xcd_barrier_post(unsigned* bar, volatile LAS unsigned* st) {
    XcdBarrier b; b.bar = bar; b.x = xb_xcc_id(); b.st = st;
    if (threadIdx.x == 0) (void)xb_add(&bar[XB_XCNT(b.x)], 1u);
    return b;
}
__device__ __forceinline__ void xcd_barrier_complete(unsigned* bar, unsigned x, unsigned& nloc, unsigned& nx) {
    const unsigned G = gridDim.x * gridDim.y * gridDim.z;
    unsigned sum, cnt, mine, sp = 0u;
    for (;;) {
        sum = 0u; cnt = 0u; mine = 0u;
#pragma unroll
        for (unsigned j = 0; j < 16; ++j) { const unsigned c = xb_ld(&bar[XB_XCNT(j)]); sum += c; cnt += (c > 0u) ? 1u : 0u; mine = (j == x) ? c : mine; }
        if (sum == G) break;
        __builtin_amdgcn_s_sleep(1);
        if ((++sp & 255u) == 0u) { if (xb_ld(&bar[XB_TMO])) break; if (sp > XB_SPIN_CAP) { atomicAdd(&bar[XB_TMO], 1u); break; } }
    }
    nloc = mine > 0u ? mine : 1u; nx = cnt > 0u ? cnt : 1u;
}
__device__ __forceinline__ void xcd_barrier(const XcdBarrier& b, const int tid) {
    asm volatile("s_waitcnt vmcnt(0)" ::: "memory");
    __syncthreads();
    if (tid == 0) {
        unsigned* bar = b.bar;
        __builtin_amdgcn_s_waitcnt(0);
        unsigned nloc = b.st[0], nx = b.st[1];
        if (nloc == 0u) { xcd_barrier_complete(bar, b.x, nloc, nx); b.st[0] = nloc; b.st[1] = nx; }
        const unsigned old = xb_add(&bar[XB_XSUB(b.x)], 1u);
        const unsigned gen = old / nloc;
        if (old + 1u == (gen + 1u) * nloc) {
            __builtin_amdgcn_fence(__ATOMIC_RELEASE, "agent");
            asm volatile("s_waitcnt vmcnt(0)" ::: "memory");
            const unsigned og = xb_add(&bar[XB_TOP], 1u);
            const unsigned tg = og / nx;
            if (og + 1u == (tg + 1u) * nx) xb_add(&bar[XB_TOPGEN], 1u);
            else XB_SPIN(xb_ld(&bar[XB_TOPGEN]) == tg, bar);
            __builtin_amdgcn_fence(__ATOMIC_ACQUIRE, "agent");
            xb_add(&bar[XB_XGEN(b.x)], 1u);
            asm volatile("s_waitcnt vmcnt(0)" ::: "memory");
        } else {
            XB_SPIN(xb_ld(&bar[XB_XGEN(b.x)]) == gen, bar);
            __builtin_amdgcn_fence(__ATOMIC_ACQUIRE, "agent");
            asm volatile("s_waitcnt vmcnt(0)" ::: "memory");
        }
    }
    __syncthreads();
}

struct Args { const float* in[N_IN]; float* out; unsigned char* ws; int ph_lo, ph_hi; };
struct Frame {
    LAS unsigned char* lds;
    int tid, lane, wave, G, bid;
    const float* const __attribute__((address_space(4)))* in; float* out; unsigned char* ws;
};
__device__ __forceinline__ const float* mod_ptr(const Frame& F, int l, int b, int part) { return (const float*)(F.ws + WS_MOD) + ((size_t)(l * NB + b) * 6 + part) * D; }

__device__ __forceinline__ void transpose_item(const float* W, int N, int k0, int n0, bf16* WT, int ldo, int drow0, int dcol0, LAS float* scr, int lane) {
    float tv[32];
#pragma unroll
    for (int i = 0; i < 32; ++i) tv[i] = W[(size_t)(k0 + 2 * i + (lane >> 5)) * N + n0 + (lane & 31)];
#pragma unroll
    for (int i = 0; i < 32; ++i) scr[(2 * i + (lane >> 5)) * 33 + (lane & 31)] = tv[i];
    LDS_WAIT(); asm volatile("" ::: "memory");
    const int c = lane & 7;
#pragma unroll
    for (int j = 0; j < 4; ++j) { const int n = (lane >> 3) + 8 * j; const LAS float* s = scr + (8 * c) * 33 + n;
        v4u o; o.x = pk2(s[0 * 33], s[1 * 33]); o.y = pk2(s[2 * 33], s[3 * 33]); o.z = pk2(s[4 * 33], s[5 * 33]); o.w = pk2(s[6 * 33], s[7 * 33]);
        *(GAS v4u*)(WT + (size_t)(drow0 + n) * ldo + dcol0 + k0 + 8 * c) = o; }
    LDS_WAIT(); asm volatile("" ::: "memory");
}
__device__ __forceinline__ int titems(int K, int N) { return (K / 64) * (N / 32); }
__device__ __forceinline__ void tdo(const float* W, int K, int N, int item, bf16* WT, int ldo, int drow0, LAS float* scr, int lane) {
    const int nblk = N / 32, kb = item / nblk, nb = item % nblk; transpose_item(W, N, 64 * kb, 32 * nb, WT, ldo, drow0 + 32 * nb, 0, scr, lane);
}

__device__ __forceinline__ void phase_mix_weights(Frame& F, int gw, int NGW) {
    LAS float* scr = (LAS float*)(F.lds + 65536 + F.wave * 8704);
    constexpr int T_WIN = (D / 64) * (DIN / 32), T_PC = (CW / 64) * (D / 32), T_PR = (RW / 64) * (D / 32), T_WO = (D / 64) * (D / 32), T_L = T_WIN + T_PC + T_PR + T_WO;
    for (int it = gw; it < DEPTH * T_L; it += NGW) {
        const int l = it / T_L; int r = it % T_L; unsigned char* wm = F.ws + WS_WMIX + (size_t)l * WMIX_STRIDE;
        if (r < T_WIN) { tdo(F.in[I_WIN] + (size_t)l * D * DIN, D, DIN, r, (bf16*)(wm + WM_WIN), D, 0, scr, F.lane); continue; } r -= T_WIN;
        if (r < T_PC) { tdo(F.in[I_PCONV] + (size_t)l * CW * D, CW, D, r, (bf16*)(wm + WM_PCONV), D, 0, scr, F.lane); continue; } r -= T_PC;
        if (r < T_PR) { tdo(F.in[I_PRWKV] + (size_t)l * RW * D, RW, D, r, (bf16*)(wm + WM_PCONV) + CW, D, 0, scr, F.lane); continue; } r -= T_PR;
        tdo(F.in[I_WO] + (size_t)l * D * D, D, D, r, (bf16*)(wm + WM_WO), D, 0, scr, F.lane);
    }
    for (int i = gw * 64 + F.lane; i < DEPTH * NLORA * KLORA; i += NGW * 64) {
        const int l = i / (NLORA * KLORA), r = i % (NLORA * KLORA), n = r / KLORA, k = r % KLORA; float v = 0.f;
        if (n < 512) { if (k < 64) v = F.in[I_W2][((size_t)l * LW + k) * RW + n]; }
        else if (n < 1024) { if (k >= 64 && k < 128) v = F.in[I_A2][((size_t)l * LA + (k - 64)) * RW + (n - 512)]; }
        else { if (k >= 128) v = F.in[I_G2][((size_t)l * LG + (k - 128)) * RW + (n - 1024)]; }
        ((bf16*)(F.ws + WS_WMIX + (size_t)l * WMIX_STRIDE + WM_LORA))[r] = (bf16)f2bf(v);
    }
}
__device__ __forceinline__ void phase_expert_weights(Frame& F, int l, int gw, int NGW) {
    LAS float* scr = (LAS float*)(F.lds + 65536 + F.wave * 8704);
    bf16* WGU = (bf16*)(F.ws + WS_WGU); bf16* WDN = (bf16*)(F.ws + WS_WDN);
    constexpr int T_G = (D / 64) * (DE / 32), T_D = (DE / 64) * (D / 32), T_E = 2 * T_G + T_D;
    for (int it = gw; it < (NE + 1) * T_E; it += NGW) {
        const int e = it / T_E; int r = it % T_E;
        if (r < 2 * T_G) { const int up = r >= T_G; if (up) r -= T_G;
            const float* W = (e < NE) ? (up ? F.in[I_WEU] : F.in[I_WEG]) + ((size_t)l * NE + e) * D * DE : (up ? F.in[I_WSU] : F.in[I_WSG]) + (size_t)l * D * DE;
            const int nblk = DE / 32, kb = r / nblk, nb = r % nblk, n0 = 32 * nb;
            const int drow0 = e * 512 + (n0 >> 7) * 256 + (up ? 128 : 0) + (n0 & 127);
            transpose_item(W, DE, 64 * kb, n0, WGU, D, drow0, 0, scr, F.lane);
        } else { r -= 2 * T_G;
            const float* W = (e < NE) ? F.in[I_WED] + ((size_t)l * NE + e) * DE * D : F.in[I_WSD] + (size_t)l * DE * D;
            tdo(W, DE, D, r, WDN, DE, e * D, scr, F.lane);
        }
    }
}
__device__ __forceinline__ void phase_ada(Frame& F) {
    LAS float* sc = (LAS float*)F.lds;
    LAS float* red = (LAS float*)(F.lds + 32768);
    for (int i = F.tid; i < NB * D; i += NTHREADS) { const int b = i / D, k = i % D; sc[k * 8 + b] = siluf_(F.in[I_C][i]); }
    __syncthreads();
    float* mod = (float*)(F.ws + WS_MOD);
    for (int it = F.bid; it < DEPTH * 96; it += F.G) {
        const int l = it / 96, n0 = (it % 96) * 64;
        float acc[8];
#pragma unroll
        for (int b = 0; b < 8; ++b) acc[b] = 0.f;
        const float* wp = F.in[I_WADA] + ((size_t)l * D + F.wave * 128) * (6 * D) + n0 + F.lane;
#pragma unroll 4
        for (int k = 0; k < 128; ++k) { const float wv = wp[(size_t)k * (6 * D)]; const LAS f32x4* s = (const LAS f32x4*)(sc + (F.wave * 128 + k) * 8); const f32x4 s0 = s[0], s1 = s[1];
            acc[0] += s0[0] * wv; acc[1] += s0[1] * wv; acc[2] += s0[2] * wv; acc[3] += s0[3] * wv; acc[4] += s1[0] * wv; acc[5] += s1[1] * wv; acc[6] += s1[2] * wv; acc[7] += s1[3] * wv; }
#pragma unroll
        for (int b = 0; b < 8; ++b) red[(F.wave * 8 + b) * 64 + F.lane] = acc[b];
        __syncthreads();
        { const int b = F.tid >> 6; float s = F.in[I_BADA][(size_t)l * 6 * D + n0 + F.lane];
#pragma unroll
          for (int w = 0; w < 8; ++w) s += red[(w * 8 + b) * 64 + F.lane];
          mod[((size_t)l * NB + b) * 6 * D + n0 + F.lane] = s; }
        __syncthreads();
    }
}

struct Row { f32x4 v[4]; };
__device__ __forceinline__ Row row_load(const float* p, int lane) { Row r; const f32x4* q = (const f32x4*)p + lane;
#pragma unroll
    for (int j = 0; j < 4; ++j) r.v[j] = q[64 * j]; return r; }
__device__ __forceinline__ void row_store(float* p, int lane, const Row& r) { f32x4* q = (f32x4*)p + lane;
#pragma unroll
    for (int j = 0; j < 4; ++j) q[64 * j] = r.v[j]; }
__device__ __forceinline__ float row_sumsq(const Row& r) { float s = 0.f;
#pragma unroll
    for (int j = 0; j < 4; ++j) s += (r.v[j][0] * r.v[j][0] + r.v[j][1] * r.v[j][1]) + (r.v[j][2] * r.v[j][2] + r.v[j][3] * r.v[j][3]); return wave_sum(s); }
__device__ __forceinline__ Row row_modnorm(const Row& x, const float* g, const float* sc, const float* sh, int lane) {
    const float rs = rsqrtf(row_sumsq(x) * (1.0f / D) + RMS_EPS); Row gg = row_load(g, lane), s1 = row_load(sc, lane), s0 = row_load(sh, lane), h;
#pragma unroll
    for (int j = 0; j < 4; ++j) h.v[j] = x.v[j] * rs * gg.v[j] * (1.0f + s1.v[j]) + s0.v[j]; return h; }
__device__ __forceinline__ void row_store_bf16(bf16* p, int lane, const Row& r) { v2u* q = (v2u*)p + lane;
#pragma unroll
    for (int j = 0; j < 4; ++j) { v2u w; w.x = pk2(r.v[j][0], r.v[j][1]); w.y = pk2(r.v[j][2], r.v[j][3]); q[64 * j] = w; } }

__device__ __forceinline__ Row row_load_bf16(const bf16* p, int lane) { Row r; const v2u* q = (const v2u*)p + lane;
#pragma unroll
    for (int j = 0; j < 4; ++j) { const v2u w = q[64 * j]; r.v[j] = (f32x4){bflo(w.x), bfhi(w.x), bflo(w.y), bfhi(w.y)}; } return r; }
__device__ __forceinline__ void phase_rowA(Frame& F, int gw, int NGW) {
    bf16* H = (bf16*)(F.ws + WS_H);
    for (int m = gw; m < M; m += NGW) { const int b = m / SEQ; Row x = row_load(F.in[I_X] + (size_t)m * D, F.lane);
        Row h = row_modnorm(x, F.in[I_NMPRE], mod_ptr(F, 0, b, 1), mod_ptr(F, 0, b, 0), F.lane); row_store_bf16(H + (size_t)m * D, F.lane, h); }
}

__device__ __forceinline__ void phase_conv(Frame& F, int l) {
    const bf16* Z = (const bf16*)(F.ws + WS_ZC); bf16* UC = (bf16*)(F.ws + WS_UC);
    LAS float* tile = (LAS float*)F.lds;
    const int c = F.tid;
    float w[CKW];
#pragma unroll
    for (int j = 0; j < CKW; ++j) w[j] = F.in[I_CONVW][((size_t)l * CKW + j) * CW + c];
    const float bias = F.in[I_CONVB][l * CW + c];
    for (int ti = F.bid; ti < M / 32; ti += F.G) {
        const int t0 = ti * 32, s0 = t0 % SEQ;
        float u[62];
#pragma unroll
        for (int i = 0; i < 62; ++i) { const bool ok = (s0 - 30 + i >= 0); const bf16* zr = Z + (size_t)(ok ? t0 - 30 + i : t0) * ZCW;
            const float a = bf2f(zr[c]), gt_ = bf2f(zr[CW + c]); u[i] = ok ? a * sigmoidf_(gt_) : 0.f; }
#pragma unroll
        for (int o = 0; o < 32; ++o) { float a = bias;
#pragma unroll
            for (int j = 0; j < CKW; ++j) a += u[o + j] * w[j];
            tile[o * CW + c] = a; }
        __syncthreads();
#pragma unroll
        for (int q = 0; q < 4; ++q) { const int o = 4 * F.wave + q; float v[8]; float s = 0.f;
#pragma unroll
            for (int i = 0; i < 8; ++i) { v[i] = tile[o * CW + F.lane + 64 * i]; s += v[i]; }
            const float mean = wave_sum(s) * (1.0f / CW); float s2 = 0.f;
#pragma unroll
            for (int i = 0; i < 8; ++i) { v[i] -= mean; s2 += v[i] * v[i]; }
            const float rstd = rsqrtf(wave_sum(s2) * (1.0f / CW) + LN_EPS);
#pragma unroll
            for (int i = 0; i < 8; ++i) { const int cc = F.lane + 64 * i; const float y = v[i] * rstd * F.in[I_CLNG][l * CW + cc] + F.in[I_CLNB][l * CW + cc];
                UC[(size_t)(t0 + o) * D + cc] = (bf16)f2bf(siluf_(y)); } }
        __syncthreads();
    }
}
__device__ __forceinline__ void phase_prep1(Frame& F, int l, int gw, int NGW) {
    const bf16* Z = (const bf16*)(F.ws + WS_ZR); bf16* LIN = (bf16*)(F.ws + WS_LIN);
    const f32x4 mu = *((const f32x4*)(F.in[I_MU] + (size_t)l * COLR + 1536) + F.lane);
    for (int m = gw; m < M; m += NGW) {
        const int s = m % SEQ; const v2u cur = *((const v2u*)(Z + (size_t)m * ZRW + 1536) + F.lane);
        v2u prv = *((const v2u*)(Z + (size_t)(s > 0 ? m - 1 : m) * ZRW + 1536) + F.lane); if (s == 0) { prv.x = 0u; prv.y = 0u; }
        float x[4] = {bflo(cur.x), bfhi(cur.x), bflo(cur.y), bfhi(cur.y)}; const float p[4] = {bflo(prv.x), bfhi(prv.x), bflo(prv.y), bfhi(prv.y)};
#pragma unroll
        for (int i = 0; i < 4; ++i) { x[i] = x[i] + (p[i] - x[i]) * mu[i]; if (F.lane < 16) x[i] = tanhf(x[i]); else if (F.lane >= 32) x[i] = sigmoidf_(x[i]); }
        v2u o; o.x = pk2(x[0], x[1]); o.y = pk2(x[2], x[3]); *((v2u*)(LIN + (size_t)m * KLORA) + F.lane) = o;
    }
}
__device__ __forceinline__ void ld8bf(const bf16* p, float (&o)[8]) { const v4u w = *(const v4u*)p; o[0] = bflo(w.x); o[1] = bfhi(w.x); o[2] = bflo(w.y); o[3] = bfhi(w.y); o[4] = bflo(w.z); o[5] = bfhi(w.z); o[6] = bflo(w.w); o[7] = bfhi(w.w); }
__device__ __forceinline__ void st8bf(bf16* p, const float (&o)[8]) { v4u w; w.x = pk2(o[0], o[1]); w.y = pk2(o[2], o[3]); w.z = pk2(o[4], o[5]); w.w = pk2(o[6], o[7]); *(v4u*)p = w; }
__device__ __forceinline__ void ld8f(const float* p, float (&o)[8]) { const f32x4 a = *(const f32x4*)p, b = *((const f32x4*)p + 1); o[0] = a[0]; o[1] = a[1]; o[2] = a[2]; o[3] = a[3]; o[4] = b[0]; o[5] = b[1]; o[6] = b[2]; o[7] = b[3]; }
__device__ __forceinline__ float grp8_sum(float v) { v += __shfl_xor(v, 1); v += __shfl_xor(v, 2); v += __shfl_xor(v, 4); return v; }
__device__ __forceinline__ void phase_prep2(Frame& F, int l, int gw, int NGW) {
    const bf16* Z = (const bf16*)(F.ws + WS_ZR); const bf16* LOUT = (const bf16*)(F.ws + WS_LOUT);
    bf16* SR = (bf16*)(F.ws + WS_SR); bf16* SKP = (bf16*)(F.ws + WS_SKP); bf16* SV = (bf16*)(F.ws + WS_SV); bf16* SKKN = (bf16*)(F.ws + WS_SKKN); bf16* SKA = (bf16*)(F.ws + WS_SKA);
    float* SDEC = (float*)(F.ws + WS_SDEC); float* BONUS = (float*)(F.ws + WS_BONUS);
    const int c = 8 * F.lane;
    float mur[8], muk[8], muv[8], w0[8], a0[8], kkw[8], kaw[8], rkw[8];
    ld8f(F.in[I_MU] + (size_t)l * COLR + c, mur); ld8f(F.in[I_MU] + (size_t)l * COLR + 512 + c, muk); ld8f(F.in[I_MU] + (size_t)l * COLR + 1024 + c, muv);
    ld8f(F.in[I_W0] + l * RW + c, w0); ld8f(F.in[I_A0] + l * RW + c, a0); ld8f(F.in[I_KK] + l * RW + c, kkw); ld8f(F.in[I_KA] + l * RW + c, kaw); ld8f(F.in[I_RK] + l * RW + c, rkw);
    for (int m = gw; m < M; m += NGW) {
        const int s = m % SEQ; const bf16* zr = Z + (size_t)m * ZRW + c;
        float r[8], k[8], v[8], pr[8], pk[8], pv[8], lw[8], la[8];
        ld8bf(zr, r); ld8bf(zr + 512, k); ld8bf(zr + 1024, v);
        { const bf16* zp = (s > 0) ? zr - ZRW : zr; ld8bf(zp, pr); ld8bf(zp + 512, pk); ld8bf(zp + 1024, pv); }
        if (s == 0) {
#pragma unroll
            for (int i = 0; i < 8; ++i) { pr[i] = 0.f; pk[i] = 0.f; pv[i] = 0.f; } }
        ld8bf(LOUT + (size_t)m * NLORA + c, lw); ld8bf(LOUT + (size_t)m * NLORA + 512 + c, la);
        float dec[8], kp[8], kk[8], ka[8]; float ss = 0.f, bo = 0.f;
#pragma unroll
        for (int i = 0; i < 8; ++i) {
            r[i] += (pr[i] - r[i]) * mur[i]; k[i] += (pk[i] - k[i]) * muk[i]; v[i] += (pv[i] - v[i]) * muv[i];
            dec[i] = __expf(-0.60653066f * sigmoidf_(w0[i] + lw[i]));
            const float a = sigmoidf_(a0[i] + la[i]);
            kk[i] = k[i] * kkw[i]; kp[i] = k[i] * (1.0f + (a - 1.0f) * kaw[i]); ka[i] = a;
            ss += kk[i] * kk[i]; bo += r[i] * kp[i] * rkw[i];
        }
        ss = grp8_sum(ss); bo = grp8_sum(bo);
        const float inv = rsqrtf(fmaxf(ss, 1e-24f));
#pragma unroll
        for (int i = 0; i < 8; ++i) { kk[i] *= inv; ka[i] *= kk[i]; }
        const size_t o = (size_t)m * RW + c;
        st8bf(SR + o, r); st8bf(SKP + o, kp); st8bf(SV + o, v); st8bf(SKKN + o, kk); st8bf(SKA + o, ka);
        *(f32x4*)(SDEC + o) = (f32x4){dec[0], dec[1], dec[2], dec[3]}; *((f32x4*)(SDEC + o) + 1) = (f32x4){dec[4], dec[5], dec[6], dec[7]};
        if ((F.lane & 7) == 0) BONUS[(size_t)m * NH + (F.lane >> 3)] = bo;
    }
}
__device__ __forceinline__ void phase_scan(Frame& F) {
    const bf16* SR = (const bf16*)(F.ws + WS_SR); const bf16* SKP = (const bf16*)(F.ws + WS_SKP); const bf16* SV = (const bf16*)(F.ws + WS_SV);
    const bf16* SKKN = (const bf16*)(F.ws + WS_SKKN); const bf16* SKA = (const bf16*)(F.ws + WS_SKA); const float* SDEC = (const float*)(F.ws + WS_SDEC);
    float* YS = (float*)(F.ws + WS_YS);
    LAS float* buf = (LAS float*)F.lds;
    const int vr = F.lane >> 3, ke = F.lane & 7, vidx = 8 * F.wave + vr;
    for (int bh = F.bid; bh < NB * NH; bh += F.G) {
        const int b = bh / NH, h = bh % NH; const size_t m0 = (size_t)b * SEQ;
        float S[8];
#pragma unroll
        for (int i = 0; i < 8; ++i) S[i] = 0.f;
        for (int c0 = 0; c0 < SEQ; c0 += 64) {
            __syncthreads();
            for (int idx = F.tid; idx < 64 * 64; idx += NTHREADS) { const int t = idx >> 6, k = idx & 63; const size_t g = (m0 + c0 + t) * RW + h * RH + k; LAS float* d = buf + t * 384 + k;
                d[0] = bf2f(SR[g]); d[64] = SDEC[g]; d[128] = bf2f(SKP[g]); d[192] = bf2f(SKKN[g]); d[256] = bf2f(SKA[g]); d[320] = bf2f(SV[g]); }
            __syncthreads();
            for (int t = 0; t < 64; ++t) {
                const LAS float* d = buf + t * 384 + ke * 8;
                float r[8], dc[8], kp[8], kn[8], ka[8];
#pragma unroll
                for (int i = 0; i < 8; ++i) { r[i] = d[i]; dc[i] = d[64 + i]; kp[i] = d[128 + i]; kn[i] = d[192 + i]; ka[i] = d[256 + i]; }
                const float v = buf[t * 384 + 320 + vidx];
                float sa = 0.f;
#pragma unroll
                for (int i = 0; i < 8; ++i) sa += S[i] * kn[i];
                sa = -grp8_sum(sa);
                float y = 0.f;
#pragma unroll
                for (int i = 0; i < 8; ++i) { S[i] = S[i] * dc[i] + sa * ka[i] + v * kp[i]; y += S[i] * r[i]; }
                y = grp8_sum(y);
                if (ke == 0) YS[(m0 + c0 + t) * RW + h * RH + vidx] = y;
            }
        }
    }
}
constexpr int CS = 72, CBUF = 64 * CS * 2;
__device__ __forceinline__ f32x4 cmm(const LAS bf16* A, const LAS bf16* B, int m0, int n0, int lane, f32x4 acc) {
#pragma unroll
    for (int ks = 0; ks < 2; ++ks) {
        const bf16x8 a = *(const LAS bf16x8*)(A + (m0 + (lane & 15)) * CS + ks * 32 + 8 * (lane >> 4));
        const bf16x8 b = *(const LAS bf16x8*)(B + (n0 + (lane & 15)) * CS + ks * 32 + 8 * (lane >> 4));
        acc = __builtin_amdgcn_mfma_f32_16x16x32_bf16(a, b, acc, 0, 0, 0);
    }
    return acc;
}
__device__ __forceinline__ void cst4(LAS bf16* O, int n, int m, const f32x4 v) { v2u w; w.x = pk2(v[0], v[1]); w.y = pk2(v[2], v[3]); *(LAS v2u*)(O + n * CS + m) = w; }
__device__ __forceinline__ f32x4 cld4(const LAS bf16* O, int n, int m) { const v2u w = *(const LAS v2u*)(O + n * CS + m); return (f32x4){bflo(w.x), bfhi(w.x), bflo(w.y), bfhi(w.y)}; }
__device__ __forceinline__ void phase_chunkprep(Frame& F, int l) {
    float* YS = (float*)(F.ws + WS_YS); bf16* CQ = (bf16*)(F.ws + WS_CQ); bf16* CG = (bf16*)(F.ws + WS_CG); float* CH = (float*)(F.ws + WS_CH);
#define CB(i) ((LAS bf16*)(F.lds + (i) * CBUF))
    LAS float* part = (LAS float*)(F.lds + 14 * CBUF);
    LAS float* pcs = part + 512;
    const int lane = F.lane, w = F.wave, n0 = 16 * (w & 3), mA = 32 * (w >> 2), nn = n0 + (lane & 15), mq = 4 * (lane >> 4);
    const bf16* ZRp = (const bf16*)(F.ws + WS_ZR); const bf16* LOUT = (const bf16*)(F.ws + WS_LOUT); bf16* SVo = (bf16*)(F.ws + WS_SV); float* BONUS = (float*)(F.ws + WS_BONUS);
    unsigned short zr_[9], zk_[9], zv_[9], lw_[8], la_[8]; float cst[8];
#define CP_LOAD(PAIR) do { const int bh_ = (PAIR) >> 5, c_ = (PAIR) & 31, h_ = bh_ & 7; const size_t mr_ = (size_t)(bh_ >> 3) * SEQ + c_ * 64 + 8 * w; const int hc_ = h_ * RH + lane; \
        _Pragma("unroll") for (int i = 0; i < 9; ++i) { const size_t row_ = (c_ == 0 && w == 0 && i == 0) ? mr_ : mr_ + i - 1; const bf16* z_ = ZRp + row_ * ZRW + hc_; zr_[i] = z_[0]; zk_[i] = z_[512]; zv_[i] = z_[1024]; } \
        _Pragma("unroll") for (int i = 0; i < 8; ++i) { const bf16* q_ = LOUT + (mr_ + i) * NLORA + hc_; lw_[i] = q_[0]; la_[i] = q_[512]; } \
        cst[0] = F.in[I_MU][(size_t)l * COLR + hc_]; cst[1] = F.in[I_MU][(size_t)l * COLR + 512 + hc_]; cst[2] = F.in[I_MU][(size_t)l * COLR + 1024 + hc_]; \
        cst[3] = F.in[I_W0][l * RW + hc_]; cst[4] = F.in[I_A0][l * RW + hc_]; cst[5] = F.in[I_KK][l * RW + hc_]; cst[6] = F.in[I_KA][l * RW + hc_]; cst[7] = F.in[I_RK][l * RW + hc_]; } while (0)
    if (F.bid < NB * NH * (SEQ / 64)) CP_LOAD(F.bid);
    for (int pair = F.bid; pair < NB * NH * (SEQ / 64); pair += F.G) {
        const int bh = pair >> 5, c = pair & 31, b = bh >> 3, h = bh & 7; const size_t m0 = (size_t)b * SEQ + c * 64;
        {
          float dc[8], kn[8], ka[8], kp[8], rr[8], vv[8], ss[8], bo[8];
          const bool first = (c == 0 && w == 0);
#pragma unroll
          for (int i = 0; i < 8; ++i) {
              const float pr = (first && i == 0) ? 0.f : bf2f(zr_[i]), pk = (first && i == 0) ? 0.f : bf2f(zk_[i]), pv = (first && i == 0) ? 0.f : bf2f(zv_[i]);
              float r = bf2f(zr_[i + 1]), k = bf2f(zk_[i + 1]), v = bf2f(zv_[i + 1]);
              r += (pr - r) * cst[0]; k += (pk - k) * cst[1]; v += (pv - v) * cst[2];
              dc[i] = __expf(-0.60653066f * sigmoidf_(cst[3] + bf2f(lw_[i])));
              const float a = sigmoidf_(cst[4] + bf2f(la_[i]));
              const float kk = k * cst[5]; kp[i] = k * (1.0f + (a - 1.0f) * cst[6]); rr[i] = r; vv[i] = v; kn[i] = kk; ka[i] = a;
              ss[i] = kk * kk; bo[i] = r * kp[i] * cst[7]; }
#pragma unroll
          for (int o = 1; o < 64; o <<= 1) {
#pragma unroll
              for (int i = 0; i < 8; ++i) { ss[i] += __shfl_xor(ss[i], o); bo[i] += __shfl_xor(bo[i], o); } }
#pragma unroll
          for (int i = 0; i < 8; ++i) { kn[i] *= rsqrtf(fmaxf(ss[i], 1e-24f)); ka[i] *= kn[i];
              SVo[(m0 + 8 * w + i) * RW + h * RH + lane] = (bf16)f2bf(vv[i]); if (lane == 0) BONUS[(m0 + 8 * w + i) * NH + h] = bo[i]; }
          float p[8]; p[0] = dc[0];
#pragma unroll
          for (int i = 1; i < 8; ++i) p[i] = p[i - 1] * dc[i];
          part[w * 64 + lane] = p[7];
          __syncthreads();
          float pre = 1.f, tot = 1.f;
#pragma unroll
          for (int g = 0; g < 8; ++g) { const float q = part[g * 64 + lane]; tot *= q; if (g < w) pre *= q; }
          if (w == 0) pcs[lane] = tot;
          float at[8], bt[8], kt[8], rt[8], bh_[8], kh[8];
#pragma unroll
          for (int i = 0; i < 8; ++i) { const float P = pre * p[i], Pm = (i == 0) ? pre : pre * p[i - 1], inv = 1.0f / P;
              at[i] = -kn[i] * Pm; bt[i] = ka[i] * inv; kt[i] = kp[i] * inv; rt[i] = rr[i] * P; bh_[i] = bt[i] * tot; kh[i] = kt[i] * tot; }
#pragma unroll
          for (int i = 0; i < 8; ++i) { const int o = (8 * w + i) * CS + lane; CB(0)[o] = (bf16)f2bf(at[i]); CB(1)[o] = (bf16)f2bf(bt[i]); CB(2)[o] = (bf16)f2bf(kt[i]); CB(3)[o] = (bf16)f2bf(rt[i]); }
          { const int o = lane * CS + 8 * w; v4u q;
            q.x = pk2(at[0], at[1]); q.y = pk2(at[2], at[3]); q.z = pk2(at[4], at[5]); q.w = pk2(at[6], at[7]); *(LAS v4u*)(CB(4) + o) = q;
            q.x = pk2(bh_[0], bh_[1]); q.y = pk2(bh_[2], bh_[3]); q.z = pk2(bh_[4], bh_[5]); q.w = pk2(bh_[6], bh_[7]); *(LAS v4u*)(CB(5) + o) = q;
            q.x = pk2(kh[0], kh[1]); q.y = pk2(kh[2], kh[3]); q.z = pk2(kh[4], kh[5]); q.w = pk2(kh[6], kh[7]); *(LAS v4u*)(CB(6) + o) = q;
            q.x = pk2(vv[0], vv[1]); q.y = pk2(vv[2], vv[3]); q.z = pk2(vv[4], vv[5]); q.w = pk2(vv[6], vv[7]); *(LAS v4u*)(CB(7) + o) = q; }
        }
        if (pair + F.G < NB * NH * (SEQ / 64)) CP_LOAD(pair + F.G);
        __syncthreads();
        const f32x4 z4 = (f32x4){0.f, 0.f, 0.f, 0.f};
#pragma unroll
        for (int tl = 0; tl < 2; ++tl) { const int m0t = mA + 16 * tl, mm = m0t + mq;
            f32x4 a1 = cmm(CB(1), CB(0), m0t, n0, lane, z4), a2 = cmm(CB(0), CB(1), m0t, n0, lane, z4), a3 = cmm(CB(2), CB(0), m0t, n0, lane, z4);
            f32x4 a4 = cmm(CB(1), CB(3), m0t, n0, lane, z4), a5 = cmm(CB(2), CB(3), m0t, n0, lane, z4), t0;
#pragma unroll
            for (int i = 0; i < 4; ++i) { const int m = mm + i; a1[i] = (m < nn) ? a1[i] : 0.f; a2[i] = (nn < m) ? a2[i] : 0.f; a3[i] = (m < nn) ? a3[i] : 0.f; a4[i] = (m <= nn) ? a4[i] : 0.f; a5[i] = (m <= nn) ? a5[i] : 0.f; t0[i] = a1[i] + ((m == nn) ? 1.f : 0.f); }
            cst4(CB(8), nn, mm, a1); cst4(CB(9), nn, mm, a2); cst4(CB(10), nn, mm, t0); cst4(CB(11), nn, mm, a3); cst4(CB(12), nn, mm, a4); cst4(CB(13), nn, mm, a5); }
        __syncthreads();
#pragma unroll
        for (int tl = 0; tl < 2; ++tl) { const int m0t = mA + 16 * tl, mm = m0t + mq;
            cst4(CB(0), nn, mm, cmm(CB(9), CB(8), m0t, n0, lane, z4)); cst4(CB(1), nn, mm, cmm(CB(8), CB(9), m0t, n0, lane, z4)); cst4(CB(2), nn, mm, cmm(CB(11), CB(7), m0t, n0, lane, z4)); }
        __syncthreads();
#define CSTEP(MP, MPT, MPN, MPTN, TI, TO, DO_MP, DO_MPT) do { _Pragma("unroll") for (int tl = 0; tl < 2; ++tl) { const int m0t = mA + 16 * tl, mm = m0t + mq; \
            if (DO_MP) cst4(CB(MPN), nn, mm, cmm(CB(MPT), CB(MP), m0t, n0, lane, z4)); if (DO_MPT) cst4(CB(MPTN), nn, mm, cmm(CB(MP), CB(MPT), m0t, n0, lane, z4)); \
            cst4(CB(TO), nn, mm, cmm(CB(MPT), CB(TI), m0t, n0, lane, cld4(CB(TI), nn, mm))); } __syncthreads(); } while (0)
        CSTEP(0, 1, 8, 9, 10, 11, true, true);
        CSTEP(8, 9, 0, 1, 11, 10, true, true);
        CSTEP(0, 1, 8, 9, 10, 11, true, true);
        CSTEP(8, 9, 0, 1, 11, 10, false, true);
        CSTEP(0, 1, 8, 9, 10, 11, false, false);
#undef CSTEP
#pragma unroll
        for (int tl = 0; tl < 2; ++tl) { const int m0t = mA + 16 * tl, mm = m0t + mq;
            cst4(CB(8), nn, mm, cmm(CB(11), CB(4), m0t, n0, lane, z4)); cst4(CB(9), nn, mm, cmm(CB(11), CB(2), m0t, n0, lane, z4)); }
        __syncthreads();
#pragma unroll
        for (int tl = 0; tl < 2; ++tl) { const int m0t = mA + 16 * tl, mm = m0t + mq;
            { const f32x4 q = cmm(CB(8), CB(12), m0t, n0, lane, cld4(CB(3), nn, mm)); v2u o; o.x = pk2(q[0], q[1]); o.y = pk2(q[2], q[3]); *(v2u*)(CQ + ((size_t)pair * 64 + nn) * 64 + mm) = o; }
            { const f32x4 y = cmm(CB(7), CB(13), m0t, n0, lane, cmm(CB(9), CB(12), m0t, n0, lane, z4)); *(f32x4*)(YS + (m0 + nn) * RW + h * RH + mm) = y; }
            { f32x4 g = cmm(CB(8), CB(5), m0t, n0, lane, z4);
#pragma unroll
              for (int i = 0; i < 4; ++i) g[i] += (mm + i == nn) ? pcs[nn] : 0.f;
              v2u o; o.x = pk2(g[0], g[1]); o.y = pk2(g[2], g[3]); *(v2u*)(CG + ((size_t)pair * 64 + nn) * 64 + mm) = o; }
            { const f32x4 hh = cmm(CB(7), CB(6), m0t, n0, lane, cmm(CB(9), CB(5), m0t, n0, lane, z4)); *(f32x4*)(CH + ((size_t)pair * 64 + nn) * 64 + mm) = hh; }
        }
        __syncthreads();
    }
#undef CB
#undef CP_LOAD
}
typedef float f32x16 __attribute__((ext_vector_type(16)));
__device__ __forceinline__ bf16x8 pack_frag(const f32x16& x, int s) {
    v4u w; w.x = pk2(x[8 * s + 0], x[8 * s + 1]); w.y = pk2(x[8 * s + 2], x[8 * s + 3]); w.z = pk2(x[8 * s + 4], x[8 * s + 5]); w.w = pk2(x[8 * s + 6], x[8 * s + 7]);
    return __builtin_bit_cast(bf16x8, w);
}
__device__ __forceinline__ bf16x8 ld_afrag(const bf16* rowp, int kbase, int hh) {
    const v2u lo = *(const v2u*)(rowp + kbase + 4 * hh), hi = *(const v2u*)(rowp + kbase + 8 + 4 * hh); v4u w; w.x = lo.x; w.y = lo.y; w.z = hi.x; w.w = hi.y; return __builtin_bit_cast(bf16x8, w);
}
__device__ __forceinline__ bf16x8 ld_afrag_lds(const LAS unsigned char* img, int row, int kbase, int hh) {
    const int k0 = kbase + 4 * hh, k1 = k0 + 8;
    const v2u lo = *(const LAS v2u*)(img + row * 128 + (((k0 >> 3) ^ (row & 7)) << 4) + ((k0 & 7) << 1));
    const v2u hi = *(const LAS v2u*)(img + row * 128 + (((k1 >> 3) ^ (row & 7)) << 4) + ((k1 & 7) << 1));
    v4u w; w.x = lo.x; w.y = lo.y; w.z = hi.x; w.w = hi.y; return __builtin_bit_cast(bf16x8, w);
}
__device__ __forceinline__ void phase_chunkscan(Frame& F) {
    float* YS = (float*)(F.ws + WS_YS); const bf16* CQ = (const bf16*)(F.ws + WS_CQ); const bf16* CG = (const bf16*)(F.ws + WS_CG); const float* CH = (const float*)(F.ws + WS_CH);
    const int lane = F.lane, r32 = lane & 31, hh = lane >> 5;
    const int per = (F.G >= 128) ? 1 : 2;
    LAS unsigned char* ring = F.lds + F.wave * 65536;
    const int drow = lane >> 3, dch = lane & 7, dsw = dch ^ drow;
    if (F.wave < per)
    for (int item = F.bid * per + F.wave; item < NB * NH * 2; item += F.G * per) {
        const int bh = item >> 1, vh = item & 1, b = bh >> 3, h = bh & 7; const size_t m0 = (size_t)b * SEQ;
#define CS_ISSUE(C, BUF) do { const size_t pr_ = (size_t)bh * 32 + (C); LAS unsigned char* d_ = ring + (BUF) * 32768; \
        const char* gq_ = (const char*)(CQ + pr_ * 4096) + drow * 128 + dsw * 16; const char* gg_ = (const char*)(CG + pr_ * 4096) + drow * 128 + dsw * 16; \
        const char* gh_ = (const char*)(CH + pr_ * 4096 + 32 * vh) + drow * 256 + dch * 16; const char* gy_ = (const char*)(YS + (m0 + (C) * 64) * RW + h * RH + 32 * vh) + (size_t)drow * (RW * 4) + dch * 16; \
        _Pragma("unroll") for (int i_ = 0; i_ < 8; ++i_) { \
            __builtin_amdgcn_global_load_lds((const unsigned*)(gq_ + i_ * 1024), (LAS unsigned*)(d_ + i_ * 1024), 16, 0, 0); \
            __builtin_amdgcn_global_load_lds((const unsigned*)(gg_ + i_ * 1024), (LAS unsigned*)(d_ + 8192 + i_ * 1024), 16, 0, 0); \
            __builtin_amdgcn_global_load_lds((const unsigned*)(gh_ + i_ * 2048), (LAS unsigned*)(d_ + 16384 + i_ * 1024), 16, 0, 0); \
            __builtin_amdgcn_global_load_lds((const unsigned*)(gy_ + (size_t)i_ * (8 * RW * 4)), (LAS unsigned*)(d_ + 24576 + i_ * 1024), 16, 0, 0); } } while (0)
        f32x16 X[2], Yh[2];
#pragma unroll
        for (int i = 0; i < 16; ++i) { X[0][i] = 0.f; X[1][i] = 0.f; Yh[0][i] = 0.f; Yh[1][i] = 0.f; }
        CS_ISSUE(0, 0);
        for (int c = 0; c < SEQ / 64; ++c) {
            asm volatile("s_waitcnt vmcnt(0)" ::: "memory"); __builtin_amdgcn_sched_barrier(0);
            if (c + 1 < SEQ / 64) CS_ISSUE(c + 1, (c + 1) & 1);
            if (c > 0) {
#pragma unroll
                for (int tt = 0; tt < 2; ++tt)
#pragma unroll
                    for (int i = 0; i < 16; ++i) { const int row = 32 * tt + (i & 3) + 8 * (i >> 2) + 4 * hh; YS[(m0 + (c - 1) * 64 + row) * RW + h * RH + 32 * vh + r32] = Yh[tt][i]; } }
            const LAS unsigned char* d = ring + (c & 1) * 32768;
            bf16x8 xb[2][2];
#pragma unroll
            for (int kt = 0; kt < 2; ++kt)
#pragma unroll
                for (int s2 = 0; s2 < 2; ++s2) xb[kt][s2] = pack_frag(X[kt], s2);
#pragma unroll
            for (int tt = 0; tt < 2; ++tt) {
                f32x16 Yt;
#pragma unroll
                for (int i = 0; i < 16; ++i) { const int row = 32 * tt + (i & 3) + 8 * (i >> 2) + 4 * hh; Yt[i] = *(const LAS float*)(d + 24576 + row * 128 + r32 * 4); }
#pragma unroll
                for (int kt = 0; kt < 2; ++kt)
#pragma unroll
                    for (int s2 = 0; s2 < 2; ++s2) Yt = __builtin_amdgcn_mfma_f32_32x32x16_bf16(ld_afrag_lds(d, 32 * tt + r32, 32 * kt + 16 * s2, hh), xb[kt][s2], Yt, 0, 0, 0);
                Yh[tt] = Yt;
            }
            f32x16 Xn[2];
#pragma unroll
            for (int tt = 0; tt < 2; ++tt) {
#pragma unroll
                for (int i = 0; i < 16; ++i) { const int row = 32 * tt + (i & 3) + 8 * (i >> 2) + 4 * hh; Xn[tt][i] = *(const LAS float*)(d + 16384 + row * 128 + r32 * 4); }
#pragma unroll
                for (int kt = 0; kt < 2; ++kt)
#pragma unroll
                    for (int s2 = 0; s2 < 2; ++s2) Xn[tt] = __builtin_amdgcn_mfma_f32_32x32x16_bf16(ld_afrag_lds(d + 8192, 32 * tt + r32, 32 * kt + 16 * s2, hh), xb[kt][s2], Xn[tt], 0, 0, 0);
            }
            X[0] = Xn[0]; X[1] = Xn[1];
        }
#pragma unroll
        for (int tt = 0; tt < 2; ++tt)
#pragma unroll
            for (int i = 0; i < 16; ++i) { const int row = 32 * tt + (i & 3) + 8 * (i >> 2) + 4 * hh; YS[(m0 + (SEQ / 64 - 1) * 64 + row) * RW + h * RH + 32 * vh + r32] = Yh[tt][i]; }
#undef CS_ISSUE
    }
}
__device__ __forceinline__ void phase_post(Frame& F, int l, int gw, int NGW) {
    const float* YS = (const float*)(F.ws + WS_YS); const bf16* SV = (const bf16*)(F.ws + WS_SV); const bf16* LOUT = (const bf16*)(F.ws + WS_LOUT); const float* BONUS = (const float*)(F.ws + WS_BONUS);
    bf16* YG = (bf16*)(F.ws + WS_YG);
    const int c = 8 * F.lane; float gg[8], gb[8]; ld8f(F.in[I_GNG] + l * RW + c, gg); ld8f(F.in[I_GNB] + l * RW + c, gb);
    for (int m = gw; m < M; m += NGW) {
        float y[8], v[8], g[8]; ld8f(YS + (size_t)m * RW + c, y); ld8bf(SV + (size_t)m * RW + c, v); ld8bf(LOUT + (size_t)m * NLORA + 1024 + c, g);
        float s = 0.f;
#pragma unroll
        for (int i = 0; i < 8; ++i) s += y[i];
        const float mean = grp8_sum(s) * (1.0f / RH); float s2 = 0.f;
#pragma unroll
        for (int i = 0; i < 8; ++i) { y[i] -= mean; s2 += y[i] * y[i]; }
        const float rstd = rsqrtf(grp8_sum(s2) * (1.0f / RH) + GN_EPS); const float bo = BONUS[(size_t)m * NH + (F.lane >> 3)];
        float o[8];
#pragma unroll
        for (int i = 0; i < 8; ++i) o[i] = (y[i] * rstd * gg[i] + gb[i] + bo * v[i]) * g[i];
        st8bf(YG + (size_t)m * D + RW + c, o);
    }
}

__device__ __forceinline__ unsigned* cnt_word(const Frame& F, int l, int e) { return (unsigned*)(F.ws + WS_CTL) + CW_CNT + (l * NE + e) * 64; }
constexpr int HT_STRIDE = 1040;
__device__ __forceinline__ void phase_rowB(Frame& F, int l, const bool dummy) {
    const bf16* Y = (const bf16*)(F.ws + WS_Y); bf16* H = (bf16*)(F.ws + (dummy ? WS_YEXP + 64 * MiB : WS_H));
    int* LIST = (int*)(F.ws + (dummy ? WS_YEXP + 96 * MiB : WS_LIST)); float* GW = (float*)(F.ws + (dummy ? WS_YEXP + 104 * MiB : WS_GW)); int* TOKA = (int*)(F.ws + (dummy ? WS_YEXP + 112 * MiB : WS_TOKA));
    float* xout = dummy ? (float*)(F.ws + WS_YEXP) : F.out; const int lc = dummy ? l + 2 : l;
    const float* xsrc = (l == 0) ? F.in[I_X] : F.out;
    LAS float* htile = (LAS float*)F.lds;
    LAS float* part = (LAS float*)(F.lds + 16 * HT_STRIDE * 4);
    LAS float* logit = part + 8 * 16 * 64;
    LAS int* cntl = (LAS int*)(logit + 1024 + 8 * 80);
    LAS int* asg = cntl + 128;
    if (F.tid < 128) cntl[F.tid] = 0;
    __syncthreads();
    int it = 0;
    const int lane = F.lane, w = F.wave, g4 = lane >> 4, j16 = lane & 15, kbase = 128 * w + 32 * g4;
    const float* wr = F.in[I_WROUTER] + (size_t)l * D * NE; const float br = F.in[I_BROUTER][l * NE + lane];
    v2u yq[2][4]; Row xq[2];
    if (F.bid < M / 16) {
#pragma unroll
        for (int rr = 0; rr < 2; ++rr) { const int m = F.bid * 16 + 2 * w + rr;
#pragma unroll
            for (int j = 0; j < 4; ++j) yq[rr][j] = *((const v2u*)(Y + (size_t)m * D) + lane + 64 * j);
            xq[rr] = row_load(xsrc + (size_t)m * D, lane); } }
    for (int tile = F.bid; tile < M / 16; tile += F.G, ++it) {
#pragma unroll
        for (int rr = 0; rr < 2; ++rr) {
            const int r = 2 * w + rr, m = tile * 16 + r, b = m / SEQ;
            Row y, x = xq[rr], gp = row_load(F.in[I_NMPOST] + l * D, lane), gt = row_load(mod_ptr(F, l, b, 2), lane);
#pragma unroll
            for (int j = 0; j < 4; ++j) y.v[j] = (f32x4){bflo(yq[rr][j].x), bfhi(yq[rr][j].x), bflo(yq[rr][j].y), bfhi(yq[rr][j].y)};
            const float rs = rsqrtf(row_sumsq(y) * (1.0f / D) + RMS_EPS);
#pragma unroll
            for (int j = 0; j < 4; ++j) x.v[j] = x.v[j] + gt.v[j] * (y.v[j] * rs * gp.v[j]);
            row_store(xout + (size_t)m * D, lane, x);
            Row h = row_modnorm(x, F.in[I_NFPRE] + l * D, mod_ptr(F, l, b, 4), mod_ptr(F, l, b, 3), lane);
            row_store_bf16(H + (size_t)m * D, lane, h);
#pragma unroll
            for (int j = 0; j < 4; ++j) *((LAS f32x4*)(htile + r * HT_STRIDE) + lane + 64 * j) = h.v[j];
        }
        if (tile + F.G < M / 16) {
#pragma unroll
            for (int rr = 0; rr < 2; ++rr) { const int m = (tile + F.G) * 16 + 2 * w + rr;
#pragma unroll
                for (int j = 0; j < 4; ++j) yq[rr][j] = *((const v2u*)(Y + (size_t)m * D) + lane + 64 * j);
                xq[rr] = row_load(xsrc + (size_t)m * D, lane); } }
        __syncthreads();
        if (dummy && MK_RB_LEVEL < 2) continue;
#pragma unroll 1
        for (int eq = 0; eq < 4; ++eq) {
            asm volatile("" : "+s"(wr));
            float Bw[32];
#pragma unroll
            for (int sidx = 0; sidx < 32; ++sidx) Bw[sidx] = wr[(size_t)(kbase + sidx) * NE + 16 * eq + j16];
            f32x4 acc = (f32x4){0.f, 0.f, 0.f, 0.f};
#pragma unroll
            for (int q = 0; q < 8; ++q) { const f32x4 a4 = *(const LAS f32x4*)(htile + j16 * HT_STRIDE + kbase + 4 * q);
#pragma unroll
                for (int i = 0; i < 4; ++i) acc = __builtin_amdgcn_mfma_f32_16x16x4f32(a4[i], Bw[4 * q + i], acc, 0, 0, 0); }
#pragma unroll
            for (int i = 0; i < 4; ++i) part[(w * 16 + 4 * g4 + i) * 64 + 16 * eq + j16] = acc[i];
        }
        __syncthreads();
#pragma unroll
        for (int o = 0; o < 2; ++o) { const int idx = F.tid + 512 * o; float sum = 0.f;
#pragma unroll
            for (int ww = 0; ww < 8; ++ww) sum += part[ww * 1024 + idx];
            logit[idx] = sum; }
        __syncthreads();
        if (dummy && MK_RB_LEVEL < 3) continue;
#pragma unroll 1
        for (int rr = 0; rr < 2; ++rr) {
            const int r = 2 * w + rr, m = tile * 16 + r;
            const float score = sigmoidf_(logit[r * 64 + lane]), biased = score + br;
            LAS float* wb = logit + 1024 + w * 80;
            wb[lane] = biased; LDS_WAIT();
            const int g = lane >> 3;
            float gs;
            { const f32x4 ga = *(const LAS f32x4*)(wb + 8 * g), gb = *(const LAS f32x4*)(wb + 8 * g + 4); float m1 = ga[0], m2 = -__builtin_inff();
#define T2(v) do { const float v_ = (v); if (v_ > m1) { m2 = m1; m1 = v_; } else if (v_ > m2) m2 = v_; } while (0)
              T2(ga[1]); T2(ga[2]); T2(ga[3]); T2(gb[0]); T2(gb[1]); T2(gb[2]); T2(gb[3]);
#undef T2
              gs = m1 + m2; }
            if ((lane & 7) == 0) wb[64 + g] = gs;
            LDS_WAIT();
            int grk = 0;
            { const f32x4 s0 = *(const LAS f32x4*)(wb + 64), s1 = *(const LAS f32x4*)(wb + 68);
#pragma unroll
              for (int q = 0; q < 8; ++q) { const float o = (q < 4) ? s0[q & 3] : s1[q & 3]; grk += (o > gs || (o == gs && q < g)) ? 1 : 0; } }
            const float masked = (grk < 4) ? biased : -__builtin_inff();
            wb[lane] = masked; LDS_WAIT();
            int rank = 0;
#pragma unroll
            for (int q = 0; q < 16; ++q) { const f32x4 o = *(const LAS f32x4*)(wb + 4 * q);
#pragma unroll
                for (int i = 0; i < 4; ++i) rank += (o[i] > masked || (o[i] == masked && (4 * q + i) < lane)) ? 1 : 0; }
            LDS_WAIT();
            const bool chosen = rank < TOPK;
            const float ssum = wave_sum(chosen ? score : 0.f);
            if (chosen) { const int lp = __hip_atomic_fetch_add((LAS int*)cntl + lane, 1, __ATOMIC_RELAXED, __HIP_MEMORY_SCOPE_WORKGROUP);
                LAS int* q = asg + ((it * 16 + r) * TOPK + rank) * 2; q[0] = lane * 65536 + lp; q[1] = __builtin_bit_cast(int, score / ssum * ROUTED_SCALE); }
            if (lane == 0) LIST[(size_t)NE * M + m] = m;
        }
    }
    if (dummy && MK_RB_LEVEL < 3) return;
    __syncthreads();
    if (F.tid < NE) cntl[NE + F.tid] = (int)__hip_atomic_fetch_add(cnt_word(F, lc, F.tid), (unsigned)cntl[F.tid], RLX_AGENT);
    __syncthreads();
    for (int idx = F.tid; idx < it * 16 * TOPK; idx += NTHREADS) {
        const int itl = idx / (16 * TOPK), r = (idx / TOPK) % 16, m = (F.bid + itl * F.G) * 16 + r; const int ep = asg[idx * 2], e = ep >> 16, pos = cntl[NE + e] + (ep & 65535);
        LIST[(size_t)e * M + pos] = m; TOKA[((size_t)m * TOPK + (idx % TOPK)) * 2] = e * 65536 + pos; TOKA[((size_t)m * TOPK + (idx % TOPK)) * 2 + 1] = asg[idx * 2 + 1]; }
}

struct MoeTab { LAS int* cnt; LAS int* start; LAS int* tstart; LAS int* ntiles; LAS int* tiles; };
__device__ __forceinline__ MoeTab moe_tab(const Frame& F) { MoeTab T; LAS int* p = (LAS int*)(F.lds + LDS_TAB_OFF); T.cnt = p; T.start = p + 80; T.tstart = p + 160; T.ntiles = p + 240; T.tiles = p + 256; return T; }
__device__ __forceinline__ void moe_build(Frame& F, int l, bool with_tiles) {
    MoeTab T = moe_tab(F);
    __syncthreads();
    if (F.tid <= NE) T.cnt[F.tid] = (F.tid < NE) ? (int)__hip_atomic_load(cnt_word(F, l, F.tid), RLX_AGENT) : M;
    __syncthreads();
    if (F.tid <= NE) { int s = 0, ts = 0; for (int e = 0; e < F.tid; ++e) { const int c = T.cnt[e]; s += c; ts += (c + 255) >> 8; } T.start[F.tid] = s; T.tstart[F.tid] = ts;
        if (F.tid == NE) T.ntiles[0] = ts + ((M + 255) >> 8);
        if (with_tiles) { const int c = T.cnt[F.tid]; const int nt = (c + 255) >> 8;
            for (int rt = 0; rt < nt; ++rt) { LAS int* q = T.tiles + (ts + rt) * 4; q[0] = F.tid; q[1] = rt * 256; q[2] = s + rt * 256; q[3] = (c - rt * 256) < 256 ? (c - rt * 256) : 256; } } }
    __syncthreads();
}
struct MoeOrder {
    LAS const int* tiles; int ntiles, npn, nwg, G, c, bstride;
    __device__ bool next(int i, pg8::Unit& u) const {
        const long L = (long)i * G + c; if (L >= nwg) return false;
        int wgid = (int)L; { const int q = nwg / 8, r = nwg % 8, xcd = wgid % 8, off = wgid / 8; wgid = (xcd < r ? xcd * (q + 1) : r * (q + 1) + (xcd - r) * q) + off; }
        const int tile = wgid / npn, pn = wgid % npn; LAS const int* q = tiles + tile * 4;
        const int q0 = __builtin_amdgcn_readfirstlane(q[0]), q1 = __builtin_amdgcn_readfirstlane(q[1]), q2 = __builtin_amdgcn_readfirstlane(q[2]), q3 = __builtin_amdgcn_readfirstlane(q[3]);
        u.e = q0; u.x0 = q0 * M + q1; u.o0 = q2; u.nrows = q3; u.b0 = q0 * bstride + pn * 256; u.oc0 = pn * 256; u.a0 = q2; return true;
    }
};
__device__ __forceinline__ Row row_load_fp8(const unsigned char* p, int lane) { Row r; const unsigned* q = (const unsigned*)p + lane;
#pragma unroll
    for (int j = 0; j < 4; ++j) { const int w = (int)q[64 * j]; const f32x2 lo = __builtin_amdgcn_cvt_pk_f32_fp8(w, false), hi = __builtin_amdgcn_cvt_pk_f32_fp8(w, true); r.v[j] = (f32x4){lo.x, lo.y, hi.x, hi.y}; } return r; }
__device__ __forceinline__ void phase_rowC(Frame& F, int l, int gw, int NGW, const bool dummy) {
    const unsigned char* YEXP = (const unsigned char*)(F.ws + WS_YEXP); const unsigned char* YSH = YEXP + (size_t)M * TOPK * D; const int* TOKA = (const int*)(F.ws + WS_TOKA); bf16* H = (bf16*)(F.ws + (dummy ? WS_S : WS_H));
    float* xout = dummy ? (float*)(F.ws + WS_S) : F.out;
    MoeTab T = moe_tab(F);
    for (int m = gw; m < M; m += NGW) {
        const int b = m / SEQ;
        Row y = row_load_fp8(YSH + (size_t)m * D, F.lane);
#pragma unroll
        for (int j8 = 0; j8 < TOPK; ++j8) { const int ep = TOKA[((size_t)m * TOPK + j8) * 2]; const float gt_ = __builtin_bit_cast(float, TOKA[((size_t)m * TOPK + j8) * 2 + 1]);
            const int slot = T.start[ep >> 16] + (ep & 65535); const Row t = row_load_fp8(YEXP + (size_t)slot * D, F.lane);
#pragma unroll
            for (int j = 0; j < 4; ++j) y.v[j] += gt_ * t.v[j]; }
        Row x = row_load(F.out + (size_t)m * D, F.lane), gp = row_load(F.in[I_NFPOST] + l * D, F.lane), gt = row_load(mod_ptr(F, l, b, 5), F.lane);
        const float rs = rsqrtf(row_sumsq(y) * (1.0f / D) + RMS_EPS);
#pragma unroll
        for (int j = 0; j < 4; ++j) x.v[j] = x.v[j] + gt.v[j] * (y.v[j] * rs * gp.v[j]);
        row_store(xout + (size_t)m * D, F.lane, x);
        if (l + 1 < DEPTH) { Row h = row_modnorm(x, F.in[I_NMPRE] + (l + 1) * D, mod_ptr(F, l + 1, b, 1), mod_ptr(F, l + 1, b, 0), F.lane); row_store_bf16(H + (size_t)m * D, F.lane, h); }
    }
}

__device__ __forceinline__ void phase_begin(Frame& F) { asm volatile("" : "+s"(F.in), "+s"(F.ws), "+s"(F.out), "+s"(F.bid), "+s"(F.G), "+s"(F.wave));
    F.lane = (int)__builtin_amdgcn_mbcnt_hi(~0u, __builtin_amdgcn_mbcnt_lo(~0u, 0u)); asm volatile("" : "+v"(F.lane)); F.tid = F.wave * 64 + F.lane; }
constexpr int PH_PER_LAYER = 13, NPH = 2 + DEPTH * PH_PER_LAYER;
__device__ __forceinline__ void bar_launder(XcdBarrier& bar) { asm volatile("" : "+s"(bar.bar)); }
#define TBIT(k) ((k) == 0 ? 13 : (k) == 1 ? 14 : ((k) - 2) % PH_PER_LAYER)
#define IN(k) (phase_begin(F), bar_launder(bar), t_ph = (((MK_TIME_MASK >> TBIT(k)) & 1) ? __builtin_amdgcn_s_memrealtime() : 0ull), (lo <= (k) && (k) < hi))
#define SEAM(k) do { if (!MK_PER_PHASE && (k) + 1 < hi) { xcd_barrier(bar, F.tid); if ((MK_TIME_MASK >> TBIT(k)) & 1) t_acc += __builtin_amdgcn_s_memrealtime() - t_ph; if (MK_REPEAT == -3) { bar_launder(bar); xcd_barrier(bar, F.tid); } } } while (0)
template <int L> __device__ __forceinline__ void layer_phases(Frame& F, XcdBarrier& bar, const int lo, const int hi, unsigned long long& t_acc) {
    constexpr int l = L, p0 = 2 + L * PH_PER_LAYER; unsigned long long t_ph = 0;
#define GW_ const int gw = F.bid * NWAVES + F.wave, NGW = F.G * NWAVES
#define WM_ unsigned char* wm = F.ws + WS_WMIX + (size_t)l * WMIX_STRIDE
    if (IN(p0 + 0)) { for (int rep_ = 0; rep_ < ((MK_REPEAT == 0) ? 2 : 1); ++rep_) { phase_begin(F); bar_launder(bar); WM_;
        pg8::Gemm g{(const bf16*)(F.ws + WS_H), (const bf16*)(wm + WM_WIN), D, nullptr}; pg8::StaticOrder S; S.init(M, DIN, F.G, F.bid);
        pg8::EpiZ E{(bf16*)(F.ws + WS_ZC)}; pg8::gemm_phase<pg8::EpiZ, pg8::StaticOrder, false>(F.lds, F.tid, g, S, E); } SEAM(p0 + 0); }
    if (IN(p0 + 1)) { for (int rep_ = 0; rep_ < ((MK_REPEAT == 1) ? 2 : 1); ++rep_) { phase_begin(F); bar_launder(bar); GW_; phase_conv(F, l); if (MK_REPEAT == 101) phase_conv(F, l); phase_prep1(F, l, gw, NGW); if (MK_REPEAT == 102) phase_prep1(F, l, gw, NGW); } SEAM(p0 + 1); }
    if (IN(p0 + 2)) { for (int rep_ = 0; rep_ < ((MK_REPEAT == 2) ? 2 : 1); ++rep_) { phase_begin(F); bar_launder(bar); WM_; pg8::Gemm g{(const bf16*)(F.ws + WS_LIN), (const bf16*)(wm + WM_LORA), KLORA, nullptr}; pg8::StaticOrder S; S.init(M, NLORA, F.G, F.bid);
        pg8::EpiBf16 E{(bf16*)(F.ws + WS_LOUT), NLORA}; pg8::gemm_phase<pg8::EpiBf16, pg8::StaticOrder, false>(F.lds, F.tid, g, S, E); } SEAM(p0 + 2); }
    if (IN(p0 + 4)) { for (int rep_ = 0; rep_ < ((MK_REPEAT == 4) ? 2 : 1); ++rep_) { phase_begin(F); bar_launder(bar); phase_chunkprep(F, l); } SEAM(p0 + 4); }
    if (IN(p0 + 5)) { for (int rep_ = 0; rep_ < ((MK_REPEAT == 5) ? 2 : 1); ++rep_) { phase_begin(F); bar_launder(bar); const int per = (F.G >= 128) ? 1 : 2;
        const int nscan = 128 / per;
        if (F.bid < nscan || F.G <= nscan) { if (F.wave < per) { if (rep_ == 0) phase_chunkscan(F); } else if (F.G <= nscan) phase_expert_weights(F, l, F.bid * (NWAVES - per) + F.wave - per, F.G * (NWAVES - per)); }
        else phase_expert_weights(F, l, (F.bid - nscan) * NWAVES + F.wave, (F.G - nscan) * NWAVES); } SEAM(p0 + 5); }
    if (IN(p0 + 6)) { for (int rep_ = 0; rep_ < ((MK_REPEAT == 6) ? 2 : 1); ++rep_) { phase_begin(F); bar_launder(bar); GW_; phase_post(F, l, gw, NGW); } SEAM(p0 + 6); }
    if (IN(p0 + 7)) { for (int rep_ = 0; rep_ < ((MK_REPEAT == 7) ? 2 : 1); ++rep_) { phase_begin(F); bar_launder(bar); WM_; pg8::StaticOrder S; S.init(M, D, F.G, F.bid);
        pg8::Gemm g{(const bf16*)(F.ws + WS_UC), (const bf16*)(wm + WM_PCONV), D, nullptr}; pg8::EpiMerge2 E{(bf16*)(F.ws + WS_MERGED), (const bf16*)(F.ws + WS_ZG)};
        pg8::gemm_phase<pg8::EpiMerge2, pg8::StaticOrder, false>(F.lds, F.tid, g, S, E); } SEAM(p0 + 7); }
    if (IN(p0 + 8)) { for (int rep_ = 0; rep_ < ((MK_REPEAT == 8) ? 2 : 1); ++rep_) { phase_begin(F); bar_launder(bar); WM_; pg8::Gemm g{(const bf16*)(F.ws + WS_MERGED), (const bf16*)(wm + WM_WO), D, nullptr}; pg8::StaticOrder S; S.init(M, D, F.G, F.bid);
        pg8::EpiBf16 E{(bf16*)(F.ws + WS_Y), D}; pg8::gemm_phase<pg8::EpiBf16, pg8::StaticOrder, false>(F.lds, F.tid, g, S, E); } SEAM(p0 + 8); }
    if (IN(p0 + 9)) { for (int rep_ = 0; rep_ < ((MK_REPEAT == 9) ? 2 : 1); ++rep_) { phase_begin(F); bar_launder(bar); phase_rowB(F, l, (MK_REPEAT == 9) && rep_ == 0); } SEAM(p0 + 9); }
    if (IN(p0 + 10)) { for (int rep_ = 0; rep_ < ((MK_REPEAT == 10) ? 2 : 1); ++rep_) { phase_begin(F); bar_launder(bar); moe_build(F, l, true); MoeTab T = moe_tab(F);
        const int ntl = __builtin_amdgcn_readfirstlane(T.ntiles[0]); MoeOrder S{T.tiles, ntl, 2, ntl * 2, F.G, F.bid, 512};
        pg8::Gemm g{(const bf16*)(F.ws + WS_H), (const bf16*)(F.ws + WS_WGU), D, (const int*)(F.ws + WS_LIST)};
        pg8::EpiSwiGLU E{(bf16*)(F.ws + WS_ACT)}; pg8::gemm_phase<pg8::EpiSwiGLU, MoeOrder, true>(F.lds, F.tid, g, S, E); } SEAM(p0 + 10); }
    if (IN(p0 + 11)) { for (int rep_ = 0; rep_ < ((MK_REPEAT == 11) ? 2 : 1); ++rep_) { phase_begin(F); bar_launder(bar); moe_build(F, l, true); MoeTab T = moe_tab(F);
        const int ntl = __builtin_amdgcn_readfirstlane(T.ntiles[0]); MoeOrder S{T.tiles, ntl, 4, ntl * 4, F.G, F.bid, 1024};
        pg8::Gemm g{(const bf16*)(F.ws + WS_ACT), (const bf16*)(F.ws + WS_WDN), DE, nullptr};
        pg8::EpiFp8 E{(unsigned char*)(F.ws + WS_YEXP), D}; pg8::gemm_phase<pg8::EpiFp8, MoeOrder, false>(F.lds, F.tid, g, S, E); } SEAM(p0 + 11); }
    if (IN(p0 + 12)) { for (int rep_ = 0; rep_ < ((MK_REPEAT == 12) ? 2 : 1); ++rep_) { phase_begin(F); bar_launder(bar); GW_; moe_build(F, l, false); phase_rowC(F, l, gw, NGW, (MK_REPEAT == 12) && rep_ == 0); } SEAM(p0 + 12); }
}
__global__ void __launch_bounds__(NTHREADS, 2) mk_fwd(Args args) {
    extern __shared__ __attribute__((aligned(16))) unsigned char lds_raw[];
    Frame F; F.lds = (LAS unsigned char*)lds_raw; F.tid = threadIdx.x; F.lane = F.tid & 63; F.wave = __builtin_amdgcn_readfirstlane(F.tid >> 6);
    F.G = gridDim.x; F.bid = blockIdx.x; F.in = (const float* const __attribute__((address_space(4)))*)__builtin_amdgcn_kernarg_segment_ptr(); F.out = args.out; F.ws = args.ws;
    volatile LAS unsigned* MISC = (volatile LAS unsigned*)(F.lds + MISC_OFF);
    if (F.tid < 64) MISC[F.tid] = 0u;
    __syncthreads();
    XcdBarrier bar; bar.bar = (unsigned*)(F.ws + WS_CTL) + CW_BAR; bar.x = 0; bar.st = nullptr;
    if (!MK_PER_PHASE) bar = xcd_barrier_post((unsigned*)(F.ws + WS_CTL) + CW_BAR, MISC + 8);
    const int lo = args.ph_lo, hi = (args.ph_hi < MK_LAST_PHASE + 1) ? args.ph_hi : MK_LAST_PHASE + 1;
    unsigned long long t_acc = 0, t_ph = 0;
    if (IN(0)) { for (int rep_ = 0; rep_ < ((MK_REPEAT == -2) ? 2 : 1); ++rep_) { phase_begin(F); bar_launder(bar); GW_; phase_ada(F); phase_mix_weights(F, gw, NGW); } SEAM(0); }
    if (IN(1)) { GW_; phase_rowA(F, gw, NGW); SEAM(1); }
    layer_phases<0>(F, bar, lo, hi, t_acc);
    layer_phases<1>(F, bar, lo, hi, t_acc);
    if (MK_TIME_MASK != 0 && F.bid == 0) { const unsigned long long te = __builtin_amdgcn_s_memrealtime() + t_acc; while (__builtin_amdgcn_s_memrealtime() < te) __builtin_amdgcn_s_sleep(8); }
    if (MK_LAST_PHASE < 2 + 9 && args.ph_hi == NPH) { phase_begin(F); for (size_t i = (size_t)F.bid * NTHREADS + F.tid; i < (size_t)M * D / 4; i += (size_t)F.G * NTHREADS) ((f32x4*)F.out)[i] = ((const f32x4*)F.in[I_X])[i]; }
}
#undef IN
#undef SEAM
#undef GW_
#undef WM_

extern "C" void kernel_launch(void* const* d_in, const int* in_sizes, int n_in, void* d_out, int out_size, void* d_ws, size_t ws_size, hipStream_t stream) {
    static int grid = 0;
    if (grid == 0) {
        if (n_in != N_IN || out_size != M * D) { fprintf(stderr, "kernel_launch: unexpected shapes (n_in %d out %d ws %zu need %zu)\n", n_in, out_size, ws_size, (size_t)WS_END); grid = -1; return; }
        if (ws_size < WS_END) { fprintf(stderr, "kernel_launch: ws too small %zu < %zu\n", ws_size, (size_t)WS_END); grid = -2; }
        int dev = 0, cus = 0;
        if (hipGetDevice(&dev) != hipSuccess || hipDeviceGetAttribute(&cus, hipDeviceAttributeMultiprocessorCount, dev) != hipSuccess) { grid = -1; return; }
        if (hipFuncSetAttribute((const void*)mk_fwd, hipFuncAttributeMaxDynamicSharedMemorySize, LDS_BYTES) != hipSuccess) { fprintf(stderr, "kernel_launch: hipFuncSetAttribute failed\n"); grid = -1; return; }
        (void)hipGetLastError();
        grid = cus;
    }
    if (grid == -2) { (void)hipMemsetAsync(d_out, 0, (size_t)out_size * 4, stream); return; }
    if (grid < 0) return;
    (void)hipMemsetAsync((char*)d_ws + WS_CTL, 0, CTL_ZERO_BYTES, stream);
    Args a{};
    for (int i = 0; i < N_IN; ++i) a.in[i] = (const float*)d_in[i];
    a.out = (float*)d_out; a.ws = (unsigned char*)d_ws;
#if MK_PER_PHASE
    for (int p = 0; p < NPH && p <= MK_LAST_PHASE; ++p) { a.ph_lo = p; a.ph_hi = p + 1; hipLaunchKernelGGL(mk_fwd, dim3(grid), dim3(NTHREADS), LDS_BYTES, stream, a); }
#else
    a.ph_lo = 0; a.ph_hi = NPH;
    hipLaunchKernelGGL(mk_fwd, dim3(grid), dim3(NTHREADS), LDS_BYTES, stream, a);
#endif
}
```

```cpp
#include <hip/hip_runtime.h>
#include <cstdio>
#include <cstdint>

#ifndef MK_PER_PHASE
#define MK_PER_PHASE 0
#endif
#ifndef MK_REPEAT
#define MK_REPEAT -1
#endif
#ifndef MK_TIME_MASK
#define MK_TIME_MASK 0
#endif
#ifndef MK_RB_LEVEL
#define MK_RB_LEVEL 3
#endif
#ifndef MK_LAST_PHASE
#define MK_LAST_PHASE 9999
#endif

#define GAS __attribute__((address_space(1)))
#define LAS __attribute__((address_space(3)))
typedef unsigned short bf16;
typedef unsigned v4u __attribute__((ext_vector_type(4)));
typedef unsigned v2u __attribute__((ext_vector_type(2)));
typedef float f32x4 __attribute__((ext_vector_type(4)));
typedef float f32x2 __attribute__((ext_vector_type(2)));
typedef short bf16x8 __attribute__((ext_vector_type(8)));
typedef GAS unsigned gu32;
#define RLX_AGENT __ATOMIC_RELAXED, __HIP_MEMORY_SCOPE_AGENT
#define LDS_WAIT() asm volatile("s_waitcnt lgkmcnt(0)" ::: "memory")
#define VM_WAIT() asm volatile("s_waitcnt vmcnt(0)" ::: "memory")

constexpr int NB = 8, SEQ = 2048, D = 1024, M = NB * SEQ, DEPTH = 2;
constexpr int CW = 512, CKW = 31, RW = 512, RH = 64, NH = 8, LW = 64, LA = 64, LG = 128;
constexpr int NE = 64, TOPK = 8, DE = 256;
constexpr int DIN = 4864, ZR0 = 1024, ZG0 = 2816, COLR = 1792;
constexpr int NLORA = 1536, KLORA = 256;
constexpr float RMS_EPS = 1e-6f, LN_EPS = 1e-5f, GN_EPS = 64e-5f, ROUTED_SCALE = 2.5f;
constexpr int NWAVES = 8, NTHREADS = 512;

enum { I_X = 0, I_C, I_WADA, I_BADA, I_NMPRE, I_NMPOST, I_NFPRE, I_NFPOST, I_WIN, I_MU, I_CONVW, I_CONVB, I_CLNG, I_CLNB, I_PCONV,
       I_W0, I_W2, I_A0, I_A2, I_G2, I_KK, I_KA, I_RK, I_GNG, I_GNB, I_PRWKV, I_WO, I_WROUTER, I_BROUTER, I_WEG, I_WEU, I_WED, I_WSG, I_WSU, I_WSD, N_IN };

constexpr size_t MiB = 1u << 20;
constexpr size_t WS_CTL = 0, CTL_ZERO_BYTES = 1 * MiB;
constexpr size_t WS_MOD = 1 * MiB;
constexpr size_t WS_BONUS = 1 * MiB + 512 * 1024;
constexpr size_t WS_WMIX = 2 * MiB;
constexpr size_t WMIX_STRIDE = 15 * MiB;
constexpr size_t WM_WIN = 0, WM_PCONV = (size_t)DIN * D * 2, WM_PRWKV = WM_PCONV + (size_t)D * CW * 2, WM_WO = WM_PRWKV + (size_t)D * RW * 2, WM_LORA = WM_WO + (size_t)D * D * 2;
constexpr size_t WM_RHI = WM_LORA + (size_t)NLORA * KLORA * 2, WM_RLO = WM_RHI + (size_t)NE * D * 2;
static_assert(WM_RLO + (size_t)NE * D * 2 <= WMIX_STRIDE, "wmix");
constexpr size_t WS_WGU = 32 * MiB;
constexpr size_t WS_WDN = 97 * MiB;
constexpr size_t WS_H = 130 * MiB;
constexpr size_t WS_LIST = 162 * MiB;
constexpr size_t WS_GW = 167 * MiB;
constexpr size_t WS_TOKA = 172 * MiB;
constexpr size_t WS_S = 173 * MiB;
constexpr size_t WS_ZC = WS_S;
constexpr size_t WS_ZR = WS_S + 32 * MiB;
constexpr size_t WS_ZG = WS_S + 88 * MiB;
constexpr size_t WS_CQ = WS_S;
constexpr size_t WS_CG = WS_S + 16 * MiB;
constexpr size_t WS_CH = WS_S + 32 * MiB;
constexpr int ZCW = 1024, ZRW = 1792, ZGW = 2048;
static_assert(WS_ZR == WS_ZC + (size_t)NB * SEQ * 1024 * 2 && WS_ZG == WS_ZR + (size_t)NB * SEQ * 1792 * 2, "ZC | ZR | ZG adjacent");
constexpr size_t WS_LIN = WS_S + 152 * MiB;
constexpr size_t WS_LOUT = WS_S + 160 * MiB;
constexpr size_t WS_SR = WS_S + 208 * MiB;
constexpr size_t WS_SKP = WS_SR + 16 * MiB, WS_SV = WS_SR + 32 * MiB, WS_SKKN = WS_SR + 48 * MiB, WS_SKA = WS_SR + 64 * MiB;
constexpr size_t WS_SDEC = WS_SR + 80 * MiB;
constexpr size_t WS_YS = WS_SDEC + 32 * MiB;
constexpr size_t WS_UC = WS_SR;
constexpr size_t WS_YG = WS_UC;
constexpr size_t WS_MERGED = WS_SKKN;
constexpr size_t WS_Y = WS_SDEC;
constexpr size_t WS_ACT = WS_S;
constexpr size_t WS_YEXP = WS_S + 74 * MiB;
constexpr size_t WS_YSH = WS_S + 330 * MiB;
constexpr size_t WS_END = WS_S + 352 * MiB;
constexpr int CW_BAR = 4096;
constexpr int CW_CNT = 16384;
constexpr int RING_BYTES = 131072, LDS_TAB_OFF = RING_BYTES, LDS_TAB_BYTES = 11264, LDS_ROWTAB_OFF = LDS_TAB_OFF + LDS_TAB_BYTES, LDS_GWTAB_OFF = LDS_ROWTAB_OFF + 2048, MISC_OFF = LDS_GWTAB_OFF + 2048, LDS_BYTES = 147456;
static_assert(MISC_OFF + 256 <= LDS_BYTES, "lds");

__device__ __forceinline__ unsigned f2bf(float f) { unsigned u = __builtin_bit_cast(unsigned, f); return (u + 0x7fffu + ((u >> 16) & 1u)) >> 16; }
typedef __bf16 bf16x2_t __attribute__((ext_vector_type(2)));
__device__ __forceinline__ unsigned pk2(float lo, float hi) { const f32x2 f = {lo, hi}; return __builtin_bit_cast(unsigned, __builtin_convertvector(f, bf16x2_t)); }
__device__ __forceinline__ float bf2f(unsigned b) { return __builtin_bit_cast(float, b << 16); }
__device__ __forceinline__ float bflo(unsigned w) { return __builtin_bit_cast(float, w << 16); }
__device__ __forceinline__ float bfhi(unsigned w) { return __builtin_bit_cast(float, w & 0xffff0000u); }
__device__ __forceinline__ float sigmoidf_(float x) { return __builtin_amdgcn_rcpf(1.0f + __expf(-x)); }
__device__ __forceinline__ float siluf_(float x) { return x * __builtin_amdgcn_rcpf(1.0f + __expf(-x)); }
__device__ __forceinline__ float wave_sum(float v) {
#pragma unroll
    for (int o = 1; o < 64; o <<= 1) v += __shfl_xor(v, o);
    return v;
}

namespace pg8 {
constexpr int BM = 256, BK = 64, HALF = 128, HTB = HALF * BK * 2, STAGE_BYTES = 8 * HTB, NXCD = 8, WGM = 8;
__host__ __device__ __forceinline__ int lds_byte(int r, int c) { const int st = (r >> 4) * 2 + (c >> 5), rr = r & 15, cc = c & 31, ob = rr * 64 + cc * 2; return st * 1024 + (ob ^ (((ob >> 9) & 1) << 5)); }
__host__ __device__ __forceinline__ void stage_rc(int b, int& R, int& C) { const int st = b / 1024, sb = b % 1024, swz = sb ^ (((sb >> 9) & 1) << 5); R = (st >> 1) * 16 + swz / 64; C = (st & 1) * 32 + (swz % 64) / 2; }
__host__ __device__ __forceinline__ int perm32(int rho) { const int n = rho >> 4, i = rho & 15; return 8 * (i >> 2) + 4 * n + (i & 3); }

struct Unit { int a0, b0, o0, oc0, nrows, e, x0; };
struct Gemm { const bf16* A; const bf16* Bt; int K; const int* list; };

struct StaticOrder {
    int nM, nN, nwg, G, c;
    __device__ void init(int M_, int N_, int G_, int c_) { nM = M_ / BM; nN = N_ / BM; nwg = nM * nN; G = G_; c = c_; }
    __device__ bool next(int i, Unit& u) const {
        const long L = (long)i * G + c; if (L >= nwg) return false;
        int wgid = (int)L; { const int q = nwg / NXCD, r = nwg % NXCD, xcd = wgid % NXCD, off = wgid / NXCD; wgid = (xcd < r ? xcd * (q + 1) : r * (q + 1) + (xcd - r) * q) + off; }
        const int nig = WGM * nN, gid = wgid / nig, fm = gid * WGM, gsz = (nM - fm) < WGM ? (nM - fm) : WGM;
        const int pm = fm + ((wgid % nig) % gsz), pn = (wgid % nig) / gsz;
        u.a0 = pm * BM; u.b0 = pn * BM; u.o0 = pm * BM; u.oc0 = pn * BM; u.nrows = BM; u.e = 0; u.x0 = 0; return true;
    }
};

__device__ __forceinline__ unsigned cvt_pk_bf16(float lo, float hi) { unsigned r; asm volatile("v_cvt_pk_bf16_f32 %0, %1, %2" : "=v"(r) : "v"(lo), "v"(hi)); return r; }

struct EpiF32 {
    static constexpr bool PERM = false, HAS_MID = false;
    float* C; int ldc;
    __device__ __forceinline__ void operator()(const f32x4 (&acc)[2][2][4][2], const Unit& u, int wr, int wc, int fr, int fq) const {
        const int row0 = wr * 64 + fr, col0 = u.oc0 + wc * 32 + 4 * fq;
#pragma unroll
        for (int ai = 0; ai < 2; ++ai)
#pragma unroll
            for (int m = 0; m < 4; ++m) { const int r = row0 + ai * HALF + m * 16; if (r < u.nrows) { float* rowp = C + (size_t)(u.o0 + r) * ldc + col0;
#pragma unroll
                for (int bj = 0; bj < 2; ++bj)
#pragma unroll
                    for (int n = 0; n < 2; ++n) *(f32x4*)(rowp + bj * HALF + n * 16) = acc[ai][bj][m][n]; } }
    }
};
struct EpiBf16 {
    static constexpr bool PERM = true, HAS_MID = false;
    bf16* O; int ldc;
    __device__ __forceinline__ void operator()(const f32x4 (&acc)[2][2][4][2], const Unit& u, int wr, int wc, int fr, int fq) const {
        const int row0 = wr * 64 + fr, col0 = u.oc0 + wc * 32 + 8 * fq;
#pragma unroll
        for (int ai = 0; ai < 2; ++ai)
#pragma unroll
            for (int m = 0; m < 4; ++m) { const int r = row0 + ai * HALF + m * 16; if (r < u.nrows) { bf16* rowp = O + (size_t)(u.o0 + r) * ldc + col0;
#pragma unroll
                for (int bj = 0; bj < 2; ++bj) { const f32x4 v0 = acc[ai][bj][m][0], v1 = acc[ai][bj][m][1];
                    v4u w; w.x = cvt_pk_bf16(v0[0], v0[1]); w.y = cvt_pk_bf16(v0[2], v0[3]); w.z = cvt_pk_bf16(v1[0], v1[1]); w.w = cvt_pk_bf16(v1[2], v1[3]);
                    *(v4u*)(rowp + bj * HALF) = w; } } }
    }
};
struct EpiZ {
    static constexpr bool PERM = true, HAS_MID = false;
    bf16* ZC;
    __device__ __forceinline__ void operator()(const f32x4 (&acc)[2][2][4][2], const Unit& u, int wr, int wc, int fr, int fq) const {
        const int seg = (u.oc0 < 1024) ? 0 : (u.oc0 < 2816) ? 1 : 2;
        const int ldc = (seg == 0) ? 1024 : (seg == 1) ? 1792 : 2048, c0 = u.oc0 - ((seg == 0) ? 0 : (seg == 1) ? 1024 : 2816);
        bf16* O = ZC + ((seg == 0) ? (size_t)0 : (seg == 1) ? (size_t)M * 1024 : (size_t)M * (1024 + 1792));
        const int row0 = u.o0 + wr * 64 + fr, col0 = c0 + wc * 32 + 8 * fq;
#pragma unroll
        for (int ai = 0; ai < 2; ++ai)
#pragma unroll
            for (int m = 0; m < 4; ++m) { bf16* rowp = O + (size_t)(row0 + ai * HALF + m * 16) * ldc + col0;
#pragma unroll
                for (int bj = 0; bj < 2; ++bj) { const f32x4 v0 = acc[ai][bj][m][0], v1 = acc[ai][bj][m][1];
                    v4u w; w.x = cvt_pk_bf16(v0[0], v0[1]); w.y = cvt_pk_bf16(v0[2], v0[3]); w.z = cvt_pk_bf16(v1[0], v1[1]); w.w = cvt_pk_bf16(v1[2], v1[3]);
                    *(v4u*)(rowp + bj * HALF) = w; } }
    }
};
template <bool FIRST> struct EpiMerge {
    static constexpr bool PERM = true, HAS_MID = false;
    bf16* O; const bf16* Z; int gcol0;
    __device__ __forceinline__ void operator()(const f32x4 (&acc)[2][2][4][2], const Unit& u, int wr, int wc, int fr, int fq) const {
        const int row0 = u.o0 + wr * 64 + fr, col0 = u.oc0 + wc * 32 + 8 * fq;
#pragma unroll
        for (int ai = 0; ai < 2; ++ai)
#pragma unroll
            for (int m = 0; m < 4; ++m) { const int r = row0 + ai * HALF + m * 16; bf16* rowp = O + (size_t)r * D + col0; const bf16* zp = Z + (size_t)r * 2048 + gcol0 + col0;
#pragma unroll
                for (int bj = 0; bj < 2; ++bj) { const v4u g = *(const v4u*)(zp + bj * HALF); const f32x4 a0 = acc[ai][bj][m][0], a1 = acc[ai][bj][m][1];
                    float o[8];
                    o[0] = a0[0] * sigmoidf_(bflo(g.x)); o[1] = a0[1] * sigmoidf_(bfhi(g.x)); o[2] = a0[2] * sigmoidf_(bflo(g.y)); o[3] = a0[3] * sigmoidf_(bfhi(g.y));
                    o[4] = a1[0] * sigmoidf_(bflo(g.z)); o[5] = a1[1] * sigmoidf_(bfhi(g.z)); o[6] = a1[2] * sigmoidf_(bflo(g.w)); o[7] = a1[3] * sigmoidf_(bfhi(g.w));
                    if (!FIRST) { const v4u p = *(const v4u*)(rowp + bj * HALF);
                        o[0] += bflo(p.x); o[1] += bfhi(p.x); o[2] += bflo(p.y); o[3] += bfhi(p.y); o[4] += bflo(p.z); o[5] += bfhi(p.z); o[6] += bflo(p.w); o[7] += bfhi(p.w); }
                    v4u w; w.x = cvt_pk_bf16(o[0], o[1]); w.y = cvt_pk_bf16(o[2], o[3]); w.z = cvt_pk_bf16(o[4], o[5]); w.w = cvt_pk_bf16(o[6], o[7]);
                    *(v4u*)(rowp + bj * HALF) = w; } }
    }
};
struct EpiMerge2 {
    static constexpr bool PERM = true, HAS_MID = true;
    bf16* O; const bf16* ZG;
    __device__ __forceinline__ void mid(f32x4 (&acc)[2][2][4][2], const Unit& u, int wr, int wc, int fr, int fq) const {
        const int row0 = u.o0 + wr * 64 + fr, col0 = u.oc0 + wc * 32 + 8 * fq;
#pragma unroll
        for (int ai = 0; ai < 2; ++ai)
#pragma unroll
            for (int m = 0; m < 4; ++m) { const bf16* zp = ZG + (size_t)(row0 + ai * HALF + m * 16) * 2048 + col0;
#pragma unroll
                for (int bj = 0; bj < 2; ++bj) { const v4u g1 = *(const v4u*)(zp + bj * HALF), g2 = *(const v4u*)(zp + 1024 + bj * HALF);
#define RT_(a, b) ((1.0f + __expf(-(b))) * __builtin_amdgcn_rcpf(1.0f + __expf(-(a))))
                    acc[ai][bj][m][0][0] *= RT_(bflo(g1.x), bflo(g2.x)); acc[ai][bj][m][0][1] *= RT_(bfhi(g1.x), bfhi(g2.x)); acc[ai][bj][m][0][2] *= RT_(bflo(g1.y), bflo(g2.y)); acc[ai][bj][m][0][3] *= RT_(bfhi(g1.y), bfhi(g2.y));
                    acc[ai][bj][m][1][0] *= RT_(bflo(g1.z), bflo(g2.z)); acc[ai][bj][m][1][1] *= RT_(bfhi(g1.z), bfhi(g2.z)); acc[ai][bj][m][1][2] *= RT_(bflo(g1.w), bflo(g2.w)); acc[ai][bj][m][1][3] *= RT_(bfhi(g1.w), bfhi(g2.w));
#undef RT_
                } }
    }
    __device__ __forceinline__ void operator()(const f32x4 (&acc)[2][2][4][2], const Unit& u, int wr, int wc, int fr, int fq) const {
        const int row0 = u.o0 + wr * 64 + fr, col0 = u.oc0 + wc * 32 + 8 * fq;
#pragma unroll
        for (int ai = 0; ai < 2; ++ai)
#pragma unroll
            for (int m = 0; m < 4; ++m) { const int r = row0 + ai * HALF + m * 16; bf16* rowp = O + (size_t)r * D + col0; const bf16* zp = ZG + (size_t)r * 2048 + 1024 + col0;
#pragma unroll
                for (int bj = 0; bj < 2; ++bj) { const v4u g = *(const v4u*)(zp + bj * HALF); const f32x4 a0 = acc[ai][bj][m][0], a1 = acc[ai][bj][m][1];
                    v4u w; w.x = cvt_pk_bf16(a0[0] * sigmoidf_(bflo(g.x)), a0[1] * sigmoidf_(bfhi(g.x))); w.y = cvt_pk_bf16(a0[2] * sigmoidf_(bflo(g.y)), a0[3] * sigmoidf_(bfhi(g.y)));
                    w.z = cvt_pk_bf16(a1[0] * sigmoidf_(bflo(g.z)), a1[1] * sigmoidf_(bfhi(g.z))); w.w = cvt_pk_bf16(a1[2] * sigmoidf_(bflo(g.w)), a1[3] * sigmoidf_(bfhi(g.w)));
                    *(v4u*)(rowp + bj * HALF) = w; } }
    }
};
struct EpiFp8 {
    static constexpr bool PERM = true, HAS_MID = false;
    unsigned char* O; int ldc;
    __device__ __forceinline__ void operator()(const f32x4 (&acc)[2][2][4][2], const Unit& u, int wr, int wc, int fr, int fq) const {
        const int row0 = wr * 64 + fr, col0 = u.oc0 + wc * 32 + 8 * fq;
#pragma unroll
        for (int ai = 0; ai < 2; ++ai)
#pragma unroll
            for (int m = 0; m < 4; ++m) { const int r = row0 + ai * HALF + m * 16; if (r < u.nrows) { unsigned char* rowp = O + (size_t)(u.o0 + r) * ldc + col0;
#pragma unroll
                for (int bj = 0; bj < 2; ++bj) { const f32x4 v0 = acc[ai][bj][m][0], v1 = acc[ai][bj][m][1]; int w0 = 0, w1 = 0;
                    w0 = __builtin_amdgcn_cvt_pk_fp8_f32(v0[0], v0[1], w0, false); w0 = __builtin_amdgcn_cvt_pk_fp8_f32(v0[2], v0[3], w0, true);
                    w1 = __builtin_amdgcn_cvt_pk_fp8_f32(v1[0], v1[1], w1, false); w1 = __builtin_amdgcn_cvt_pk_fp8_f32(v1[2], v1[3], w1, true);
                    v2u w; w.x = (unsigned)w0; w.y = (unsigned)w1; *(v2u*)(rowp + bj * HALF) = w; } } }
    }
};
struct EpiSwiGLU {
    static constexpr bool PERM = true, HAS_MID = false;
    bf16* O;
    __device__ __forceinline__ void operator()(const f32x4 (&acc)[2][2][4][2], const Unit& u, int wr, int wc, int fr, int fq) const {
        const int row0 = wr * 64 + fr, col0 = (u.oc0 >> 1) + wc * 32 + 8 * fq;
#pragma unroll
        for (int ai = 0; ai < 2; ++ai)
#pragma unroll
            for (int m = 0; m < 4; ++m) { const int r = row0 + ai * HALF + m * 16; if (r < u.nrows) { bf16* rowp = O + (size_t)(u.o0 + r) * DE + col0;
                const f32x4 g0 = acc[ai][0][m][0], g1 = acc[ai][0][m][1], u0 = acc[ai][1][m][0], u1 = acc[ai][1][m][1];
                v4u w; w.x = cvt_pk_bf16(siluf_(g0[0]) * u0[0], siluf_(g0[1]) * u0[1]); w.y = cvt_pk_bf16(siluf_(g0[2]) * u0[2], siluf_(g0[3]) * u0[3]);
                w.z = cvt_pk_bf16(siluf_(g1[0]) * u1[0], siluf_(g1[1]) * u1[1]); w.w = cvt_pk_bf16(siluf_(g1[2]) * u1[2], siluf_(g1[3]) * u1[3]);
                *(v4u*)rowp = w; } }
    }
};

constexpr int ROWTAB_OFF = 131072 + 11264, GWTAB_OFF = ROWTAB_OFF + 2048;
template <class Epi, class Sched, bool GATHER>
__device__ __forceinline__ void gemm_phase(LAS unsigned char* lds, const int tid, const Gemm g, const Sched& S, const Epi& E) {
    const int wid = __builtin_amdgcn_readfirstlane(tid >> 6), lane = tid & 63, wr = wid >> 2, wc = wid & 3, fr = lane & 15, fq = lane >> 4;
    const int K = g.K, nt = K / BK;
    int sR, sC; stage_rc(tid * 16, sR, sC);
    const unsigned voffA = (unsigned)(sR * K + sC) * 2u;
    const unsigned voffB = (unsigned)((Epi::PERM ? ((sR & ~31) + perm32(sR & 31)) : sR) * K + sC) * 2u;
    const size_t kstep = (size_t)(BK * 2);
    const size_t pstep = (size_t)64 * K * 2;
    const size_t hstep = (size_t)HALF * K * 2;
    const unsigned ldsw = (unsigned)wid * 1024u;
    const int aoff = lds_byte(wr * 64 + fr, fq * 8), boff = lds_byte(wc * 32 + fr, fq * 8);
    LAS unsigned* rowtab = (LAS unsigned*)(lds + ROWTAB_OFF);
#define PG8_SA(b, h) (((b) * 2 + (h)) * HTB)
#define PG8_SB(b, h) ((4 + (b) * 2 + (h)) * HTB)
#define PG8_STAGE(bufoff, gbase, voff) do { _Pragma("unroll") for (int _i = 0; _i < 2; ++_i) { const char* _gb = (const char*)(gbase) + _i * pstep; asm volatile("" : "+s"(_gb));   \
        __builtin_amdgcn_global_load_lds((const unsigned*)(_gb + (voff)), (LAS unsigned*)(lds + (bufoff) + ldsw + _i * 8192), 16, 0, 0); } } while (0)
#define PG8_STAGE_G(bufoff, kb, sel, h) do { _Pragma("unroll") for (int _i = 0; _i < 2; ++_i) { const unsigned _ro = rowtab[(sel) * 256 + (h) * HALF + sR + 64 * _i] + (unsigned)(sC * 2); const char* _gb = (const char*)(kb); asm volatile("" : "+s"(_gb)); \
        __builtin_amdgcn_global_load_lds((const unsigned*)(_gb + _ro), (LAS unsigned*)(lds + (bufoff) + ldsw + _i * 8192), 16, 0, 0); } } while (0)
#define PG8_STAGE_A(bufoff, basep, kb, sel, h) do { if constexpr (GATHER) PG8_STAGE_G(bufoff, (const char*)g.A + (kb), sel, h); else PG8_STAGE(bufoff, (basep) + (kb) + (h) * hstep, voffA); } while (0)
#define PG8_ROWTAB(sel, u) do { if (tid < 256) { const int _rr = tid < (u).nrows ? tid : (u).nrows - 1; rowtab[(sel) * 256 + tid] = (unsigned)g.list[(u).x0 + _rr] * (unsigned)(K * 2); } } while (0)
#define PG8_LDA(dst, b, h) do { _Pragma("unroll") for (int m = 0; m < 4; ++m) _Pragma("unroll") for (int k = 0; k < 2; ++k) dst[m][k] = *(const LAS bf16x8*)(lds + PG8_SA(b, h) + aoff + m * 2048 + k * 1024); } while (0)
#define PG8_LDB(dst, b, h) do { _Pragma("unroll") for (int n = 0; n < 2; ++n) _Pragma("unroll") for (int k = 0; k < 2; ++k) dst[n][k] = *(const LAS bf16x8*)(lds + PG8_SB(b, h) + boff + n * 2048 + k * 1024); } while (0)
#define PG8_MMA(ai, bj, At, Bt) do { __builtin_amdgcn_s_setprio(1); _Pragma("unroll") for (int m = 0; m < 4; ++m) _Pragma("unroll") for (int n = 0; n < 2; ++n) _Pragma("unroll") for (int k = 0; k < 2; ++k) \
        acc[ai][bj][m][n] = __builtin_amdgcn_mfma_f32_16x16x32_bf16(Bt[n][k], At[m][k], acc[ai][bj][m][n], 0, 0, 0); __builtin_amdgcn_s_setprio(0); } while (0)
#define PG8_WAIT_V(n) asm volatile("s_waitcnt vmcnt(" #n ")" ::: "memory")
#define PG8_WAIT_L(n) asm volatile("s_waitcnt lgkmcnt(" #n ")" ::: "memory")
#define PG8_BAR __builtin_amdgcn_s_barrier()
#define PG8_SCHED __builtin_amdgcn_sched_barrier(0)
    Unit cur, nxt; int ui = 0;
    if (!S.next(0, cur)) return;
    f32x4 acc[2][2][4][2];
#pragma unroll
    for (int a = 0; a < 2; ++a)
#pragma unroll
        for (int b = 0; b < 2; ++b)
#pragma unroll
            for (int m = 0; m < 4; ++m)
#pragma unroll
                for (int n = 0; n < 2; ++n) acc[a][b][m][n] = (f32x4){0.f, 0.f, 0.f, 0.f};
    bf16x8 At[4][2], B0[2][2], B1[2][2];
    int par = 0;
    if constexpr (GATHER) { PG8_ROWTAB(0, cur); asm volatile("s_waitcnt vmcnt(0) lgkmcnt(0)" ::: "memory"); __syncthreads(); }
    const char* cA = (const char*)g.A + (size_t)cur.a0 * K * 2;
    const char* cB = (const char*)g.Bt + (size_t)cur.b0 * K * 2;
    PG8_STAGE(PG8_SB(0, 0), cB, voffB); PG8_STAGE(PG8_SB(0, 1), cB + hstep, voffB); PG8_STAGE_A(PG8_SA(0, 0), cA, 0, 0, 0); PG8_STAGE_A(PG8_SA(0, 1), cA, 0, 0, 1);
    if (wr == 1) PG8_BAR;
    PG8_WAIT_V(2); PG8_BAR;
    PG8_STAGE(PG8_SB(1, 0), cB + kstep, voffB); PG8_STAGE_A(PG8_SA(1, 0), cA, kstep, 0, 0); PG8_STAGE(PG8_SB(1, 1), cB + hstep + kstep, voffB);
    PG8_WAIT_V(6); PG8_BAR;
    for (;;) {
        const bool has_next = S.next(ui + 1, nxt);
        if constexpr (GATHER) { if (has_next) { PG8_ROWTAB(par ^ 1, nxt); asm volatile("s_waitcnt vmcnt(0) lgkmcnt(0)" ::: "memory"); } }
        const char* nA = has_next ? (const char*)g.A + (size_t)nxt.a0 * K * 2 : cA;
        const char* nB = has_next ? (const char*)g.Bt + (size_t)nxt.b0 * K * 2 : cB;
        const int npar = has_next ? (par ^ 1) : par;
        for (int t = 0; t < nt; t += 2) {
            if constexpr (Epi::HAS_MID) { if (t == nt / 2) E.mid(acc, cur, wr, wc, fr, fq); }
            const bool last = (t == nt - 2);
            const size_t k1 = (size_t)(t + 1) * kstep;
            const char* a2 = last ? nA : cA; const size_t k2 = last ? 0 : (size_t)(t + 2) * kstep; const char* b2 = last ? nB : cB + (size_t)(t + 2) * kstep;
            const size_t k3 = k2 + kstep; const char* b3 = b2 + kstep;
            const int p2 = last ? npar : par;
            PG8_LDB(B0, 0, 0); PG8_LDB(B1, 0, 1); PG8_SCHED; PG8_LDA(At, 0, 0); PG8_STAGE_A(PG8_SA(1, 1), cA, k1, par, 1);
            PG8_WAIT_V(8); PG8_WAIT_L(0); PG8_BAR; PG8_MMA(0, 0, At, B0); PG8_MMA(0, 1, At, B1); PG8_BAR; PG8_SCHED;
            PG8_LDA(At, 0, 1); PG8_STAGE(PG8_SB(0, 0), b2, voffB); PG8_STAGE(PG8_SB(0, 1), b2 + hstep, voffB); PG8_STAGE_A(PG8_SA(0, 0), a2, k2, p2, 0);
            PG8_WAIT_V(8); PG8_WAIT_L(0); PG8_BAR; PG8_MMA(1, 0, At, B0); PG8_MMA(1, 1, At, B1); PG8_BAR; PG8_SCHED;
            PG8_LDB(B0, 1, 0); PG8_LDB(B1, 1, 1); PG8_SCHED; PG8_LDA(At, 1, 0); PG8_STAGE_A(PG8_SA(0, 1), a2, k2, p2, 1);
            PG8_WAIT_V(8); PG8_WAIT_L(0); PG8_BAR; PG8_MMA(0, 0, At, B0); PG8_MMA(0, 1, At, B1); PG8_BAR; PG8_SCHED;
            PG8_LDA(At, 1, 1); PG8_STAGE(PG8_SB(1, 0), b3, voffB); PG8_STAGE(PG8_SB(1, 1), b3 + hstep, voffB); PG8_STAGE_A(PG8_SA(1, 0), a2, k3, p2, 0);
            PG8_WAIT_V(8); PG8_WAIT_L(0); PG8_BAR; PG8_MMA(1, 0, At, B0); PG8_MMA(1, 1, At, B1); PG8_BAR; PG8_SCHED;
        }
        if (wr == 0) PG8_BAR;
        E(acc, cur, wr, wc, fr, fq);
        if (!has_next) break;
#pragma unroll
        for (int a = 0; a < 2; ++a)
#pragma unroll
            for (int b = 0; b < 2; ++b)
#pragma unroll
                for (int m = 0; m < 4; ++m)
#pragma unroll
                    for (int n = 0; n < 2; ++n) acc[a][b][m][n] = (f32x4){0.f, 0.f, 0.f, 0.f};
        cur = nxt; cA = nA; cB = nB; par = npar; ++ui;
        if (wr == 1) PG8_BAR;
    }
    PG8_WAIT_V(0);
    PG8_BAR;
#undef PG8_SA
#undef PG8_SB
#undef PG8_STAGE
#undef PG8_STAGE_G
#undef PG8_STAGE_A
#undef PG8_ROWTAB
#undef PG8_LDA
#undef PG8_LDB
#undef PG8_MMA
#undef PG8_WAIT_V
#undef PG8_WAIT_L
#undef PG8_BAR
#undef PG8_SCHED
}
}

#define XB_TMO      128
#define XB_XCNT(j)  (256  + 64 * (j))
#define XB_XSUB(j)  (1280 + 64 * (j))
#define XB_XGEN(j)  (2304 + 64 * (j))
#define XB_TOP      3328
#define XB_TOPGEN   3392
#define XCD_BAR_WORDS 3456
#define XB_SPIN_CAP (1u << 18)
__device__ __forceinline__ unsigned xb_ld(unsigned* p)              { return __hip_atomic_load(p, __ATOMIC_RELAXED, __HIP_MEMORY_SCOPE_AGENT); }
__device__ __forceinline__ unsigned xb_add(unsigned* p, unsigned v) { return __hip_atomic_fetch_add(p, v, __ATOMIC_RELAXED, __HIP_MEMORY_SCOPE_AGENT); }
__device__ __forceinline__ unsigned xb_xcc_id() { return (unsigned)__builtin_amdgcn_s_getreg((3 << 11) | 20) & 0xFu; }
#define XB_SPIN(cond, bar) do { unsigned _sp = 0; while (cond) { __builtin_amdgcn_s_sleep(1); \
    if ((++_sp & 255u) == 0u) { if (xb_ld(&(bar)[XB_TMO])) break; if (_sp > XB_SPIN_CAP) { atomicAdd(&(bar)[XB_TMO], 1u); break; } } } } while (0)
struct XcdBarrier { unsigned* bar; unsigned x; volatile LAS unsigned* st; };
__device__ __forceinline__ XcdBarrier xcd_barrier_post(unsigned* bar, volatile LAS unsigned* st) {
    XcdBarrier b; b.bar = bar; b.x = xb_xcc_id(); b.st = st;
    if (threadIdx.x == 0) (void)xb_add(&bar[XB_XCNT(b.x)], 1u);
    return b;
}
__device__ __forceinline__ void xcd_barrier_complete(unsigned* bar, unsigned x, unsigned& nloc, unsigned& nx) {
    const unsigned G = gridDim.x * gridDim.y * gridDim.z;
    unsigned sum, cnt, mine, sp = 0u;
    for (;;) {
        sum = 0u; cnt = 0u; mine = 0u;
#pragma unroll
        for (unsigned j = 0; j < 16; ++j) { const unsigned c = xb_ld(&bar[XB_XCNT(j)]); sum += c; cnt += (c > 0u) ? 1u : 0u; mine = (j == x) ? c : mine; }
        if (sum == G) break;
        __builtin_amdgcn_s_sleep(1);
        if ((++sp & 255u) == 0u) { if (xb_ld(&bar[XB_TMO])) break; if (sp > XB_SPIN_CAP) { atomicAdd(&bar[XB_TMO], 1u); break; } }
    }
    nloc = mine > 0u ? mine : 1u; nx = cnt > 0u ? cnt : 1u;
}
__device__ __forceinline__ void xcd_barrier(const XcdBarrier& b, const int tid) {
    asm volatile("s_waitcnt vmcnt(0)" ::: "memory");
    __syncthreads();
    if (tid == 0) {
        unsigned* bar = b.bar;
        __builtin_amdgcn_s_waitcnt(0);
        unsigned nloc = b.st[0], nx = b.st[1];
        if (nloc == 0u) { xcd_barrier_complete(bar, b.x, nloc, nx); b.st[0] = nloc; b.st[1] = nx; }
        const unsigned old = xb_add(&bar[XB_XSUB(b.x)], 1u);
        const unsigned gen = old / nloc;
        if (old + 1u == (gen + 1u) * nloc) {
            __builtin_amdgcn_fence(__ATOMIC_RELEASE, "agent");
            asm volatile("s_waitcnt vmcnt(0)" ::: "memory");
            const unsigned og = xb_add(&bar[XB_TOP], 1u);
            const unsigned tg = og / nx;
            if (og + 1u == (tg + 1u) * nx) xb_add(&bar[XB_TOPGEN], 1u);
            else XB_SPIN(xb_ld(&bar[XB_TOPGEN]) == tg, bar);
            __builtin_amdgcn_fence(__ATOMIC_ACQUIRE, "agent");
            xb_add(&bar[XB_XGEN(b.x)], 1u);
            asm volatile("s_waitcnt vmcnt(0)" ::: "memory");
        } else {
            XB_SPIN(xb_ld(&bar[XB_XGEN(b.x)]) == gen, bar);
            __builtin_amdgcn_fence(__ATOMIC_ACQUIRE, "agent");
            asm volatile("s_waitcnt vmcnt(0)" ::: "memory");
        }
    }
    __syncthreads();
}

struct Args { const float* in[N_IN]; float* out; unsigned char* ws; int ph_lo, ph_hi; };
struct Frame {
    LAS unsigned char* lds;
    int tid, lane, wave, G, bid;
    const float* const __attribute__((address_space(4)))* in; float* out; unsigned char* ws;
};
__device__ __forceinline__ const float* mod_ptr(const Frame& F, int l, int b, int part) { return (const float*)(F.ws + WS_MOD) + ((size_t)(l * NB + b) * 6 + part) * D; }

__device__ __forceinline__ void transpose_item(const float* W, int N, int k0, int n0, bf16* WT, int ldo, int drow0, int dcol0, LAS float* scr, int lane) {
    float tv[32];
#pragma unroll
    for (int i = 0; i < 32; ++i) tv[i] = W[(size_t)(k0 + 2 * i + (lane >> 5)) * N + n0 + (lane & 31)];
#pragma unroll
    for (int i = 0; i < 32; ++i) scr[(2 * i + (lane >> 5)) * 33 + (lane & 31)] = tv[i];
    LDS_WAIT(); asm volatile("" ::: "memory");
    const int c = lane & 7;
#pragma unroll
    for (int j = 0; j < 4; ++j) { const int n = (lane >> 3) + 8 * j; const LAS float* s = scr + (8 * c) * 33 + n;
        v4u o; o.x = pk2(s[0 * 33], s[1 * 33]); o.y = pk2(s[2 * 33], s[3 * 33]); o.z = pk2(s[4 * 33], s[5 * 33]); o.w = pk2(s[6 * 33], s[7 * 33]);
        *(GAS v4u*)(WT + (size_t)(drow0 + n) * ldo + dcol0 + k0 + 8 * c) = o; }
    LDS_WAIT(); asm volatile("" ::: "memory");
}
__device__ __forceinline__ int titems(int K, int N) { return (K / 64) * (N / 32); }
__device__ __forceinline__ void tdo(const float* W, int K, int N, int item, bf16* WT, int ldo, int drow0, LAS float* scr, int lane) {
    const int nblk = N / 32, kb = item / nblk, nb = item % nblk; transpose_item(W, N, 64 * kb, 32 * nb, WT, ldo, drow0 + 32 * nb, 0, scr, lane);
}

__device__ __forceinline__ void phase_mix_weights(Frame& F, int gw, int NGW) {
    LAS float* scr = (LAS float*)(F.lds + 65536 + F.wave * 8704);
    constexpr int T_WIN = (D / 64) * (DIN / 32), T_PC = (CW / 64) * (D / 32), T_PR = (RW / 64) * (D / 32), T_WO = (D / 64) * (D / 32), T_L = T_WIN + T_PC + T_PR + T_WO;
    for (int it = gw; it < DEPTH * T_L; it += NGW) {
        const int l = it / T_L; int r = it % T_L; unsigned char* wm = F.ws + WS_WMIX + (size_t)l * WMIX_STRIDE;
        if (r < T_WIN) { tdo(F.in[I_WIN] + (size_t)l * D * DIN, D, DIN, r, (bf16*)(wm + WM_WIN), D, 0, scr, F.lane); continue; } r -= T_WIN;
        if (r < T_PC) { tdo(F.in[I_PCONV] + (size_t)l * CW * D, CW, D, r, (bf16*)(wm + WM_PCONV), D, 0, scr, F.lane); continue; } r -= T_PC;
        if (r < T_PR) { tdo(F.in[I_PRWKV] + (size_t)l * RW * D, RW, D, r, (bf16*)(wm + WM_PCONV) + CW, D, 0, scr, F.lane); continue; } r -= T_PR;
        tdo(F.in[I_WO] + (size_t)l * D * D, D, D, r, (bf16*)(wm + WM_WO), D, 0, scr, F.lane);
    }
    for (int i = gw * 64 + F.lane; i < DEPTH * NE * D; i += NGW * 64) { const int l = i / (NE * D), r = i % (NE * D), e = r / D, k = r % D;
        const float v = F.in[I_WROUTER][((size_t)l * D + k) * NE + e]; const unsigned hi = f2bf(v); unsigned char* wm = F.ws + WS_WMIX + (size_t)l * WMIX_STRIDE;
        ((bf16*)(wm + WM_RHI))[r] = (bf16)hi; ((bf16*)(wm + WM_RLO))[r] = (bf16)f2bf(v - bf2f(hi)); }
    for (int i = gw * 64 + F.lane; i < DEPTH * NLORA * KLORA; i += NGW * 64) {
        const int l = i / (NLORA * KLORA), r = i % (NLORA * KLORA), n = r / KLORA, k = r % KLORA; float v = 0.f;
        if (n < 512) { if (k < 64) v = F.in[I_W2][((size_t)l * LW + k) * RW + n]; }
        else if (n < 1024) { if (k >= 64 && k < 128) v = F.in[I_A2][((size_t)l * LA + (k - 64)) * RW + (n - 512)]; }
        else { if (k >= 128) v = F.in[I_G2][((size_t)l * LG + (k - 128)) * RW + (n - 1024)]; }
        ((bf16*)(F.ws + WS_WMIX + (size_t)l * WMIX_STRIDE + WM_LORA))[r] = (bf16)f2bf(v);
    }
}
__device__ __forceinline__ void phase_expert_weights(Frame& F, int l, int gw, int NGW) {
    LAS float* scr = (LAS float*)(F.lds + 65536 + F.wave * 8704);
    bf16* WGU = (bf16*)(F.ws + WS_WGU); bf16* WDN = (bf16*)(F.ws + WS_WDN);
    constexpr int T_G = (D / 64) * (DE / 32), T_D = (DE / 64) * (D / 32), T_E = 2 * T_G + T_D;
    for (int it = gw; it < (NE + 1) * T_E; it += NGW) {
        const int e = it / T_E; int r = it % T_E;
        if (r < 2 * T_G) { const int up = r >= T_G; if (up) r -= T_G;
            const float* W = (e < NE) ? (up ? F.in[I_WEU] : F.in[I_WEG]) + ((size_t)l * NE + e) * D * DE : (up ? F.in[I_WSU] : F.in[I_WSG]) + (size_t)l * D * DE;
            const int nblk = DE / 32, kb = r / nblk, nb = r % nblk, n0 = 32 * nb;
            const int drow0 = e * 512 + (n0 >> 7) * 256 + (up ? 128 : 0) + (n0 & 127);
            transpose_item(W, DE, 64 * kb, n0, WGU, D, drow0, 0, scr, F.lane);
        } else { r -= 2 * T_G;
            const float* W = (e < NE) ? F.in[I_WED] + ((size_t)l * NE + e) * DE * D : F.in[I_WSD] + (size_t)l * DE * D;
            tdo(W, DE, D, r, WDN, DE, e * D, scr, F.lane);
        }
    }
}
__device__ __forceinline__ void phase_ada(Frame& F) {
    LAS float* sc = (LAS float*)F.lds;
    LAS float* red = (LAS float*)(F.lds + 32768);
    for (int i = F.tid; i < NB * D; i += NTHREADS) { const int b = i / D, k = i % D; sc[k * 8 + b] = siluf_(F.in[I_C][i]); }
    __syncthreads();
    float* mod = (float*)(F.ws + WS_MOD);
    for (int it = F.bid; it < DEPTH * 96; it += F.G) {
        const int l = it / 96, n0 = (it % 96) * 64;
        float acc[8];
#pragma unroll
        for (int b = 0; b < 8; ++b) acc[b] = 0.f;
        const float* wp = F.in[I_WADA] + ((size_t)l * D + F.wave * 128) * (6 * D) + n0 + F.lane;
#pragma unroll 4
        for (int k = 0; k < 128; ++k) { const float wv = wp[(size_t)k * (6 * D)]; const LAS f32x4* s = (const LAS f32x4*)(sc + (F.wave * 128 + k) * 8); const f32x4 s0 = s[0], s1 = s[1];
            acc[0] += s0[0] * wv; acc[1] += s0[1] * wv; acc[2] += s0[2] * wv; acc[3] += s0[3] * wv; acc[4] += s1[0] * wv; acc[5] += s1[1] * wv; acc[6] += s1[2] * wv; acc[7] += s1[3] * wv; }
#pragma unroll
        for (int b = 0; b < 8; ++b) red[(F.wave * 8 + b) * 64 + F.lane] = acc[b];
        __syncthreads();
        { const int b = F.tid >> 6; float s = F.in[I_BADA][(size_t)l * 6 * D + n0 + F.lane];
#pragma unroll
          for (int w = 0; w < 8; ++w) s += red[(w * 8 + b) * 64 + F.lane];
          mod[((size_t)l * NB + b) * 6 * D + n0 + F.lane] = s; }
        __syncthreads();
    }
}

struct Row { f32x4 v[4]; };
__device__ __forceinline__ Row row_load(const float* p, int lane) { Row r; const f32x4* q = (const f32x4*)p + lane;
#pragma unroll
    for (int j = 0; j < 4; ++j) r.v[j] = q[64 * j]; return r; }
__device__ __forceinline__ void row_store(float* p, int lane, const Row& r) { f32x4* q = (f32x4*)p + lane;
#pragma unroll
    for (int j = 0; j < 4; ++j) q[64 * j] = r.v[j]; }
__device__ __forceinline__ float row_sumsq(const Row& r) { float s = 0.f;
#pragma unroll
    for (int j = 0; j < 4; ++j) s += (r.v[j][0] * r.v[j][0] + r.v[j][1] * r.v[j][1]) + (r.v[j][2] * r.v[j][2] + r.v[j][3] * r.v[j][3]); return wave_sum(s); }
__device__ __forceinline__ Row row_modnorm(const Row& x, const float* g, const float* sc, const float* sh, int lane) {
    const float rs = rsqrtf(row_sumsq(x) * (1.0f / D) + RMS_EPS); Row gg = row_load(g, lane), s1 = row_load(sc, lane), s0 = row_load(sh, lane), h;
#pragma unroll
    for (int j = 0; j < 4; ++j) h.v[j] = x.v[j] * rs * gg.v[j] * (1.0f + s1.v[j]) + s0.v[j]; return h; }
__device__ __forceinline__ void row_store_bf16(bf16* p, int lane, const Row& r) { v2u* q = (v2u*)p + lane;
#pragma unroll
    for (int j = 0; j < 4; ++j) { v2u w; w.x = pk2(r.v[j][0], r.v[j][1]); w.y = pk2(r.v[j][2], r.v[j][3]); q[64 * j] = w; } }

__device__ __forceinline__ Row row_load_bf16(const bf16* p, int lane) { Row r; const v2u* q = (const v2u*)p + lane;
#pragma unroll
    for (int j = 0; j < 4; ++j) { const v2u w = q[64 * j]; r.v[j] = (f32x4){bflo(w.x), bfhi(w.x), bflo(w.y), bfhi(w.y)}; } return r; }
__device__ __forceinline__ void phase_rowA(Frame& F, int gw, int NGW) {
    bf16* H = (bf16*)(F.ws + WS_H);
    for (int m = gw; m < M; m += NGW) { const int b = m / SEQ; Row x = row_load(F.in[I_X] + (size_t)m * D, F.lane);
        Row h = row_modnorm(x, F.in[I_NMPRE], mod_ptr(F, 0, b, 1), mod_ptr(F, 0, b, 0), F.lane); row_store_bf16(H + (size_t)m * D, F.lane, h); }
}

__device__ __forceinline__ void phase_conv(Frame& F, int l) {
    const bf16* Z = (const bf16*)(F.ws + WS_ZC); bf16* UC = (bf16*)(F.ws + WS_UC);
    LAS float* tile = (LAS float*)F.lds;
    const int c = F.tid;
    float w[CKW];
#pragma unroll
    for (int j = 0; j < CKW; ++j) w[j] = F.in[I_CONVW][((size_t)l * CKW + j) * CW + c];
    const float bias = F.in[I_CONVB][l * CW + c];
    for (int ti = F.bid; ti < M / 32; ti += F.G) {
        const int t0 = ti * 32, s0 = t0 % SEQ;
        float u[62];
#pragma unroll
        for (int i = 0; i < 62; ++i) { const bool ok = (s0 - 30 + i >= 0); const bf16* zr = Z + (size_t)(ok ? t0 - 30 + i : t0) * ZCW;
            const float a = bf2f(zr[c]), gt_ = bf2f(zr[CW + c]); u[i] = ok ? a * sigmoidf_(gt_) : 0.f; }
#pragma unroll
        for (int o = 0; o < 32; ++o) { float a = bias;
#pragma unroll
            for (int j = 0; j < CKW; ++j) a += u[o + j] * w[j];
            tile[o * CW + c] = a; }
        __syncthreads();
#pragma unroll
        for (int q = 0; q < 4; ++q) { const int o = 4 * F.wave + q; float v[8]; float s = 0.f;
#pragma unroll
            for (int i = 0; i < 8; ++i) { v[i] = tile[o * CW + F.lane + 64 * i]; s += v[i]; }
            const float mean = wave_sum(s) * (1.0f / CW); float s2 = 0.f;
#pragma unroll
            for (int i = 0; i < 8; ++i) { v[i] -= mean; s2 += v[i] * v[i]; }
            const float rstd = rsqrtf(wave_sum(s2) * (1.0f / CW) + LN_EPS);
#pragma unroll
            for (int i = 0; i < 8; ++i) { const int cc = F.lane + 64 * i; const float y = v[i] * rstd * F.in[I_CLNG][l * CW + cc] + F.in[I_CLNB][l * CW + cc];
                UC[(size_t)(t0 + o) * D + cc] = (bf16)f2bf(siluf_(y)); } }
        __syncthreads();
    }
}
__device__ __forceinline__ void phase_prep1(Frame& F, int l, int gw, int NGW) {
    const bf16* Z = (const bf16*)(F.ws + WS_ZR); bf16* LIN = (bf16*)(F.ws + WS_LIN);
    const f32x4 mu = *((const f32x4*)(F.in[I_MU] + (size_t)l * COLR + 1536) + F.lane);
    for (int m = gw; m < M; m += NGW) {
        const int s = m % SEQ; const v2u cur = *((const v2u*)(Z + (size_t)m * ZRW + 1536) + F.lane);
        v2u prv = *((const v2u*)(Z + (size_t)(s > 0 ? m - 1 : m) * ZRW + 1536) + F.lane); if (s == 0) { prv.x = 0u; prv.y = 0u; }
        float x[4] = {bflo(cur.x), bfhi(cur.x), bflo(cur.y), bfhi(cur.y)}; const float p[4] = {bflo(prv.x), bfhi(prv.x), bflo(prv.y), bfhi(prv.y)};
#pragma unroll
        for (int i = 0; i < 4; ++i) { x[i] = x[i] + (p[i] - x[i]) * mu[i]; if (F.lane < 16) x[i] = tanhf(x[i]); else if (F.lane >= 32) x[i] = sigmoidf_(x[i]); }
        v2u o; o.x = pk2(x[0], x[1]); o.y = pk2(x[2], x[3]); *((v2u*)(LIN + (size_t)m * KLORA) + F.lane) = o;
    }
}
__device__ __forceinline__ void ld8bf(const bf16* p, float (&o)[8]) { const v4u w = *(const v4u*)p; o[0] = bflo(w.x); o[1] = bfhi(w.x); o[2] = bflo(w.y); o[3] = bfhi(w.y); o[4] = bflo(w.z); o[5] = bfhi(w.z); o[6] = bflo(w.w); o[7] = bfhi(w.w); }
__device__ __forceinline__ void st8bf(bf16* p, const float (&o)[8]) { v4u w; w.x = pk2(o[0], o[1]); w.y = pk2(o[2], o[3]); w.z = pk2(o[4], o[5]); w.w = pk2(o[6], o[7]); *(v4u*)p = w; }
__device__ __forceinline__ void ld8f(const float* p, float (&o)[8]) { const f32x4 a = *(const f32x4*)p, b = *((const f32x4*)p + 1); o[0] = a[0]; o[1] = a[1]; o[2] = a[2]; o[3] = a[3]; o[4] = b[0]; o[5] = b[1]; o[6] = b[2]; o[7] = b[3]; }
__device__ __forceinline__ float grp8_sum(float v) { v += __shfl_xor(v, 1); v += __shfl_xor(v, 2); v += __shfl_xor(v, 4); return v; }
__device__ __forceinline__ void phase_prep2(Frame& F, int l, int gw, int NGW) {
    const bf16* Z = (const bf16*)(F.ws + WS_ZR); const bf16* LOUT = (const bf16*)(F.ws + WS_LOUT);
    bf16* SR = (bf16*)(F.ws + WS_SR); bf16* SKP = (bf16*)(F.ws + WS_SKP); bf16* SV = (bf16*)(F.ws + WS_SV); bf16* SKKN = (bf16*)(F.ws + WS_SKKN); bf16* SKA = (bf16*)(F.ws + WS_SKA);
    float* SDEC = (float*)(F.ws + WS_SDEC); float* BONUS = (float*)(F.ws + WS_BONUS);
    const int c = 8 * F.lane;
    float mur[8], muk[8], muv[8], w0[8], a0[8], kkw[8], kaw[8], rkw[8];
    ld8f(F.in[I_MU] + (size_t)l * COLR + c, mur); ld8f(F.in[I_MU] + (size_t)l * COLR + 512 + c, muk); ld8f(F.in[I_MU] + (size_t)l * COLR + 1024 + c, muv);
    ld8f(F.in[I_W0] + l * RW + c, w0); ld8f(F.in[I_A0] + l * RW + c, a0); ld8f(F.in[I_KK] + l * RW + c, kkw); ld8f(F.in[I_KA] + l * RW + c, kaw); ld8f(F.in[I_RK] + l * RW + c, rkw);
    for (int m = gw; m < M; m += NGW) {
        const int s = m % SEQ; const bf16* zr = Z + (size_t)m * ZRW + c;
        float r[8], k[8], v[8], pr[8], pk[8], pv[8], lw[8], la[8];
        ld8bf(zr, r); ld8bf(zr + 512, k); ld8bf(zr + 1024, v);
        { const bf16* zp = (s > 0) ? zr - ZRW : zr; ld8bf(zp, pr); ld8bf(zp + 512, pk); ld8bf(zp + 1024, pv); }
        if (s == 0) {
#pragma unroll
            for (int i = 0; i < 8; ++i) { pr[i] = 0.f; pk[i] = 0.f; pv[i] = 0.f; } }
        ld8bf(LOUT + (size_t)m * NLORA + c, lw); ld8bf(LOUT + (size_t)m * NLORA + 512 + c, la);
        float dec[8], kp[8], kk[8], ka[8]; float ss = 0.f, bo = 0.f;
#pragma unroll
        for (int i = 0; i < 8; ++i) {
            r[i] += (pr[i] - r[i]) * mur[i]; k[i] += (pk[i] - k[i]) * muk[i]; v[i] += (pv[i] - v[i]) * muv[i];
            dec[i] = __expf(-0.60653066f * sigmoidf_(w0[i] + lw[i]));
            const float a = sigmoidf_(a0[i] + la[i]);
            kk[i] = k[i] * kkw[i]; kp[i] = k[i] * (1.0f + (a - 1.0f) * kaw[i]); ka[i] = a;
            ss += kk[i] * kk[i]; bo += r[i] * kp[i] * rkw[i];
        }
        ss = grp8_sum(ss); bo = grp8_sum(bo);
        const float inv = rsqrtf(fmaxf(ss, 1e-24f));
#pragma unroll
        for (int i = 0; i < 8; ++i) { kk[i] *= inv; ka[i] *= kk[i]; }
        const size_t o = (size_t)m * RW + c;
        st8bf(SR + o, r); st8bf(SKP + o, kp); st8bf(SV + o, v); st8bf(SKKN + o, kk); st8bf(SKA + o, ka);
        *(f32x4*)(SDEC + o) = (f32x4){dec[0], dec[1], dec[2], dec[3]}; *((f32x4*)(SDEC + o) + 1) = (f32x4){dec[4], dec[5], dec[6], dec[7]};
        if ((F.lane & 7) == 0) BONUS[(size_t)m * NH + (F.lane >> 3)] = bo;
    }
}
__device__ __forceinline__ void phase_scan(Frame& F) {
    const bf16* SR = (const bf16*)(F.ws + WS_SR); const bf16* SKP = (const bf16*)(F.ws + WS_SKP); const bf16* SV = (const bf16*)(F.ws + WS_SV);
    const bf16* SKKN = (const bf16*)(F.ws + WS_SKKN); const bf16* SKA = (const bf16*)(F.ws + WS_SKA); const float* SDEC = (const float*)(F.ws + WS_SDEC);
    float* YS = (float*)(F.ws + WS_YS);
    LAS float* buf = (LAS float*)F.lds;
    const int vr = F.lane >> 3, ke = F.lane & 7, vidx = 8 * F.wave + vr;
    for (int bh = F.bid; bh < NB * NH; bh += F.G) {
        const int b = bh / NH, h = bh % NH; const size_t m0 = (size_t)b * SEQ;
        float S[8];
#pragma unroll
        for (int i = 0; i < 8; ++i) S[i] = 0.f;
        for (int c0 = 0; c0 < SEQ; c0 += 64) {
            __syncthreads();
            for (int idx = F.tid; idx < 64 * 64; idx += NTHREADS) { const int t = idx >> 6, k = idx & 63; const size_t g = (m0 + c0 + t) * RW + h * RH + k; LAS float* d = buf + t * 384 + k;
                d[0] = bf2f(SR[g]); d[64] = SDEC[g]; d[128] = bf2f(SKP[g]); d[192] = bf2f(SKKN[g]); d[256] = bf2f(SKA[g]); d[320] = bf2f(SV[g]); }
            __syncthreads();
            for (int t = 0; t < 64; ++t) {
                const LAS float* d = buf + t * 384 + ke * 8;
                float r[8], dc[8], kp[8], kn[8], ka[8];
#pragma unroll
                for (int i = 0; i < 8; ++i) { r[i] = d[i]; dc[i] = d[64 + i]; kp[i] = d[128 + i]; kn[i] = d[192 + i]; ka[i] = d[256 + i]; }
                const float v = buf[t * 384 + 320 + vidx];
                float sa = 0.f;
#pragma unroll
                for (int i = 0; i < 8; ++i) sa += S[i] * kn[i];
                sa = -grp8_sum(sa);
                float y = 0.f;
#pragma unroll
                for (int i = 0; i < 8; ++i) { S[i] = S[i] * dc[i] + sa * ka[i] + v * kp[i]; y += S[i] * r[i]; }
                y = grp8_sum(y);
                if (ke == 0) YS[(m0 + c0 + t) * RW + h * RH + vidx] = y;
            }
        }
    }
}
constexpr int CS = 72, CBUF = 64 * CS * 2;
__device__ __forceinline__ f32x4 cmm(const LAS bf16* A, const LAS bf16* B, int m0, int n0, int lane, f32x4 acc) {
#pragma unroll
    for (int ks = 0; ks < 2; ++ks) {
        const bf16x8 a = *(const LAS bf16x8*)(A + (m0 + (lane & 15)) * CS + ks * 32 + 8 * (lane >> 4));
        const bf16x8 b = *(const LAS bf16x8*)(B + (n0 + (lane & 15)) * CS + ks * 32 + 8 * (lane >> 4));
        acc = __builtin_amdgcn_mfma_f32_16x16x32_bf16(a, b, acc, 0, 0, 0);
    }
    return acc;
}
__device__ __forceinline__ void cst4(LAS bf16* O, int n, int m, const f32x4 v) { v2u w; w.x = pk2(v[0], v[1]); w.y = pk2(v[2], v[3]); *(LAS v2u*)(O + n * CS + m) = w; }
__device__ __forceinline__ f32x4 cld4(const LAS bf16* O, int n, int m) { const v2u w = *(const LAS v2u*)(O + n * CS + m); return (f32x4){bflo(w.x), bfhi(w.x), bflo(w.y), bfhi(w.y)}; }
__device__ __forceinline__ void phase_chunkprep(Frame& F, int l) {
    float* YS = (float*)(F.ws + WS_YS); bf16* CQ = (bf16*)(F.ws + WS_CQ); bf16* CG = (bf16*)(F.ws + WS_CG); float* CH = (float*)(F.ws + WS_CH);
#define CB(i) ((LAS bf16*)(F.lds + (i) * CBUF))
    LAS float* part = (LAS float*)(F.lds + 14 * CBUF);
    LAS float* pcs = part + 512;
    const int lane = F.lane, w = F.wave, n0 = 16 * (w & 3), mA = 32 * (w >> 2), nn = n0 + (lane & 15), mq = 4 * (lane >> 4);
    const bf16* ZRp = (const bf16*)(F.ws + WS_ZR); const bf16* LOUT = (const bf16*)(F.ws + WS_LOUT); bf16* SVo = (bf16*)(F.ws + WS_SV); float* BONUS = (float*)(F.ws + WS_BONUS);
    unsigned short zr_[9], zk_[9], zv_[9], lw_[8], la_[8]; float cst[8];
#define CP_LOAD(PAIR) do { const int bh_ = (PAIR) >> 5, c_ = (PAIR) & 31, h_ = bh_ & 7; const size_t mr_ = (size_t)(bh_ >> 3) * SEQ + c_ * 64 + 8 * w; const int hc_ = h_ * RH + lane; \
        _Pragma("unroll") for (int i = 0; i < 9; ++i) { const size_t row_ = (c_ == 0 && w == 0 && i == 0) ? mr_ : mr_ + i - 1; const bf16* z_ = ZRp + row_ * ZRW + hc_; zr_[i] = z_[0]; zk_[i] = z_[512]; zv_[i] = z_[1024]; } \
        _Pragma("unroll") for (int i = 0; i < 8; ++i) { const bf16* q_ = LOUT + (mr_ + i) * NLORA + hc_; lw_[i] = q_[0]; la_[i] = q_[512]; } \
        cst[0] = F.in[I_MU][(size_t)l * COLR + hc_]; cst[1] = F.in[I_MU][(size_t)l * COLR + 512 + hc_]; cst[2] = F.in[I_MU][(size_t)l * COLR + 1024 + hc_]; \
        cst[3] = F.in[I_W0][l * RW + hc_]; cst[4] = F.in[I_A0][l * RW + hc_]; cst[5] = F.in[I_KK][l * RW + hc_]; cst[6] = F.in[I_KA][l * RW + hc_]; cst[7] = F.in[I_RK][l * RW + hc_]; } while (0)
    if (F.bid < NB * NH * (SEQ / 64)) CP_LOAD(F.bid);
    for (int pair = F.bid; pair < NB * NH * (SEQ / 64); pair += F.G) {
        const int bh = pair >> 5, c = pair & 31, b = bh >> 3, h = bh & 7; const size_t m0 = (size_t)b * SEQ + c * 64;
        {
          float dc[8], kn[8], ka[8], kp[8], rr[8], vv[8], ss[8], bo[8];
          const bool first = (c == 0 && w == 0);
#pragma unroll
          for (int i = 0; i < 8; ++i) {
              const float pr = (first && i == 0) ? 0.f : bf2f(zr_[i]), pk = (first && i == 0) ? 0.f : bf2f(zk_[i]), pv = (first && i == 0) ? 0.f : bf2f(zv_[i]);
              float r = bf2f(zr_[i + 1]), k = bf2f(zk_[i + 1]), v = bf2f(zv_[i + 1]);
              r += (pr - r) * cst[0]; k += (pk - k) * cst[1]; v += (pv - v) * cst[2];
              dc[i] = __expf(-0.60653066f * sigmoidf_(cst[3] + bf2f(lw_[i])));
              const float a = sigmoidf_(cst[4] + bf2f(la_[i]));
              const float kk = k * cst[5]; kp[i] = k * (1.0f + (a - 1.0f) * cst[6]); rr[i] = r; vv[i] = v; kn[i] = kk; ka[i] = a;
              ss[i] = kk * kk; bo[i] = r * kp[i] * cst[7]; }
#pragma unroll
          for (int o = 1; o < 64; o <<= 1) {
#pragma unroll
              for (int i = 0; i < 8; ++i) { ss[i] += __shfl_xor(ss[i], o); bo[i] += __shfl_xor(bo[i], o); } }
#pragma unroll
          for (int i = 0; i < 8; ++i) { kn[i] *= rsqrtf(fmaxf(ss[i], 1e-24f)); ka[i] *= kn[i];
              SVo[(m0 + 8 * w + i) * RW + h * RH + lane] = (bf16)f2bf(vv[i]); if (lane == 0) BONUS[(m0 + 8 * w + i) * NH + h] = bo[i]; }
          float p[8]; p[0] = dc[0];
#pragma unroll
          for (int i = 1; i < 8; ++i) p[i] = p[i - 1] * dc[i];
          part[w * 64 + lane] = p[7];
          __syncthreads();
          float pre = 1.f, tot = 1.f;
#pragma unroll
          for (int g = 0; g < 8; ++g) { const float q = part[g * 64 + lane]; tot *= q; if (g < w) pre *= q; }
          if (w == 0) pcs[lane] = tot;
          float at[8], bt[8], kt[8], rt[8], bh_[8], kh[8];
#pragma unroll
          for (int i = 0; i < 8; ++i) { const float P = pre * p[i], Pm = (i == 0) ? pre : pre * p[i - 1], inv = 1.0f / P;
              at[i] = -kn[i] * Pm; bt[i] = ka[i] * inv; kt[i] = kp[i] * inv; rt[i] = rr[i] * P; bh_[i] = bt[i] * tot; kh[i] = kt[i] * tot; }
#pragma unroll
          for (int i = 0; i < 8; ++i) { const int o = (8 * w + i) * CS + lane; CB(0)[o] = (bf16)f2bf(at[i]); CB(1)[o] = (bf16)f2bf(bt[i]); CB(2)[o] = (bf16)f2bf(kt[i]); CB(3)[o] = (bf16)f2bf(rt[i]); }
          { const int o = lane * CS + 8 * w; v4u q;
            q.x = pk2(at[0], at[1]); q.y = pk2(at[2], at[3]); q.z = pk2(at[4], at[5]); q.w = pk2(at[6], at[7]); *(LAS v4u*)(CB(4) + o) = q;
            q.x = pk2(bh_[0], bh_[1]); q.y = pk2(bh_[2], bh_[3]); q.z = pk2(bh_[4], bh_[5]); q.w = pk2(bh_[6], bh_[7]); *(LAS v4u*)(CB(5) + o) = q;
            q.x = pk2(kh[0], kh[1]); q.y = pk2(kh[2], kh[3]); q.z = pk2(kh[4], kh[5]); q.w = pk2(kh[6], kh[7]); *(LAS v4u*)(CB(6) + o) = q;
            q.x = pk2(vv[0], vv[1]); q.y = pk2(vv[2], vv[3]); q.z = pk2(vv[4], vv[5]); q.w = pk2(vv[6], vv[7]); *(LAS v4u*)(CB(7) + o) = q; }
        }
        if (pair + F.G < NB * NH * (SEQ / 64)) CP_LOAD(pair + F.G);
        __syncthreads();
        const f32x4 z4 = (f32x4){0.f, 0.f, 0.f, 0.f};
#pragma unroll
        for (int tl = 0; tl < 2; ++tl) { const int m0t = mA + 16 * tl, mm = m0t + mq;
            f32x4 a1 = cmm(CB(1), CB(0), m0t, n0, lane, z4), a2 = cmm(CB(0), CB(1), m0t, n0, lane, z4), a3 = cmm(CB(2), CB(0), m0t, n0, lane, z4);
            f32x4 a4 = cmm(CB(1), CB(3), m0t, n0, lane, z4), a5 = cmm(CB(2), CB(3), m0t, n0, lane, z4), t0;
#pragma unroll
            for (int i = 0; i < 4; ++i) { const int m = mm + i; a1[i] = (m < nn) ? a1[i] : 0.f; a2[i] = (nn < m) ? a2[i] : 0.f; a3[i] = (m < nn) ? a3[i] : 0.f; a4[i] = (m <= nn) ? a4[i] : 0.f; a5[i] = (m <= nn) ? a5[i] : 0.f; t0[i] = a1[i] + ((m == nn) ? 1.f : 0.f); }
            cst4(CB(8), nn, mm, a1); cst4(CB(9), nn, mm, a2); cst4(CB(10), nn, mm, t0); cst4(CB(11), nn, mm, a3); cst4(CB(12), nn, mm, a4); cst4(CB(13), nn, mm, a5); }
        __syncthreads();
#pragma unroll
        for (int tl = 0; tl < 2; ++tl) { const int m0t = mA + 16 * tl, mm = m0t + mq;
            cst4(CB(0), nn, mm, cmm(CB(9), CB(8), m0t, n0, lane, z4)); cst4(CB(1), nn, mm, cmm(CB(8), CB(9), m0t, n0, lane, z4)); cst4(CB(2), nn, mm, cmm(CB(11), CB(7), m0t, n0, lane, z4)); }
        __syncthreads();
#define CSTEP(MP, MPT, MPN, MPTN, TI, TO, DO_MP, DO_MPT) do { _Pragma("unroll") for (int tl = 0; tl < 2; ++tl) { const int m0t = mA + 16 * tl, mm = m0t + mq; \
            if (DO_MP) cst4(CB(MPN), nn, mm, cmm(CB(MPT), CB(MP), m0t, n0, lane, z4)); if (DO_MPT) cst4(CB(MPTN), nn, mm, cmm(CB(MP), CB(MPT), m0t, n0, lane, z4)); \
            cst4(CB(TO), nn, mm, cmm(CB(MPT), CB(TI), m0t, n0, lane, cld4(CB(TI), nn, mm))); } __syncthreads(); } while (0)
        CSTEP(0, 1, 8, 9, 10, 11, true, true);
        CSTEP(8, 9, 0, 1, 11, 10, true, true);
        CSTEP(0, 1, 8, 9, 10, 11, true, true);
        CSTEP(8, 9, 0, 1, 11, 10, false, true);
        CSTEP(0, 1, 8, 9, 10, 11, false, false);
#undef CSTEP
#pragma unroll
        for (int tl = 0; tl < 2; ++tl) { const int m0t = mA + 16 * tl, mm = m0t + mq;
            cst4(CB(8), nn, mm, cmm(CB(11), CB(4), m0t, n0, lane, z4)); cst4(CB(9), nn, mm, cmm(CB(11), CB(2), m0t, n0, lane, z4)); }
        __syncthreads();
#pragma unroll
        for (int tl = 0; tl < 2; ++tl) { const int m0t = mA + 16 * tl, mm = m0t + mq;
            { const f32x4 q = cmm(CB(8), CB(12), m0t, n0, lane, cld4(CB(3), nn, mm)); v2u o; o.x = pk2(q[0], q[1]); o.y = pk2(q[2], q[3]); *(v2u*)(CQ + ((size_t)pair * 64 + nn) * 64 + mm) = o; }
            { const f32x4 y = cmm(CB(7), CB(13), m0t, n0, lane, cmm(CB(9), CB(12), m0t, n0, lane, z4)); *(f32x4*)(YS + (m0 + nn) * RW + h * RH + mm) = y; }
            { f32x4 g = cmm(CB(8), CB(5), m0t, n0, lane, z4);
#pragma unroll
              for (int i = 0; i < 4; ++i) g[i] += (mm + i == nn) ? pcs[nn] : 0.f;
              v2u o; o.x = pk2(g[0], g[1]); o.y = pk2(g[2], g[3]); *(v2u*)(CG + ((size_t)pair * 64 + nn) * 64 + mm) = o; }
            { const f32x4 hh = cmm(CB(7), CB(6), m0t, n0, lane, cmm(CB(9), CB(5), m0t, n0, lane, z4)); *(f32x4*)(CH + ((size_t)pair * 64 + nn) * 64 + mm) = hh; }
        }
        __syncthreads();
    }
#undef CB
#undef CP_LOAD
}
typedef float f32x16 __attribute__((ext_vector_type(16)));
__device__ __forceinline__ bf16x8 pack_frag(const f32x16& x, int s) {
    v4u w; w.x = pk2(x[8 * s + 0], x[8 * s + 1]); w.y = pk2(x[8 * s + 2], x[8 * s + 3]); w.z = pk2(x[8 * s + 4], x[8 * s + 5]); w.w = pk2(x[8 * s + 6], x[8 * s + 7]);
    return __builtin_bit_cast(bf16x8, w);
}
__device__ __forceinline__ bf16x8 ld_afrag(const bf16* rowp, int kbase, int hh) {
    const v2u lo = *(const v2u*)(rowp + kbase + 4 * hh), hi = *(const v2u*)(rowp + kbase + 8 + 4 * hh); v4u w; w.x = lo.x; w.y = lo.y; w.z = hi.x; w.w = hi.y; return __builtin_bit_cast(bf16x8, w);
}
__device__ __forceinline__ bf16x8 ld_afrag_lds(const LAS unsigned char* img, int row, int kbase, int hh) {
    const int k0 = kbase + 4 * hh, k1 = k0 + 8;
    const v2u lo = *(const LAS v2u*)(img + row * 128 + (((k0 >> 3) ^ (row & 7)) << 4) + ((k0 & 7) << 1));
    const v2u hi = *(const LAS v2u*)(img + row * 128 + (((k1 >> 3) ^ (row & 7)) << 4) + ((k1 & 7) << 1));
    v4u w; w.x = lo.x; w.y = lo.y; w.z = hi.x; w.w = hi.y; return __builtin_bit_cast(bf16x8, w);
}
__device__ __forceinline__ void phase_chunkscan(Frame& F) {
    float* YS = (float*)(F.ws + WS_YS); const bf16* CQ = (const bf16*)(F.ws + WS_CQ); const bf16* CG = (const bf16*)(F.ws + WS_CG); const float* CH = (const float*)(F.ws + WS_CH);
    const int lane = F.lane, r32 = lane & 31, hh = lane >> 5;
    const int per = (F.G >= 128) ? 1 : 2;
    LAS unsigned char* ring = F.lds + F.wave * 65536;
    const int drow = lane >> 3, dch = lane & 7, dsw = dch ^ drow;
    if (F.wave < per)
    for (int item = F.bid * per + F.wave; item < NB * NH * 2; item += F.G * per) {
        const int bh = item >> 1, vh = item & 1, b = bh >> 3, h = bh & 7; const size_t m0 = (size_t)b * SEQ;
#define CS_ISSUE(C, BUF) do { const size_t pr_ = (size_t)bh * 32 + (C); LAS unsigned char* d_ = ring + (BUF) * 32768; \
        const char* gq_ = (const char*)(CQ + pr_ * 4096) + drow * 128 + dsw * 16; const char* gg_ = (const char*)(CG + pr_ * 4096) + drow * 128 + dsw * 16; \
        const char* gh_ = (const char*)(CH + pr_ * 4096 + 32 * vh) + drow * 256 + dch * 16; const char* gy_ = (const char*)(YS + (m0 + (C) * 64) * RW + h * RH + 32 * vh) + (size_t)drow * (RW * 4) + dch * 16; \
        _Pragma("unroll") for (int i_ = 0; i_ < 8; ++i_) { \
            __builtin_amdgcn_global_load_lds((const unsigned*)(gq_ + i_ * 1024), (LAS unsigned*)(d_ + i_ * 1024), 16, 0, 0); \
            __builtin_amdgcn_global_load_lds((const unsigned*)(gg_ + i_ * 1024), (LAS unsigned*)(d_ + 8192 + i_ * 1024), 16, 0, 0); \
            __builtin_amdgcn_global_load_lds((const unsigned*)(gh_ + i_ * 2048), (LAS unsigned*)(d_ + 16384 + i_ * 1024), 16, 0, 0); \
            __builtin_amdgcn_global_load_lds((const unsigned*)(gy_ + (size_t)i_ * (8 * RW * 4)), (LAS unsigned*)(d_ + 24576 + i_ * 1024), 16, 0, 0); } } while (0)
        f32x16 X[2], Yh[2];
#pragma unroll
        for (int i = 0; i < 16; ++i) { X[0][i] = 0.f; X[1][i] = 0.f; Yh[0][i] = 0.f; Yh[1][i] = 0.f; }
        CS_ISSUE(0, 0);
        for (int c = 0; c < SEQ / 64; ++c) {
            asm volatile("s_waitcnt vmcnt(0)" ::: "memory"); __builtin_amdgcn_sched_barrier(0);
            if (c + 1 < SEQ / 64) CS_ISSUE(c + 1, (c + 1) & 1);
            if (c > 0) {
#pragma unroll
                for (int tt = 0; tt < 2; ++tt)
#pragma unroll
                    for (int i = 0; i < 16; ++i) { const int row = 32 * tt + (i & 3) + 8 * (i >> 2) + 4 * hh; YS[(m0 + (c - 1) * 64 + row) * RW + h * RH + 32 * vh + r32] = Yh[tt][i]; } }
            const LAS unsigned char* d = ring + (c & 1) * 32768;
            bf16x8 xb[2][2];
#pragma unroll
            for (int kt = 0; kt < 2; ++kt)
#pragma unroll
                for (int s2 = 0; s2 < 2; ++s2) xb[kt][s2] = pack_frag(X[kt], s2);
#pragma unroll
            for (int tt = 0; tt < 2; ++tt) {
                f32x16 Yt;
#pragma unroll
                for (int i = 0; i < 16; ++i) { const int row = 32 * tt + (i & 3) + 8 * (i >> 2) + 4 * hh; Yt[i] = *(const LAS float*)(d + 24576 + row * 128 + r32 * 4); }
#pragma unroll
                for (int kt = 0; kt < 2; ++kt)
#pragma unroll
                    for (int s2 = 0; s2 < 2; ++s2) Yt = __builtin_amdgcn_mfma_f32_32x32x16_bf16(ld_afrag_lds(d, 32 * tt + r32, 32 * kt + 16 * s2, hh), xb[kt][s2], Yt, 0, 0, 0);
                Yh[tt] = Yt;
            }
            f32x16 Xn[2];
#pragma unroll
            for (int tt = 0; tt < 2; ++tt) {
#pragma unroll
                for (int i = 0; i < 16; ++i) { const int row = 32 * tt + (i & 3) + 8 * (i >> 2) + 4 * hh; Xn[tt][i] = *(const LAS float*)(d + 16384 + row * 128 + r32 * 4); }
#pragma unroll
                for (int kt = 0; kt < 2; ++kt)
#pragma unroll
                    for (int s2 = 0; s2 < 2; ++s2) Xn[tt] = __builtin_amdgcn_mfma_f32_32x32x16_bf16(ld_afrag_lds(d + 8192, 32 * tt + r32, 32 * kt + 16 * s2, hh), xb[kt][s2], Xn[tt], 0, 0, 0);
            }
            X[0] = Xn[0]; X[1] = Xn[1];
        }
#pragma unroll
        for (int tt = 0; tt < 2; ++tt)
#pragma unroll
            for (int i = 0; i < 16; ++i) { const int row = 32 * tt + (i & 3) + 8 * (i >> 2) + 4 * hh; YS[(m0 + (SEQ / 64 - 1) * 64 + row) * RW + h * RH + 32 * vh + r32] = Yh[tt][i]; }
#undef CS_ISSUE
    }
}
__device__ __forceinline__ void phase_post(Frame& F, int l, int gw, int NGW) {
    const float* YS = (const float*)(F.ws + WS_YS); const bf16* SV = (const bf16*)(F.ws + WS_SV); const bf16* LOUT = (const bf16*)(F.ws + WS_LOUT); const float* BONUS = (const float*)(F.ws + WS_BONUS);
    bf16* YG = (bf16*)(F.ws + WS_YG);
    const int c = 8 * F.lane; float gg[8], gb[8]; ld8f(F.in[I_GNG] + l * RW + c, gg); ld8f(F.in[I_GNB] + l * RW + c, gb);
    for (int m = gw; m < M; m += NGW) {
        float y[8], v[8], g[8]; ld8f(YS + (size_t)m * RW + c, y); ld8bf(SV + (size_t)m * RW + c, v); ld8bf(LOUT + (size_t)m * NLORA + 1024 + c, g);
        float s = 0.f;
#pragma unroll
        for (int i = 0; i < 8; ++i) s += y[i];
        const float mean = grp8_sum(s) * (1.0f / RH); float s2 = 0.f;
#pragma unroll
        for (int i = 0; i < 8; ++i) { y[i] -= mean; s2 += y[i] * y[i]; }
        const float rstd = rsqrtf(grp8_sum(s2) * (1.0f / RH) + GN_EPS); const float bo = BONUS[(size_t)m * NH + (F.lane >> 3)];
        float o[8];
#pragma unroll
        for (int i = 0; i < 8; ++i) o[i] = (y[i] * rstd * gg[i] + gb[i] + bo * v[i]) * g[i];
        st8bf(YG + (size_t)m * D + RW + c, o);
    }
}

__device__ __forceinline__ unsigned* cnt_word(const Frame& F, int l, int e) { return (unsigned*)(F.ws + WS_CTL) + CW_CNT + (l * NE + e) * 64; }
constexpr int HT_STRIDE = 1032;
__device__ __forceinline__ void phase_rowB(Frame& F, int l, const bool dummy) {
    const bf16* Y = (const bf16*)(F.ws + WS_Y); bf16* H = (bf16*)(F.ws + (dummy ? WS_YEXP + 64 * MiB : WS_H));
    int* LIST = (int*)(F.ws + (dummy ? WS_YEXP + 96 * MiB : WS_LIST)); float* GW = (float*)(F.ws + (dummy ? WS_YEXP + 104 * MiB : WS_GW)); int* TOKA = (int*)(F.ws + (dummy ? WS_YEXP + 112 * MiB : WS_TOKA));
    float* xout = dummy ? (float*)(F.ws + WS_YEXP) : F.out; const int lc = dummy ? l + 2 : l;
    const float* xsrc = (l == 0) ? F.in[I_X] : F.out;
    LAS bf16* hhi = (LAS bf16*)F.lds; LAS bf16* hlo = hhi + 16 * HT_STRIDE;
    LAS float* part = (LAS float*)(F.lds + 2 * 16 * HT_STRIDE * 2);
    LAS float* logit = part + 8 * 16 * 64;
    LAS int* cntl = (LAS int*)(logit + 1024 + 8 * 80);
    LAS int* asg = cntl + 128;
    if (F.tid < 128) cntl[F.tid] = 0;
    __syncthreads();
    int it = 0;
    const int lane = F.lane, w = F.wave, g4 = lane >> 4, j16 = lane & 15;
    const bf16* wrh = (const bf16*)(F.ws + WS_WMIX + (size_t)l * WMIX_STRIDE + WM_RHI); const bf16* wrl = (const bf16*)(F.ws + WS_WMIX + (size_t)l * WMIX_STRIDE + WM_RLO); const float br = F.in[I_BROUTER][l * NE + lane];
    v2u yq[2][4]; Row xq[2];
    if (F.bid < M / 16) {
#pragma unroll
        for (int rr = 0; rr < 2; ++rr) { const int m = F.bid * 16 + 2 * w + rr;
#pragma unroll
            for (int j = 0; j < 4; ++j) yq[rr][j] = *((const v2u*)(Y + (size_t)m * D) + lane + 64 * j);
            xq[rr] = row_load(xsrc + (size_t)m * D, lane); } }
    for (int tile = F.bid; tile < M / 16; tile += F.G, ++it) {
#pragma unroll
        for (int rr = 0; rr < 2; ++rr) {
            const int r = 2 * w + rr, m = tile * 16 + r, b = m / SEQ;
            Row y, x = xq[rr], gp = row_load(F.in[I_NMPOST] + l * D, lane), gt = row_load(mod_ptr(F, l, b, 2), lane);
#pragma unroll
            for (int j = 0; j < 4; ++j) y.v[j] = (f32x4){bflo(yq[rr][j].x), bfhi(yq[rr][j].x), bflo(yq[rr][j].y), bfhi(yq[rr][j].y)};
            const float rs = rsqrtf(row_sumsq(y) * (1.0f / D) + RMS_EPS);
#pragma unroll
            for (int j = 0; j < 4; ++j) x.v[j] = x.v[j] + gt.v[j] * (y.v[j] * rs * gp.v[j]);
            row_store(xout + (size_t)m * D, lane, x);
            Row h = row_modnorm(x, F.in[I_NFPRE] + l * D, mod_ptr(F, l, b, 4), mod_ptr(F, l, b, 3), lane);
            row_store_bf16(H + (size_t)m * D, lane, h);
#pragma unroll
            for (int j = 0; j < 4; ++j) { const unsigned p0 = pk2(h.v[j][0], h.v[j][1]), p1 = pk2(h.v[j][2], h.v[j][3]); v2u hi2; hi2.x = p0; hi2.y = p1;
                v2u lo2; lo2.x = pk2(h.v[j][0] - bflo(p0), h.v[j][1] - bfhi(p0)); lo2.y = pk2(h.v[j][2] - bflo(p1), h.v[j][3] - bfhi(p1));
                *((LAS v2u*)(hhi + r * HT_STRIDE) + lane + 64 * j) = hi2; *((LAS v2u*)(hlo + r * HT_STRIDE) + lane + 64 * j) = lo2; }
        }
        if (tile + F.G < M / 16) {
#pragma unroll
            for (int rr = 0; rr < 2; ++rr) { const int m = (tile + F.G) * 16 + 2 * w + rr;
#pragma unroll
                for (int j = 0; j < 4; ++j) yq[rr][j] = *((const v2u*)(Y + (size_t)m * D) + lane + 64 * j);
                xq[rr] = row_load(xsrc + (size_t)m * D, lane); } }
        __syncthreads();
        if (dummy && MK_RB_LEVEL < 2) continue;
#pragma unroll 1
        for (int et = 0; et < 4; ++et) {
            asm volatile("" : "+s"(wrh), "+s"(wrl));
            f32x4 acc = (f32x4){0.f, 0.f, 0.f, 0.f};
#pragma unroll
            for (int ks = 0; ks < 4; ++ks) { const int ko = 128 * w + 32 * ks + 8 * g4;
                const bf16x8 ah = *(const LAS bf16x8*)(hhi + j16 * HT_STRIDE + ko), al = *(const LAS bf16x8*)(hlo + j16 * HT_STRIDE + ko);
                const bf16x8 bh = *(const bf16x8*)(wrh + (size_t)(16 * et + j16) * D + ko), bl = *(const bf16x8*)(wrl + (size_t)(16 * et + j16) * D + ko);
                acc = __builtin_amdgcn_mfma_f32_16x16x32_bf16(ah, bh, acc, 0, 0, 0); acc = __builtin_amdgcn_mfma_f32_16x16x32_bf16(ah, bl, acc, 0, 0, 0); acc = __builtin_amdgcn_mfma_f32_16x16x32_bf16(al, bh, acc, 0, 0, 0); }
#pragma unroll
            for (int i = 0; i < 4; ++i) part[(w * 16 + 4 * g4 + i) * 64 + 16 * et + j16] = acc[i];
        }
        __syncthreads();
#pragma unroll
        for (int o = 0; o < 2; ++o) { const int idx = F.tid + 512 * o; float sum = 0.f;
#pragma unroll
            for (int ww = 0; ww < 8; ++ww) sum += part[ww * 1024 + idx];
            logit[idx] = sum; }
        __syncthreads();
        if (dummy && MK_RB_LEVEL < 3) continue;
#pragma unroll 1
        for (int rr = 0; rr < 2; ++rr) {
            const int r = 2 * w + rr, m = tile * 16 + r;
            const float score = sigmoidf_(logit[r * 64 + lane]), biased = score + br;
            LAS float* wb = logit + 1024 + w * 80;
            wb[lane] = biased; LDS_WAIT();
            const int g = lane >> 3;
            float gs;
            { const f32x4 ga = *(const LAS f32x4*)(wb + 8 * g), gb = *(const LAS f32x4*)(wb + 8 * g + 4); float m1 = ga[0], m2 = -__builtin_inff();
#define T2(v) do { const float v_ = (v); if (v_ > m1) { m2 = m1; m1 = v_; } else if (v_ > m2) m2 = v_; } while (0)
              T2(ga[1]); T2(ga[2]); T2(ga[3]); T2(gb[0]); T2(gb[1]); T2(gb[2]); T2(gb[3]);
#undef T2
              gs = m1 + m2; }
            if ((lane & 7) == 0) wb[64 + g] = gs;
            LDS_WAIT();
            int grk = 0;
            { const f32x4 s0 = *(const LAS f32x4*)(wb + 64), s1 = *(const LAS f32x4*)(wb + 68);
#pragma unroll
              for (int q = 0; q < 8; ++q) { const float o = (q < 4) ? s0[q & 3] : s1[q & 3]; grk += (o > gs || (o == gs && q < g)) ? 1 : 0; } }
            const float masked = (grk < 4) ? biased : -__builtin_inff();
            wb[lane] = masked; LDS_WAIT();
            int rank = 0;
#pragma unroll
            for (int q = 0; q < 16; ++q) { const f32x4 o = *(const LAS f32x4*)(wb + 4 * q);
#pragma unroll
                for (int i = 0; i < 4; ++i) rank += (o[i] > masked || (o[i] == masked && (4 * q + i) < lane)) ? 1 : 0; }
            LDS_WAIT();
            const bool chosen = rank < TOPK;
            const float ssum = wave_sum(chosen ? score : 0.f);
            if (chosen) { const int lp = __hip_atomic_fetch_add((LAS int*)cntl + lane, 1, __ATOMIC_RELAXED, __HIP_MEMORY_SCOPE_WORKGROUP);
                LAS int* q = asg + ((it * 16 + r) * TOPK + rank) * 2; q[0] = lane * 65536 + lp; q[1] = __builtin_bit_cast(int, score / ssum * ROUTED_SCALE); }
            if (lane == 0) LIST[(size_t)NE * M + m] = m;
        }
    }
    if (dummy && MK_RB_LEVEL < 3) return;
    __syncthreads();
    if (F.tid < NE) cntl[NE + F.tid] = (int)__hip_atomic_fetch_add(cnt_word(F, lc, F.tid), (unsigned)cntl[F.tid], RLX_AGENT);
    __syncthreads();
    for (int idx = F.tid; idx < it * 16 * TOPK; idx += NTHREADS) {
        const int itl = idx / (16 * TOPK), r = (idx / TOPK) % 16, m = (F.bid + itl * F.G) * 16 + r; const int ep = asg[idx * 2], e = ep >> 16, pos = cntl[NE + e] + (ep & 65535);
        LIST[(size_t)e * M + pos] = m; TOKA[((size_t)m * TOPK + (idx % TOPK)) * 2] = e * 65536 + pos; TOKA[((size_t)m * TOPK + (idx % TOPK)) * 2 + 1] = asg[idx * 2 + 1]; }
}

struct MoeTab { LAS int* cnt; LAS int* start; LAS int* tstart; LAS int* ntiles; LAS int* tiles; };
__device__ __forceinline__ MoeTab moe_tab(const Frame& F) { MoeTab T; LAS int* p = (LAS int*)(F.lds + LDS_TAB_OFF); T.cnt = p; T.start = p + 80; T.tstart = p + 160; T.ntiles = p + 240; T.tiles = p + 256; return T; }
__device__ __forceinline__ void moe_build(Frame& F, int l, bool with_tiles) {
    MoeTab T = moe_tab(F);
    __syncthreads();
    if (F.tid <= NE) T.cnt[F.tid] = (F.tid < NE) ? (int)__hip_atomic_load(cnt_word(F, l, F.tid), RLX_AGENT) : M;
    __syncthreads();
    if (F.tid <= NE) { int s = 0, ts = 0; for (int e = 0; e < F.tid; ++e) { const int c = T.cnt[e]; s += c; ts += (c + 255) >> 8; } T.start[F.tid] = s; T.tstart[F.tid] = ts;
        if (F.tid == NE) T.ntiles[0] = ts + ((M + 255) >> 8);
        if (with_tiles) { const int c = T.cnt[F.tid]; const int nt = (c + 255) >> 8;
            for (int rt = 0; rt < nt; ++rt) { LAS int* q = T.tiles + (ts + rt) * 4; q[0] = F.tid; q[1] = rt * 256; q[2] = s + rt * 256; q[3] = (c - rt * 256) < 256 ? (c - rt * 256) : 256; } } }
    __syncthreads();
}
struct MoeOrder {
    LAS const int* tiles; int ntiles, npn, nwg, G, c, bstride;
    __device__ bool next(int i, pg8::Unit& u) const {
        const long L = (long)i * G + c; if (L >= nwg) return false;
        int wgid = (int)L; { const int q = nwg / 8, r = nwg % 8, xcd = wgid % 8, off = wgid / 8; wgid = (xcd < r ? xcd * (q + 1) : r * (q + 1) + (xcd - r) * q) + off; }
        const int tile = wgid / npn, pn = wgid % npn; LAS const int* q = tiles + tile * 4;
        const int q0 = __builtin_amdgcn_readfirstlane(q[0]), q1 = __builtin_amdgcn_readfirstlane(q[1]), q2 = __builtin_amdgcn_readfirstlane(q[2]), q3 = __builtin_amdgcn_readfirstlane(q[3]);
        u.e = q0; u.x0 = q0 * M + q1; u.o0 = q2; u.nrows = q3; u.b0 = q0 * bstride + pn * 256; u.oc0 = pn * 256; u.a0 = q2; return true;
    }
};
__device__ __forceinline__ Row row_load_fp8(const unsigned char* p, int lane) { Row r; const unsigned* q = (const unsigned*)p + lane;
#pragma unroll
    for (int j = 0; j < 4; ++j) { const int w = (int)q[64 * j]; const f32x2 lo = __builtin_amdgcn_cvt_pk_f32_fp8(w, false), hi = __builtin_amdgcn_cvt_pk_f32_fp8(w, true); r.v[j] = (f32x4){lo.x, lo.y, hi.x, hi.y}; } return r; }
__device__ __forceinline__ void phase_rowC(Frame& F, int l, int gw, int NGW, const bool dummy) {
    const unsigned char* YEXP = (const unsigned char*)(F.ws + WS_YEXP); const unsigned char* YSH = YEXP + (size_t)M * TOPK * D; const int* TOKA = (const int*)(F.ws + WS_TOKA); bf16* H = (bf16*)(F.ws + (dummy ? WS_S : WS_H));
    float* xout = dummy ? (float*)(F.ws + WS_S) : F.out;
    MoeTab T = moe_tab(F);
    for (int m = gw; m < M; m += NGW) {
        const int b = m / SEQ;
        Row y = row_load_fp8(YSH + (size_t)m * D, F.lane);
#pragma unroll
        for (int j8 = 0; j8 < TOPK; ++j8) { const int ep = TOKA[((size_t)m * TOPK + j8) * 2]; const float gt_ = __builtin_bit_cast(float, TOKA[((size_t)m * TOPK + j8) * 2 + 1]);
            const int slot = T.start[ep >> 16] + (ep & 65535); const Row t = row_load_fp8(YEXP + (size_t)slot * D, F.lane);
#pragma unroll
            for (int j = 0; j < 4; ++j) y.v[j] += gt_ * t.v[j]; }
        Row x = row_load(F.out + (size_t)m * D, F.lane), gp = row_load(F.in[I_NFPOST] + l * D, F.lane), gt = row_load(mod_ptr(F, l, b, 5), F.lane);
        const float rs = rsqrtf(row_sumsq(y) * (1.0f / D) + RMS_EPS);
#pragma unroll
        for (int j = 0; j < 4; ++j) x.v[j] = x.v[j] + gt.v[j] * (y.v[j] * rs * gp.v[j]);
        row_store(xout + (size_t)m * D, F.lane, x);
        if (l + 1 < DEPTH) { Row h = row_modnorm(x, F.in[I_NMPRE] + (l + 1) * D, mod_ptr(F, l + 1, b, 1), mod_ptr(F, l + 1, b, 0), F.lane); row_store_bf16(H + (size_t)m * D, F.lane, h); }
    }
}

__device__ __forceinline__ void phase_begin(Frame& F) { asm volatile("" : "+s"(F.in), "+s"(F.ws), "+s"(F.out), "+s"(F.bid), "+s"(F.G), "+s"(F.wave));
    F.lane = (int)__builtin_amdgcn_mbcnt_hi(~0u, __builtin_amdgcn_mbcnt_lo(~0u, 0u)); asm volatile("" : "+v"(F.lane)); F.tid = F.wave * 64 + F.lane; }
constexpr int PH_PER_LAYER = 13, NPH = 2 + DEPTH * PH_PER_LAYER;
__device__ __forceinline__ void bar_launder(XcdBarrier& bar) { asm volatile("" : "+s"(bar.bar)); }
#define TBIT(k) ((k) == 0 ? 13 : (k) == 1 ? 14 : ((k) - 2) % PH_PER_LAYER)
#define IN(k) (phase_begin(F), bar_launder(bar), t_ph = (((MK_TIME_MASK >> TBIT(k)) & 1) ? __builtin_amdgcn_s_memrealtime() : 0ull), (lo <= (k) && (k) < hi))
#define SEAM(k) do { if (!MK_PER_PHASE && (k) + 1 < hi) { xcd_barrier(bar, F.tid); if ((MK_TIME_MASK >> TBIT(k)) & 1) t_acc += __builtin_amdgcn_s_memrealtime() - t_ph; if (MK_REPEAT == -3) { bar_launder(bar); xcd_barrier(bar, F.tid); } } } while (0)
template <int L> __device__ __forceinline__ void layer_phases(Frame& F, XcdBarrier& bar, const int lo, const int hi, unsigned long long& t_acc) {
    constexpr int l = L, p0 = 2 + L * PH_PER_LAYER; unsigned long long t_ph = 0;
#define GW_ const int gw = F.bid * NWAVES + F.wave, NGW = F.G * NWAVES
#define WM_ unsigned char* wm = F.ws + WS_WMIX + (size_t)l * WMIX_STRIDE
    if (IN(p0 + 0)) { for (int rep_ = 0; rep_ < ((MK_REPEAT == 0) ? 2 : 1); ++rep_) { phase_begin(F); bar_launder(bar); WM_;
        pg8::Gemm g{(const bf16*)(F.ws + WS_H), (const bf16*)(wm + WM_WIN), D, nullptr}; pg8::StaticOrder S; S.init(M, DIN, F.G, F.bid);
        pg8::EpiZ E{(bf16*)(F.ws + WS_ZC)}; pg8::gemm_phase<pg8::EpiZ, pg8::StaticOrder, false>(F.lds, F.tid, g, S, E); } SEAM(p0 + 0); }
    if (IN(p0 + 1)) { for (int rep_ = 0; rep_ < ((MK_REPEAT == 1) ? 2 : 1); ++rep_) { phase_begin(F); bar_launder(bar); GW_; phase_conv(F, l); if (MK_REPEAT == 101) phase_conv(F, l); phase_prep1(F, l, gw, NGW); if (MK_REPEAT == 102) phase_prep1(F, l, gw, NGW); } SEAM(p0 + 1); }
    if (IN(p0 + 2)) { for (int rep_ = 0; rep_ < ((MK_REPEAT == 2) ? 2 : 1); ++rep_) { phase_begin(F); bar_launder(bar); WM_; pg8::Gemm g{(const bf16*)(F.ws + WS_LIN), (const bf16*)(wm + WM_LORA), KLORA, nullptr}; pg8::StaticOrder S; S.init(M, NLORA, F.G, F.bid);
        pg8::EpiBf16 E{(bf16*)(F.ws + WS_LOUT), NLORA}; pg8::gemm_phase<pg8::EpiBf16, pg8::StaticOrder, false>(F.lds, F.tid, g, S, E); } SEAM(p0 + 2); }
    if (IN(p0 + 4)) { for (int rep_ = 0; rep_ < ((MK_REPEAT == 4) ? 2 : 1); ++rep_) { phase_begin(F); bar_launder(bar); phase_chunkprep(F, l); } SEAM(p0 + 4); }
    if (IN(p0 + 5)) { for (int rep_ = 0; rep_ < ((MK_REPEAT == 5) ? 2 : 1); ++rep_) { phase_begin(F); bar_launder(bar); const int per = (F.G >= 128) ? 1 : 2;
        const int nscan = 128 / per;
        if (F.bid < nscan || F.G <= nscan) { if (F.wave < per) { if (rep_ == 0) phase_chunkscan(F); } else if (F.G <= nscan) phase_expert_weights(F, l, F.bid * (NWAVES - per) + F.wave - per, F.G * (NWAVES - per)); }
        else phase_expert_weights(F, l, (F.bid - nscan) * NWAVES + F.wave, (F.G - nscan) * NWAVES); } SEAM(p0 + 5); }
    if (IN(p0 + 6)) { for (int rep_ = 0; rep_ < ((MK_REPEAT == 6) ? 2 : 1); ++rep_) { phase_begin(F); bar_launder(bar); GW_; phase_post(F, l, gw, NGW); } SEAM(p0 + 6); }
    if (IN(p0 + 7)) { for (int rep_ = 0; rep_ < ((MK_REPEAT == 7) ? 2 : 1); ++rep_) { phase_begin(F); bar_launder(bar); WM_; pg8::StaticOrder S; S.init(M, D, F.G, F.bid);
        pg8::Gemm g{(const bf16*)(F.ws + WS_UC), (const bf16*)(wm + WM_PCONV), D, nullptr}; pg8::EpiMerge2 E{(bf16*)(F.ws + WS_MERGED), (const bf16*)(F.ws + WS_ZG)};
        pg8::gemm_phase<pg8::EpiMerge2, pg8::StaticOrder, false>(F.lds, F.tid, g, S, E); } SEAM(p0 + 7); }
    if (IN(p0 + 8)) { for (int rep_ = 0; rep_ < ((MK_REPEAT == 8) ? 2 : 1); ++rep_) { phase_begin(F); bar_launder(bar); WM_; pg8::Gemm g{(const bf16*)(F.ws + WS_MERGED), (const bf16*)(wm + WM_WO), D, nullptr}; pg8::StaticOrder S; S.init(M, D, F.G, F.bid);
        pg8::EpiBf16 E{(bf16*)(F.ws + WS_Y), D}; pg8::gemm_phase<pg8::EpiBf16, pg8::StaticOrder, false>(F.lds, F.tid, g, S, E); } SEAM(p0 + 8); }
    if (IN(p0 + 9)) { for (int rep_ = 0; rep_ < ((MK_REPEAT == 9) ? 2 : 1); ++rep_) { phase_begin(F); bar_launder(bar); phase_rowB(F, l, (MK_REPEAT == 9) && rep_ == 0); } SEAM(p0 + 9); }
    if (IN(p0 + 10)) { for (int rep_ = 0; rep_ < ((MK_REPEAT == 10) ? 2 : 1); ++rep_) { phase_begin(F); bar_launder(bar); moe_build(F, l, true); MoeTab T = moe_tab(F);
        const int ntl = __builtin_amdgcn_readfirstlane(T.ntiles[0]); MoeOrder S{T.tiles, ntl, 2, ntl * 2, F.G, F.bid, 512};
        pg8::Gemm g{(const bf16*)(F.ws + WS_H), (const bf16*)(F.ws + WS_WGU), D, (const int*)(F.ws + WS_LIST)};
        pg8::EpiSwiGLU E{(bf16*)(F.ws + WS_ACT)}; pg8::gemm_phase<pg8::EpiSwiGLU, MoeOrder, true>(F.lds, F.tid, g, S, E); } SEAM(p0 + 10); }
    if (IN(p0 + 11)) { for (int rep_ = 0; rep_ < ((MK_REPEAT == 11) ? 2 : 1); ++rep_) { phase_begin(F); bar_launder(bar); moe_build(F, l, true); MoeTab T = moe_tab(F);
        const int ntl = __builtin_amdgcn_readfirstlane(T.ntiles[0]); MoeOrder S{T.tiles, ntl, 4, ntl * 4, F.G, F.bid, 1024};
        pg8::Gemm g{(const bf16*)(F.ws + WS_ACT), (const bf16*)(F.ws + WS_WDN), DE, nullptr};
        pg8::EpiFp8 E{(unsigned char*)(F.ws + WS_YEXP), D}; pg8::gemm_phase<pg8::EpiFp8, MoeOrder, false>(F.lds, F.tid, g, S, E); } SEAM(p0 + 11); }
    if (IN(p0 + 12)) { for (int rep_ = 0; rep_ < ((MK_REPEAT == 12) ? 2 : 1); ++rep_) { phase_begin(F); bar_launder(bar); GW_; moe_build(F, l, false); phase_rowC(F, l, gw, NGW, (MK_REPEAT == 12) && rep_ == 0); } SEAM(p0 + 12); }
}
__global__ void __launch_bounds__(NTHREADS, 2) mk_fwd(Args args) {
    extern __shared__ __attribute__((aligned(16))) unsigned char lds_raw[];
    Frame F; F.lds = (LAS unsigned char*)lds_raw; F.tid = threadIdx.x; F.lane = F.tid & 63; F.wave = __builtin_amdgcn_readfirstlane(F.tid >> 6);
    F.G = gridDim.x; F.bid = blockIdx.x; F.in = (const float* const __attribute__((address_space(4)))*)__builtin_amdgcn_kernarg_segment_ptr(); F.out = args.out; F.ws = args.ws;
    volatile LAS unsigned* MISC = (volatile LAS unsigned*)(F.lds + MISC_OFF);
    if (F.tid < 64) MISC[F.tid] = 0u;
    __syncthreads();
    XcdBarrier bar; bar.bar = (unsigned*)(F.ws + WS_CTL) + CW_BAR; bar.x = 0; bar.st = nullptr;
    if (!MK_PER_PHASE) bar = xcd_barrier_post((unsigned*)(F.ws + WS_CTL) + CW_BAR, MISC + 8);
    const int lo = args.ph_lo, hi = (args.ph_hi < MK_LAST_PHASE + 1) ? args.ph_hi : MK_LAST_PHASE + 1;
    unsigned long long t_acc = 0, t_ph = 0;
    if (IN(0)) { for (int rep_ = 0; rep_ < ((MK_REPEAT == -2) ? 2 : 1); ++rep_) { phase_begin(F); bar_launder(bar); GW_; phase_ada(F); phase_mix_weights(F, gw, NGW); } SEAM(0); }
    if (IN(1)) { GW_; phase_rowA(F, gw, NGW); SEAM(1); }
    layer_phases<0>(F, bar, lo, hi, t_acc);
    layer_phases<1>(F, bar, lo, hi, t_acc);
    if (MK_TIME_MASK != 0 && F.bid == 0) { const unsigned long long te = __builtin_amdgcn_s_memrealtime() + t_acc; while (__builtin_amdgcn_s_memrealtime() < te) __builtin_amdgcn_s_sleep(8); }
    if (MK_LAST_PHASE < 2 + 9 && args.ph_hi == NPH) { phase_begin(F); for (size_t i = (size_t)F.bid * NTHREADS + F.tid; i < (size_t)M * D / 4; i += (size_t)F.G * NTHREADS) ((f32x4*)F.out)[i] = ((const f32x4*)F.in[I_X])[i]; }
}
#undef IN
#undef SEAM
#undef GW_
#undef WM_

extern "C" void kernel_launch(void* const* d_in, const int* in_sizes, int n_in, void* d_out, int out_size, void* d_ws, size_t ws_size, hipStream_t stream) {
    static int grid = 0;
    if (grid == 0) {
        if (n_in != N_IN || out_size != M * D) { fprintf(stderr, "kernel_launch: unexpected shapes (n_in %d out %d ws %zu need %zu)\n", n_in, out_size, ws_size, (size_t)WS_END); grid = -1; return; }
        if (ws_size < WS_END) { fprintf(stderr, "kernel_launch: ws too small %zu < %zu\n", ws_size, (size_t)WS_END); grid = -2; }
        int dev = 0, cus = 0;
        if (hipGetDevice(&dev) != hipSuccess || hipDeviceGetAttribute(&cus, hipDeviceAttributeMultiprocessorCount, dev) != hipSuccess) { grid = -1; return; }
        if (hipFuncSetAttribute((const void*)mk_fwd, hipFuncAttributeMaxDynamicSharedMemorySize, LDS_BYTES) != hipSuccess) { fprintf(stderr, "kernel_launch: hipFuncSetAttribute failed\n"); grid = -1; return; }
        (void)hipGetLastError();
        grid = cus;
    }
    if (grid == -2) { (void)hipMemsetAsync(d_out, 0, (size_t)out_size * 4, stream); return; }
    if (grid < 0) return;
    (void)hipMemsetAsync((char*)d_ws + WS_CTL, 0, CTL_ZERO_BYTES, stream);
    Args a{};
    for (int i = 0; i < N_IN; ++i) a.in[i] = (const float*)d_in[i];
    a.out = (float*)d_out; a.ws = (unsigned char*)d_ws;
#if MK_PER_PHASE
    for (int p = 0; p < NPH && p <= MK_LAST_PHASE; ++p) { a.ph_lo = p; a.ph_hi = p + 1; hipLaunchKernelGGL(mk_fwd, dim3(grid), dim3(NTHREADS), LDS_BYTES, stream, a); }
#else
    a.ph_lo = 0; a.ph_hi = NPH;
    hipLaunchKernelGGL(mk_fwd, dim3(grid), dim3(NTHREADS), LDS_BYTES, stream, a);
#endif
}
```

```cpp
#include <hip/hip_runtime.h>
#include <cstdio>
#include <cstdint>

#ifndef MK_PER_PHASE
#define MK_PER_PHASE 0
#endif
#ifndef MK_REPEAT
#define MK_REPEAT -1
#endif
#ifndef MK_TIME_MASK
#define MK_TIME_MASK 0
#endif
#ifndef MK_RB_LEVEL
#define MK_RB_LEVEL 3
#endif
#ifndef MK_LAST_PHASE
#define MK_LAST_PHASE 9999
#endif

#define GAS __attribute__((address_space(1)))
#define LAS __attribute__((address_space(3)))
typedef unsigned short bf16;
typedef unsigned v4u __attribute__((ext_vector_type(4)));
typedef unsigned v2u __attribute__((ext_vector_type(2)));
typedef float f32x4 __attribute__((ext_vector_type(4)));
typedef float f32x2 __attribute__((ext_vector_type(2)));
typedef short bf16x8 __attribute__((ext_vector_type(8)));
typedef GAS unsigned gu32;
#define RLX_AGENT __ATOMIC_RELAXED, __HIP_MEMORY_SCOPE_AGENT
#define LDS_WAIT() asm volatile("s_waitcnt lgkmcnt(0)" ::: "memory")
#define VM_WAIT() asm volatile("s_waitcnt vmcnt(0)" ::: "memory")

constexpr int NB = 8, SEQ = 2048, D = 1024, M = NB * SEQ, DEPTH = 2;
constexpr int CW = 512, CKW = 31, RW = 512, RH = 64, NH = 8, LW = 64, LA = 64, LG = 128;
constexpr int NE = 64, TOPK = 8, DE = 256;
constexpr int DIN = 4864, ZR0 = 1024, ZG0 = 2816, COLR = 1792;
constexpr int NLORA = 1536, KLORA = 256;
constexpr float RMS_EPS = 1e-6f, LN_EPS = 1e-5f, GN_EPS = 64e-5f, ROUTED_SCALE = 2.5f;
constexpr int NWAVES = 8, NTHREADS = 512;

enum { I_X = 0, I_C, I_WADA, I_BADA, I_NMPRE, I_NMPOST, I_NFPRE, I_NFPOST, I_WIN, I_MU, I_CONVW, I_CONVB, I_CLNG, I_CLNB, I_PCONV,
       I_W0, I_W2, I_A0, I_A2, I_G2, I_KK, I_KA, I_RK, I_GNG, I_GNB, I_PRWKV, I_WO, I_WROUTER, I_BROUTER, I_WEG, I_WEU, I_WED, I_WSG, I_WSU, I_WSD, N_IN };

constexpr size_t MiB = 1u << 20;
constexpr size_t WS_CTL = 0, CTL_ZERO_BYTES = 1 * MiB;
constexpr size_t WS_MOD = 1 * MiB;
constexpr size_t WS_BONUS = 1 * MiB + 512 * 1024;
constexpr size_t WS_WMIX = 2 * MiB;
constexpr size_t WMIX_STRIDE = 15 * MiB;
constexpr size_t WM_WIN = 0, WM_PCONV = (size_t)DIN * D * 2, WM_PRWKV = WM_PCONV + (size_t)D * CW * 2, WM_WO = WM_PRWKV + (size_t)D * RW * 2, WM_LORA = WM_WO + (size_t)D * D * 2;
constexpr size_t WM_RHI = WM_LORA + (size_t)NLORA * KLORA * 2, WM_RLO = WM_RHI + (size_t)NE * D * 2;
static_assert(WM_RLO + (size_t)NE * D * 2 <= WMIX_STRIDE, "wmix");
constexpr size_t WS_WGU = 32 * MiB;
constexpr size_t WS_WDN = 97 * MiB;
constexpr size_t WS_H = 130 * MiB;
constexpr size_t WS_LIST = 162 * MiB;
constexpr size_t WS_GW = 167 * MiB;
constexpr size_t WS_TOKA = 172 * MiB;
constexpr size_t WS_S = 173 * MiB;
constexpr size_t WS_ZC = WS_S;
constexpr size_t WS_ZR = WS_S + 32 * MiB;
constexpr size_t WS_ZG = WS_S + 88 * MiB;
constexpr size_t WS_CQ = WS_S;
constexpr size_t WS_CG = WS_S + 16 * MiB;
constexpr size_t WS_CH = WS_S + 32 * MiB;
constexpr int ZCW = 1024, ZRW = 1792, ZGW = 2048;
static_assert(WS_ZR == WS_ZC + (size_t)NB * SEQ * 1024 * 2 && WS_ZG == WS_ZR + (size_t)NB * SEQ * 1792 * 2, "ZC | ZR | ZG adjacent");
constexpr size_t WS_LIN = WS_S + 152 * MiB;
constexpr size_t WS_LOUT = WS_S + 160 * MiB;
constexpr size_t WS_SR = WS_S + 208 * MiB;
constexpr size_t WS_SKP = WS_SR + 16 * MiB, WS_SV = WS_SR + 32 * MiB, WS_SKKN = WS_SR + 48 * MiB, WS_SKA = WS_SR + 64 * MiB;
constexpr size_t WS_SDEC = WS_SR + 80 * MiB;
constexpr size_t WS_YS = WS_SDEC + 32 * MiB;
constexpr size_t WS_UC = WS_SR;
constexpr size_t WS_YG = WS_UC;
constexpr size_t WS_MERGED = WS_SKKN;
constexpr size_t WS_Y = WS_SDEC;
constexpr size_t WS_ACT = WS_S;
constexpr size_t WS_YEXP = WS_S + 74 * MiB;
constexpr size_t WS_YSH = WS_S + 330 * MiB;
constexpr size_t WS_END = WS_S + 352 * MiB;
constexpr int CW_BAR = 4096;
constexpr int CW_CNT = 16384;
constexpr int RING_BYTES = 131072, LDS_TAB_OFF = RING_BYTES, LDS_TAB_BYTES = 11264, LDS_ROWTAB_OFF = LDS_TAB_OFF + LDS_TAB_BYTES, LDS_GWTAB_OFF = LDS_ROWTAB_OFF + 2048, MISC_OFF = 163840 - 256, LDS_BYTES = 163840;
static_assert(MISC_OFF + 256 <= LDS_BYTES, "lds");

__device__ __forceinline__ unsigned f2bf(float f) { unsigned u = __builtin_bit_cast(unsigned, f); return (u + 0x7fffu + ((u >> 16) & 1u)) >> 16; }
typedef __bf16 bf16x2_t __attribute__((ext_vector_type(2)));
__device__ __forceinline__ unsigned pk2(float lo, float hi) { const f32x2 f = {lo, hi}; return __builtin_bit_cast(unsigned, __builtin_convertvector(f, bf16x2_t)); }
__device__ __forceinline__ float bf2f(unsigned b) { return __builtin_bit_cast(float, b << 16); }
__device__ __forceinline__ float bflo(unsigned w) { return __builtin_bit_cast(float, w << 16); }
__device__ __forceinline__ float bfhi(unsigned w) { return __builtin_bit_cast(float, w & 0xffff0000u); }
__device__ __forceinline__ float sigmoidf_(float x) { return __builtin_amdgcn_rcpf(1.0f + __expf(-x)); }
__device__ __forceinline__ float siluf_(float x) { return x * __builtin_amdgcn_rcpf(1.0f + __expf(-x)); }
__device__ __forceinline__ float wave_sum(float v) {
#pragma unroll
    for (int o = 1; o < 64; o <<= 1) v += __shfl_xor(v, o);
    return v;
}

namespace pg8 {
constexpr int BM = 256, BK = 64, HALF = 128, HTB = HALF * BK * 2, STAGE_BYTES = 8 * HTB, NXCD = 8, WGM = 8;
__host__ __device__ __forceinline__ int lds_byte(int r, int c) { const int st = (r >> 4) * 2 + (c >> 5), rr = r & 15, cc = c & 31, ob = rr * 64 + cc * 2; return st * 1024 + (ob ^ (((ob >> 9) & 1) << 5)); }
__host__ __device__ __forceinline__ void stage_rc(int b, int& R, int& C) { const int st = b / 1024, sb = b % 1024, swz = sb ^ (((sb >> 9) & 1) << 5); R = (st >> 1) * 16 + swz / 64; C = (st & 1) * 32 + (swz % 64) / 2; }
__host__ __device__ __forceinline__ int perm32(int rho) { const int n = rho >> 4, i = rho & 15; return 8 * (i >> 2) + 4 * n + (i & 3); }

struct Unit { int a0, b0, o0, oc0, nrows, e, x0; };
struct Gemm { const bf16* A; const bf16* Bt; int K; const int* list; };

struct StaticOrder {
    int nM, nN, nwg, G, c;
    __device__ void init(int M_, int N_, int G_, int c_) { nM = M_ / BM; nN = N_ / BM; nwg = nM * nN; G = G_; c = c_; }
    __device__ bool next(int i, Unit& u) const {
        const long L = (long)i * G + c; if (L >= nwg) return false;
        int wgid = (int)L; { const int q = nwg / NXCD, r = nwg % NXCD, xcd = wgid % NXCD, off = wgid / NXCD; wgid = (xcd < r ? xcd * (q + 1) : r * (q + 1) + (xcd - r) * q) + off; }
        const int nig = WGM * nN, gid = wgid / nig, fm = gid * WGM, gsz = (nM - fm) < WGM ? (nM - fm) : WGM;
        const int pm = fm + ((wgid % nig) % gsz), pn = (wgid % nig) / gsz;
        u.a0 = pm * BM; u.b0 = pn * BM; u.o0 = pm * BM; u.oc0 = pn * BM; u.nrows = BM; u.e = 0; u.x0 = 0; return true;
    }
};

__device__ __forceinline__ unsigned cvt_pk_bf16(float lo, float hi) { unsigned r; asm volatile("v_cvt_pk_bf16_f32 %0, %1, %2" : "=v"(r) : "v"(lo), "v"(hi)); return r; }

struct EpiF32 {
    static constexpr bool PERM = false, HAS_MID = false;
    float* C; int ldc;
    __device__ __forceinline__ void operator()(const f32x4 (&acc)[2][2][4][2], const Unit& u, int wr, int wc, int fr, int fq) const {
        const int row0 = wr * 64 + fr, col0 = u.oc0 + wc * 32 + 4 * fq;
#pragma unroll
        for (int ai = 0; ai < 2; ++ai)
#pragma unroll
            for (int m = 0; m < 4; ++m) { const int r = row0 + ai * HALF + m * 16; if (r < u.nrows) { float* rowp = C + (size_t)(u.o0 + r) * ldc + col0;
#pragma unroll
                for (int bj = 0; bj < 2; ++bj)
#pragma unroll
                    for (int n = 0; n < 2; ++n) *(f32x4*)(rowp + bj * HALF + n * 16) = acc[ai][bj][m][n]; } }
    }
};
struct EpiBf16 {
    static constexpr bool PERM = true, HAS_MID = false;
    bf16* O; int ldc;
    __device__ __forceinline__ void operator()(const f32x4 (&acc)[2][2][4][2], const Unit& u, int wr, int wc, int fr, int fq) const {
        const int row0 = wr * 64 + fr, col0 = u.oc0 + wc * 32 + 8 * fq;
#pragma unroll
        for (int ai = 0; ai < 2; ++ai)
#pragma unroll
            for (int m = 0; m < 4; ++m) { const int r = row0 + ai * HALF + m * 16; if (r < u.nrows) { bf16* rowp = O + (size_t)(u.o0 + r) * ldc + col0;
#pragma unroll
                for (int bj = 0; bj < 2; ++bj) { const f32x4 v0 = acc[ai][bj][m][0], v1 = acc[ai][bj][m][1];
                    v4u w; w.x = cvt_pk_bf16(v0[0], v0[1]); w.y = cvt_pk_bf16(v0[2], v0[3]); w.z = cvt_pk_bf16(v1[0], v1[1]); w.w = cvt_pk_bf16(v1[2], v1[3]);
                    *(v4u*)(rowp + bj * HALF) = w; } } }
    }
};
struct EpiZ {
    static constexpr bool PERM = true, HAS_MID = false;
    bf16* ZC;
    __device__ __forceinline__ void operator()(const f32x4 (&acc)[2][2][4][2], const Unit& u, int wr, int wc, int fr, int fq) const {
        const int seg = (u.oc0 < 1024) ? 0 : (u.oc0 < 2816) ? 1 : 2;
        const int ldc = (seg == 0) ? 1024 : (seg == 1) ? 1792 : 2048, c0 = u.oc0 - ((seg == 0) ? 0 : (seg == 1) ? 1024 : 2816);
        bf16* O = ZC + ((seg == 0) ? (size_t)0 : (seg == 1) ? (size_t)M * 1024 : (size_t)M * (1024 + 1792));
        const int row0 = u.o0 + wr * 64 + fr, col0 = c0 + wc * 32 + 8 * fq;
#pragma unroll
        for (int ai = 0; ai < 2; ++ai)
#pragma unroll
            for (int m = 0; m < 4; ++m) { bf16* rowp = O + (size_t)(row0 + ai * HALF + m * 16) * ldc + col0;
#pragma unroll
                for (int bj = 0; bj < 2; ++bj) { const f32x4 v0 = acc[ai][bj][m][0], v1 = acc[ai][bj][m][1];
                    v4u w; w.x = cvt_pk_bf16(v0[0], v0[1]); w.y = cvt_pk_bf16(v0[2], v0[3]); w.z = cvt_pk_bf16(v1[0], v1[1]); w.w = cvt_pk_bf16(v1[2], v1[3]);
                    *(v4u*)(rowp + bj * HALF) = w; } }
    }
};
template <bool FIRST> struct EpiMerge {
    static constexpr bool PERM = true, HAS_MID = false;
    bf16* O; const bf16* Z; int gcol0;
    __device__ __forceinline__ void operator()(const f32x4 (&acc)[2][2][4][2], const Unit& u, int wr, int wc, int fr, int fq) const {
        const int row0 = u.o0 + wr * 64 + fr, col0 = u.oc0 + wc * 32 + 8 * fq;
#pragma unroll
        for (int ai = 0; ai < 2; ++ai)
#pragma unroll
            for (int m = 0; m < 4; ++m) { const int r = row0 + ai * HALF + m * 16; bf16* rowp = O + (size_t)r * D + col0; const bf16* zp = Z + (size_t)r * 2048 + gcol0 + col0;
#pragma unroll
                for (int bj = 0; bj < 2; ++bj) { const v4u g = *(const v4u*)(zp + bj * HALF); const f32x4 a0 = acc[ai][bj][m][0], a1 = acc[ai][bj][m][1];
                    float o[8];
                    o[0] = a0[0] * sigmoidf_(bflo(g.x)); o[1] = a0[1] * sigmoidf_(bfhi(g.x)); o[2] = a0[2] * sigmoidf_(bflo(g.y)); o[3] = a0[3] * sigmoidf_(bfhi(g.y));
                    o[4] = a1[0] * sigmoidf_(bflo(g.z)); o[5] = a1[1] * sigmoidf_(bfhi(g.z)); o[6] = a1[2] * sigmoidf_(bflo(g.w)); o[7] = a1[3] * sigmoidf_(bfhi(g.w));
                    if (!FIRST) { const v4u p = *(const v4u*)(rowp + bj * HALF);
                        o[0] += bflo(p.x); o[1] += bfhi(p.x); o[2] += bflo(p.y); o[3] += bfhi(p.y); o[4] += bflo(p.z); o[5] += bfhi(p.z); o[6] += bflo(p.w); o[7] += bfhi(p.w); }
                    v4u w; w.x = cvt_pk_bf16(o[0], o[1]); w.y = cvt_pk_bf16(o[2], o[3]); w.z = cvt_pk_bf16(o[4], o[5]); w.w = cvt_pk_bf16(o[6], o[7]);
                    *(v4u*)(rowp + bj * HALF) = w; } }
    }
};
struct EpiMerge2 {
    static constexpr bool PERM = true, HAS_MID = true;
    bf16* O; const bf16* ZG;
    __device__ __forceinline__ void mid(f32x4 (&acc)[2][2][4][2], const Unit& u, int wr, int wc, int fr, int fq) const {
        const int row0 = u.o0 + wr * 64 + fr, col0 = u.oc0 + wc * 32 + 8 * fq;
#pragma unroll
        for (int ai = 0; ai < 2; ++ai)
#pragma unroll
            for (int m = 0; m < 4; ++m) { const bf16* zp = ZG + (size_t)(row0 + ai * HALF + m * 16) * 2048 + col0;
#pragma unroll
                for (int bj = 0; bj < 2; ++bj) { const v4u g1 = *(const v4u*)(zp + bj * HALF), g2 = *(const v4u*)(zp + 1024 + bj * HALF);
#define RT_(a, b) ((1.0f + __expf(-(b))) * __builtin_amdgcn_rcpf(1.0f + __expf(-(a))))
                    acc[ai][bj][m][0][0] *= RT_(bflo(g1.x), bflo(g2.x)); acc[ai][bj][m][0][1] *= RT_(bfhi(g1.x), bfhi(g2.x)); acc[ai][bj][m][0][2] *= RT_(bflo(g1.y), bflo(g2.y)); acc[ai][bj][m][0][3] *= RT_(bfhi(g1.y), bfhi(g2.y));
                    acc[ai][bj][m][1][0] *= RT_(bflo(g1.z), bflo(g2.z)); acc[ai][bj][m][1][1] *= RT_(bfhi(g1.z), bfhi(g2.z)); acc[ai][bj][m][1][2] *= RT_(bflo(g1.w), bflo(g2.w)); acc[ai][bj][m][1][3] *= RT_(bfhi(g1.w), bfhi(g2.w));
#undef RT_
                } }
    }
    __device__ __forceinline__ void operator()(const f32x4 (&acc)[2][2][4][2], const Unit& u, int wr, int wc, int fr, int fq) const {
        const int row0 = u.o0 + wr * 64 + fr, col0 = u.oc0 + wc * 32 + 8 * fq;
#pragma unroll
        for (int ai = 0; ai < 2; ++ai)
#pragma unroll
            for (int m = 0; m < 4; ++m) { const int r = row0 + ai * HALF + m * 16; bf16* rowp = O + (size_t)r * D + col0; const bf16* zp = ZG + (size_t)r * 2048 + 1024 + col0;
#pragma unroll
                for (int bj = 0; bj < 2; ++bj) { const v4u g = *(const v4u*)(zp + bj * HALF); const f32x4 a0 = acc[ai][bj][m][0], a1 = acc[ai][bj][m][1];
                    v4u w; w.x = cvt_pk_bf16(a0[0] * sigmoidf_(bflo(g.x)), a0[1] * sigmoidf_(bfhi(g.x))); w.y = cvt_pk_bf16(a0[2] * sigmoidf_(bflo(g.y)), a0[3] * sigmoidf_(bfhi(g.y)));
                    w.z = cvt_pk_bf16(a1[0] * sigmoidf_(bflo(g.z)), a1[1] * sigmoidf_(bfhi(g.z))); w.w = cvt_pk_bf16(a1[2] * sigmoidf_(bflo(g.w)), a1[3] * sigmoidf_(bfhi(g.w)));
                    *(v4u*)(rowp + bj * HALF) = w; } }
    }
};
struct EpiFp8 {
    static constexpr bool PERM = true, HAS_MID = false;
    unsigned char* O; int ldc;
    __device__ __forceinline__ void operator()(const f32x4 (&acc)[2][2][4][2], const Unit& u, int wr, int wc, int fr, int fq) const {
        const int row0 = wr * 64 + fr, col0 = u.oc0 + wc * 32 + 8 * fq;
#pragma unroll
        for (int ai = 0; ai < 2; ++ai)
#pragma unroll
            for (int m = 0; m < 4; ++m) { const int r = row0 + ai * HALF + m * 16; if (r < u.nrows) { unsigned char* rowp = O + (size_t)(u.o0 + r) * ldc + col0;
#pragma unroll
                for (int bj = 0; bj < 2; ++bj) { const f32x4 v0 = acc[ai][bj][m][0], v1 = acc[ai][bj][m][1]; int w0 = 0, w1 = 0;
                    w0 = __builtin_amdgcn_cvt_pk_fp8_f32(v0[0], v0[1], w0, false); w0 = __builtin_amdgcn_cvt_pk_fp8_f32(v0[2], v0[3], w0, true);
                    w1 = __builtin_amdgcn_cvt_pk_fp8_f32(v1[0], v1[1], w1, false); w1 = __builtin_amdgcn_cvt_pk_fp8_f32(v1[2], v1[3], w1, true);
                    v2u w; w.x = (unsigned)w0; w.y = (unsigned)w1; *(v2u*)(rowp + bj * HALF) = w; } } }
    }
};
struct EpiSwiGLU {
    static constexpr bool PERM = true, HAS_MID = false;
    bf16* O;
    __device__ __forceinline__ void operator()(const f32x4 (&acc)[2][2][4][2], const Unit& u, int wr, int wc, int fr, int fq) const {
        const int row0 = wr * 64 + fr, col0 = (u.oc0 >> 1) + wc * 32 + 8 * fq;
#pragma unroll
        for (int ai = 0; ai < 2; ++ai)
#pragma unroll
            for (int m = 0; m < 4; ++m) { const int r = row0 + ai * HALF + m * 16; if (r < u.nrows) { bf16* rowp = O + (size_t)(u.o0 + r) * DE + col0;
                const f32x4 g0 = acc[ai][0][m][0], g1 = acc[ai][0][m][1], u0 = acc[ai][1][m][0], u1 = acc[ai][1][m][1];
                v4u w; w.x = cvt_pk_bf16(siluf_(g0[0]) * u0[0], siluf_(g0[1]) * u0[1]); w.y = cvt_pk_bf16(siluf_(g0[2]) * u0[2], siluf_(g0[3]) * u0[3]);
                w.z = cvt_pk_bf16(siluf_(g1[0]) * u1[0], siluf_(g1[1]) * u1[1]); w.w = cvt_pk_bf16(siluf_(g1[2]) * u1[2], siluf_(g1[3]) * u1[3]);
                *(v4u*)rowp = w; } }
    }
};

constexpr int ROWTAB_OFF = 131072 + 11264, GWTAB_OFF = ROWTAB_OFF + 2048;
template <class Epi, class Sched, bool GATHER>
__device__ __forceinline__ void gemm_phase(LAS unsigned char* lds, const int tid, const Gemm g, const Sched& S, const Epi& E) {
    const int wid = __builtin_amdgcn_readfirstlane(tid >> 6), lane = tid & 63, wr = wid >> 2, wc = wid & 3, fr = lane & 15, fq = lane >> 4;
    const int K = g.K, nt = K / BK;
    int sR, sC; stage_rc(tid * 16, sR, sC);
    const unsigned voffA = (unsigned)(sR * K + sC) * 2u;
    const unsigned voffB = (unsigned)((Epi::PERM ? ((sR & ~31) + perm32(sR & 31)) : sR) * K + sC) * 2u;
    const size_t kstep = (size_t)(BK * 2);
    const size_t pstep = (size_t)64 * K * 2;
    const size_t hstep = (size_t)HALF * K * 2;
    const unsigned ldsw = (unsigned)wid * 1024u;
    const int aoff = lds_byte(wr * 64 + fr, fq * 8), boff = lds_byte(wc * 32 + fr, fq * 8);
    LAS unsigned* rowtab = (LAS unsigned*)(lds + ROWTAB_OFF);
#define PG8_SA(b, h) (((b) * 2 + (h)) * HTB)
#define PG8_SB(b, h) ((4 + (b) * 2 + (h)) * HTB)
#define PG8_STAGE(bufoff, gbase, voff) do { _Pragma("unroll") for (int _i = 0; _i < 2; ++_i) { const char* _gb = (const char*)(gbase) + _i * pstep; asm volatile("" : "+s"(_gb));   \
        __builtin_amdgcn_global_load_lds((const unsigned*)(_gb + (voff)), (LAS unsigned*)(lds + (bufoff) + ldsw + _i * 8192), 16, 0, 0); } } while (0)
#define PG8_STAGE_G(bufoff, kb, sel, h) do { _Pragma("unroll") for (int _i = 0; _i < 2; ++_i) { const unsigned _ro = rowtab[(sel) * 256 + (h) * HALF + sR + 64 * _i] + (unsigned)(sC * 2); const char* _gb = (const char*)(kb); asm volatile("" : "+s"(_gb)); \
        __builtin_amdgcn_global_load_lds((const unsigned*)(_gb + _ro), (LAS unsigned*)(lds + (bufoff) + ldsw + _i * 8192), 16, 0, 0); } } while (0)
#define PG8_STAGE_A(bufoff, basep, kb, sel, h) do { if constexpr (GATHER) PG8_STAGE_G(bufoff, (const char*)g.A + (kb), sel, h); else PG8_STAGE(bufoff, (basep) + (kb) + (h) * hstep, voffA); } while (0)
#define PG8_ROWTAB(sel, u) do { if (tid < 256) { const int _rr = tid < (u).nrows ? tid : (u).nrows - 1; rowtab[(sel) * 256 + tid] = (unsigned)g.list[(u).x0 + _rr] * (unsigned)(K * 2); } } while (0)
#define PG8_LDA(dst, b, h) do { _Pragma("unroll") for (int m = 0; m < 4; ++m) _Pragma("unroll") for (int k = 0; k < 2; ++k) dst[m][k] = *(const LAS bf16x8*)(lds + PG8_SA(b, h) + aoff + m * 2048 + k * 1024); } while (0)
#define PG8_LDB(dst, b, h) do { _Pragma("unroll") for (int n = 0; n < 2; ++n) _Pragma("unroll") for (int k = 0; k < 2; ++k) dst[n][k] = *(const LAS bf16x8*)(lds + PG8_SB(b, h) + boff + n * 2048 + k * 1024); } while (0)
#define PG8_MMA(ai, bj, At, Bt) do { __builtin_amdgcn_s_setprio(1); _Pragma("unroll") for (int m = 0; m < 4; ++m) _Pragma("unroll") for (int n = 0; n < 2; ++n) _Pragma("unroll") for (int k = 0; k < 2; ++k) \
        acc[ai][bj][m][n] = __builtin_amdgcn_mfma_f32_16x16x32_bf16(Bt[n][k], At[m][k], acc[ai][bj][m][n], 0, 0, 0); __builtin_amdgcn_s_setprio(0); } while (0)
#define PG8_WAIT_V(n) asm volatile("s_waitcnt vmcnt(" #n ")" ::: "memory")
#define PG8_WAIT_L(n) asm volatile("s_waitcnt lgkmcnt(" #n ")" ::: "memory")
#define PG8_BAR __builtin_amdgcn_s_barrier()
#define PG8_SCHED __builtin_amdgcn_sched_barrier(0)
    Unit cur, nxt; int ui = 0;
    if (!S.next(0, cur)) return;
    f32x4 acc[2][2][4][2];
#pragma unroll
    for (int a = 0; a < 2; ++a)
#pragma unroll
        for (int b = 0; b < 2; ++b)
#pragma unroll
            for (int m = 0; m < 4; ++m)
#pragma unroll
                for (int n = 0; n < 2; ++n) acc[a][b][m][n] = (f32x4){0.f, 0.f, 0.f, 0.f};
    bf16x8 At[4][2], B0[2][2], B1[2][2];
    int par = 0;
    if constexpr (GATHER) { PG8_ROWTAB(0, cur); asm volatile("s_waitcnt vmcnt(0) lgkmcnt(0)" ::: "memory"); __syncthreads(); }
    const char* cA = (const char*)g.A + (size_t)cur.a0 * K * 2;
    const char* cB = (const char*)g.Bt + (size_t)cur.b0 * K * 2;
    PG8_STAGE(PG8_SB(0, 0), cB, voffB); PG8_STAGE(PG8_SB(0, 1), cB + hstep, voffB); PG8_STAGE_A(PG8_SA(0, 0), cA, 0, 0, 0); PG8_STAGE_A(PG8_SA(0, 1), cA, 0, 0, 1);
    if (wr == 1) PG8_BAR;
    PG8_WAIT_V(2); PG8_BAR;
    PG8_STAGE(PG8_SB(1, 0), cB + kstep, voffB); PG8_STAGE_A(PG8_SA(1, 0), cA, kstep, 0, 0); PG8_STAGE(PG8_SB(1, 1), cB + hstep + kstep, voffB);
    PG8_WAIT_V(6); PG8_BAR;
    for (;;) {
        const bool has_next = S.next(ui + 1, nxt);
        if constexpr (GATHER) { if (has_next) { PG8_ROWTAB(par ^ 1, nxt); asm volatile("s_waitcnt vmcnt(0) lgkmcnt(0)" ::: "memory"); } }
        const char* nA = has_next ? (const char*)g.A + (size_t)nxt.a0 * K * 2 : cA;
        const char* nB = has_next ? (const char*)g.Bt + (size_t)nxt.b0 * K * 2 : cB;
        const int npar = has_next ? (par ^ 1) : par;
        for (int t = 0; t < nt; t += 2) {
            if constexpr (Epi::HAS_MID) { if (t == nt / 2) E.mid(acc, cur, wr, wc, fr, fq); }
            const bool last = (t == nt - 2);
            const size_t k1 = (size_t)(t + 1) * kstep;
            const char* a2 = last ? nA : cA; const size_t k2 = last ? 0 : (size_t)(t + 2) * kstep; const char* b2 = last ? nB : cB + (size_t)(t + 2) * kstep;
            const size_t k3 = k2 + kstep; const char* b3 = b2 + kstep;
            const int p2 = last ? npar : par;
            PG8_LDB(B0, 0, 0); PG8_LDB(B1, 0, 1); PG8_SCHED; PG8_LDA(At, 0, 0); PG8_STAGE_A(PG8_SA(1, 1), cA, k1, par, 1);
            PG8_WAIT_V(8); PG8_WAIT_L(0); PG8_BAR; PG8_MMA(0, 0, At, B0); PG8_MMA(0, 1, At, B1); PG8_BAR; PG8_SCHED;
            PG8_LDA(At, 0, 1); PG8_STAGE(PG8_SB(0, 0), b2, voffB); PG8_STAGE(PG8_SB(0, 1), b2 + hstep, voffB); PG8_STAGE_A(PG8_SA(0, 0), a2, k2, p2, 0);
            PG8_WAIT_V(8); PG8_WAIT_L(0); PG8_BAR; PG8_MMA(1, 0, At, B0); PG8_MMA(1, 1, At, B1); PG8_BAR; PG8_SCHED;
            PG8_LDB(B0, 1, 0); PG8_LDB(B1, 1, 1); PG8_SCHED; PG8_LDA(At, 1, 0); PG8_STAGE_A(PG8_SA(0, 1), a2, k2, p2, 1);
            PG8_WAIT_V(8); PG8_WAIT_L(0); PG8_BAR; PG8_MMA(0, 0, At, B0); PG8_MMA(0, 1, At, B1); PG8_BAR; PG8_SCHED;
            PG8_LDA(At, 1, 1); PG8_STAGE(PG8_SB(1, 0), b3, voffB); PG8_STAGE(PG8_SB(1, 1), b3 + hstep, voffB); PG8_STAGE_A(PG8_SA(1, 0), a2, k3, p2, 0);
            PG8_WAIT_V(8); PG8_WAIT_L(0); PG8_BAR; PG8_MMA(1, 0, At, B0); PG8_MMA(1, 1, At, B1); PG8_BAR; PG8_SCHED;
        }
        if (wr == 0) PG8_BAR;
        E(acc, cur, wr, wc, fr, fq);
        if (!has_next) break;
#pragma unroll
        for (int a = 0; a < 2; ++a)
#pragma unroll
            for (int b = 0; b < 2; ++b)
#pragma unroll
                for (int m = 0; m < 4; ++m)
#pragma unroll
                    for (int n = 0; n < 2; ++n) acc[a][b][m][n] = (f32x4){0.f, 0.f, 0.f, 0.f};
        cur = nxt; cA = nA; cB = nB; par = npar; ++ui;
        if (wr == 1) PG8_BAR;
    }
    PG8_WAIT_V(0);
    PG8_BAR;
#undef PG8_SA
#undef PG8_SB
#undef PG8_STAGE
#undef PG8_STAGE_G
#undef PG8_STAGE_A
#undef PG8_ROWTAB
#undef PG8_LDA
#undef PG8_LDB
#undef PG8_MMA
#undef PG8_WAIT_V
#undef PG8_WAIT_L
#undef PG8_BAR
#undef PG8_SCHED
}
}

#define XB_TMO      128
#define XB_XCNT(j)  (256  + 64 * (j))
#define XB_XSUB(j)  (1280 + 64 * (j))
#define XB_XGEN(j)  (2304 + 64 * (j))
#define XB_TOP      3328
#define XB_TOPGEN   3392
#define XCD_BAR_WORDS 3456
#define XB_SPIN_CAP (1u << 18)
__device__ __forceinline__ unsigned xb_ld(unsigned* p)              { return __hip_atomic_load(p, __ATOMIC_RELAXED, __HIP_MEMORY_SCOPE_AGENT); }
__device__ __forceinline__ unsigned xb_add(unsigned* p, unsigned v) { return __hip_atomic_fetch_add(p, v, __ATOMIC_RELAXED, __HIP_MEMORY_SCOPE_AGENT); }
__device__ __forceinline__ unsigned xb_xcc_id() { return (unsigned)__builtin_amdgcn_s_getreg((3 << 11) | 20) & 0xFu; }
#define XB_SPIN(cond, bar) do { unsigned _sp = 0; while (cond) { __builtin_amdgcn_s_sleep(1); \
    if ((++_sp & 255u) == 0u) { if (xb_ld(&(bar)[XB_TMO])) break; if (_sp > XB_SPIN_CAP) { atomicAdd(&(bar)[XB_TMO], 1u); break; } } } } while (0)
struct XcdBarrier { unsigned* bar; unsigned x; volatile LAS unsigned* st; };
__device__ __forceinline__ XcdBarrier xcd_barrier_post(unsigned* bar, volatile LAS unsigned* st) {
    XcdBarrier b; b.bar = bar; b.x = xb_xcc_id(); b.st = st;
    if (threadIdx.x == 0) (void)xb_add(&bar[XB_XCNT(b.x)], 1u);
    return b;
}
__device__ __forceinline__ void xcd_barrier_complete(unsigned* bar, unsigned x, unsigned& nloc, unsigned& nx) {
    const unsigned G = gridDim.x * gridDim.y * gridDim.z;
    unsigned sum, cnt, mine, sp = 0u;
    for (;;) {
        sum = 0u; cnt = 0u; mine = 0u;
#pragma unroll
        for (unsigned j = 0; j < 16; ++j) { const unsigned c = xb_ld(&bar[XB_XCNT(j)]); sum += c; cnt += (c > 0u) ? 1u : 0u; mine = (j == x) ? c : mine; }
        if (sum == G) break;
        __builtin_amdgcn_s_sleep(1);
        if ((++sp & 255u) == 0u) { if (xb_ld(&bar[XB_TMO])) break; if (sp > XB_SPIN_CAP) { atomicAdd(&bar[XB_TMO], 1u); break; } }
    }
    nloc = mine > 0u ? mine : 1u; nx = cnt > 0u ? cnt : 1u;
}
__device__ __forceinline__ void xcd_barrier(const XcdBarrier& b, const int tid) {
    asm volatile("s_waitcnt vmcnt(0)" ::: "memory");
    __syncthreads();
    if (tid == 0) {
        unsigned* bar = b.bar;
        __builtin_amdgcn_s_waitcnt(0);
        unsigned nloc = b.st[0], nx = b.st[1];
        if (nloc == 0u) { xcd_barrier_complete(bar, b.x, nloc, nx); b.st[0] = nloc; b.st[1] = nx; }
        const unsigned old = xb_add(&bar[XB_XSUB(b.x)], 1u);
        const unsigned gen = old / nloc;
        if (old + 1u == (gen + 1u) * nloc) {
            __builtin_amdgcn_fence(__ATOMIC_RELEASE, "agent");
            asm volatile("s_waitcnt vmcnt(0)" ::: "memory");
            const unsigned og = xb_add(&bar[XB_TOP], 1u);
            const unsigned tg = og / nx;
            if (og + 1u == (tg + 1u) * nx) xb_add(&bar[XB_TOPGEN], 1u);
            else XB_SPIN(xb_ld(&bar[XB_TOPGEN]) == tg, bar);
            __builtin_amdgcn_fence(__ATOMIC_ACQUIRE, "agent");
            xb_add(&bar[XB_XGEN(b.x)], 1u);
            asm volatile("s_waitcnt vmcnt(0)" ::: "memory");
        } else {
            XB_SPIN(xb_ld(&bar[XB_XGEN(b.x)]) == gen, bar);
            __builtin_amdgcn_fence(__ATOMIC_ACQUIRE, "agent");
            asm volatile("s_waitcnt vmcnt(0)" ::: "memory");
        }
    }
    __syncthreads();
}

struct Args { const float* in[N_IN]; float* out; unsigned char* ws; int ph_lo, ph_hi; };
struct Frame {
    LAS unsigned char* lds;
    int tid, lane, wave, G, bid;
    const float* const __attribute__((address_space(4)))* in; float* out; unsigned char* ws;
};
__device__ __forceinline__ const float* mod_ptr(const Frame& F, int l, int b, int part) { return (const float*)(F.ws + WS_MOD) + ((size_t)(l * NB + b) * 6 + part) * D; }

__device__ __forceinline__ void transpose_item(const float* W, int N, int k0, int n0, bf16* WT, int ldo, int drow0, int dcol0, LAS float* scr, int lane) {
    float tv[32];
#pragma unroll
    for (int i = 0; i < 32; ++i) tv[i] = W[(size_t)(k0 + 2 * i + (lane >> 5)) * N + n0 + (lane & 31)];
#pragma unroll
    for (int i = 0; i < 32; ++i) scr[(2 * i + (lane >> 5)) * 33 + (lane & 31)] = tv[i];
    LDS_WAIT(); asm volatile("" ::: "memory");
    const int c = lane & 7;
#pragma unroll
    for (int j = 0; j < 4; ++j) { const int n = (lane >> 3) + 8 * j; const LAS float* s = scr + (8 * c) * 33 + n;
        v4u o; o.x = pk2(s[0 * 33], s[1 * 33]); o.y = pk2(s[2 * 33], s[3 * 33]); o.z = pk2(s[4 * 33], s[5 * 33]); o.w = pk2(s[6 * 33], s[7 * 33]);
        *(GAS v4u*)(WT + (size_t)(drow0 + n) * ldo + dcol0 + k0 + 8 * c) = o; }
    LDS_WAIT(); asm volatile("" ::: "memory");
}
struct EwItem { const float* src; bf16* dst; int N, ldo; };
__device__ __forceinline__ void ew_load(const EwItem& q, f32x4 (&tv)[16], int lane) {
#pragma unroll
    for (int i = 0; i < 16; ++i) tv[i] = *(const f32x4*)(q.src + (size_t)(4 * i + (lane >> 4)) * q.N + 4 * (lane & 15));
}
__device__ __forceinline__ void ew_finish(const EwItem& q, const f32x4 (&tv)[16], LAS float* scr, int lane) {
#pragma unroll
    for (int i = 0; i < 16; ++i) { LAS float* d = scr + (4 * i + (lane >> 4)) * 65 + 4 * (lane & 15); d[0] = tv[i][0]; d[1] = tv[i][1]; d[2] = tv[i][2]; d[3] = tv[i][3]; }
    LDS_WAIT(); asm volatile("" ::: "memory");
    const int c = lane & 7;
#pragma unroll
    for (int j = 0; j < 8; ++j) { const int n = (lane >> 3) + 8 * j; const LAS float* sp = scr + (8 * c) * 65 + n;
        v4u o; o.x = pk2(sp[0 * 65], sp[1 * 65]); o.y = pk2(sp[2 * 65], sp[3 * 65]); o.z = pk2(sp[4 * 65], sp[5 * 65]); o.w = pk2(sp[6 * 65], sp[7 * 65]);
        *(GAS v4u*)(q.dst + (size_t)n * q.ldo + 8 * c) = o; }
    LDS_WAIT(); asm volatile("" ::: "memory");
}
__device__ __forceinline__ int titems(int K, int N) { return (K / 64) * (N / 32); }
__device__ __forceinline__ void tdo(const float* W, int K, int N, int item, bf16* WT, int ldo, int drow0, LAS float* scr, int lane) {
    const int nblk = N / 32, kb = item / nblk, nb = item % nblk; transpose_item(W, N, 64 * kb, 32 * nb, WT, ldo, drow0 + 32 * nb, 0, scr, lane);
}

__device__ __forceinline__ void phase_mix_weights(Frame& F, int gw, int NGW) {
    LAS float* scr = (LAS float*)(F.lds + 65536 + F.wave * 8704);
    constexpr int T_WIN = (D / 64) * (DIN / 32), T_PC = (CW / 64) * (D / 32), T_PR = (RW / 64) * (D / 32), T_WO = (D / 64) * (D / 32), T_L = T_WIN + T_PC + T_PR + T_WO;
    for (int it = gw; it < DEPTH * T_L; it += NGW) {
        const int l = it / T_L; int r = it % T_L; unsigned char* wm = F.ws + WS_WMIX + (size_t)l * WMIX_STRIDE;
        if (r < T_WIN) { tdo(F.in[I_WIN] + (size_t)l * D * DIN, D, DIN, r, (bf16*)(wm + WM_WIN), D, 0, scr, F.lane); continue; } r -= T_WIN;
        if (r < T_PC) { tdo(F.in[I_PCONV] + (size_t)l * CW * D, CW, D, r, (bf16*)(wm + WM_PCONV), D, 0, scr, F.lane); continue; } r -= T_PC;
        if (r < T_PR) { tdo(F.in[I_PRWKV] + (size_t)l * RW * D, RW, D, r, (bf16*)(wm + WM_PCONV) + CW, D, 0, scr, F.lane); continue; } r -= T_PR;
        tdo(F.in[I_WO] + (size_t)l * D * D, D, D, r, (bf16*)(wm + WM_WO), D, 0, scr, F.lane);
    }
    for (int i = gw * 64 + F.lane; i < DEPTH * NE * D; i += NGW * 64) { const int l = i / (NE * D), r = i % (NE * D), e = r / D, k = r % D;
        const float v = F.in[I_WROUTER][((size_t)l * D + k) * NE + e]; const unsigned hi = f2bf(v); unsigned char* wm = F.ws + WS_WMIX + (size_t)l * WMIX_STRIDE;
        ((bf16*)(wm + WM_RHI))[r] = (bf16)hi; ((bf16*)(wm + WM_RLO))[r] = (bf16)f2bf(v - bf2f(hi)); }
    for (int i = gw * 64 + F.lane; i < DEPTH * NLORA * KLORA; i += NGW * 64) {
        const int l = i / (NLORA * KLORA), r = i % (NLORA * KLORA), n = r / KLORA, k = r % KLORA; float v = 0.f;
        if (n < 512) { if (k < 64) v = F.in[I_W2][((size_t)l * LW + k) * RW + n]; }
        else if (n < 1024) { if (k >= 64 && k < 128) v = F.in[I_A2][((size_t)l * LA + (k - 64)) * RW + (n - 512)]; }
        else { if (k >= 128) v = F.in[I_G2][((size_t)l * LG + (k - 128)) * RW + (n - 1024)]; }
        ((bf16*)(F.ws + WS_WMIX + (size_t)l * WMIX_STRIDE + WM_LORA))[r] = (bf16)f2bf(v);
    }
}
constexpr int EW_ITEMS = (NE + 1) * 192, EW_A = 2304, EW_B = 2304 + 1920;
__device__ __forceinline__ EwItem ew_item(const Frame& F, int l, int it) {
    constexpr int T_G = (D / 64) * (DE / 64), T_D = (DE / 64) * (D / 64), T_E = 2 * T_G + T_D;
    static_assert((NE + 1) * T_E == EW_ITEMS, "items");
    bf16* WGU = (bf16*)(F.ws + WS_WGU); bf16* WDN = (bf16*)(F.ws + WS_WDN);
    const int e = it / T_E; int r = it % T_E; EwItem q;
    if (r < 2 * T_G) { const int up = r >= T_G; if (up) r -= T_G;
        const float* W = (e < NE) ? (up ? F.in[I_WEU] : F.in[I_WEG]) + ((size_t)l * NE + e) * D * DE : (up ? F.in[I_WSU] : F.in[I_WSG]) + (size_t)l * D * DE;
        const int nblk = DE / 64, kb = r / nblk, nb = r % nblk, n0 = 64 * nb;
        const int drow0 = e * 512 + (n0 >> 7) * 256 + (up ? 128 : 0) + (n0 & 127);
        q.src = W + (size_t)(64 * kb) * DE + n0; q.N = DE; q.dst = WGU + (size_t)drow0 * D + 64 * kb; q.ldo = D;
    } else { r -= 2 * T_G;
        const float* W = (e < NE) ? F.in[I_WED] + ((size_t)l * NE + e) * DE * D : F.in[I_WSD] + (size_t)l * DE * D;
        const int nblk = D / 64, kb = r / nblk, nb = r % nblk;
        q.src = W + (size_t)(64 * kb) * D + 64 * nb; q.N = D; q.dst = WDN + (size_t)(e * D + 64 * nb) * DE + 64 * kb; q.ldo = DE;
    }
    return q;
}
__device__ __forceinline__ void phase_expert_weights(Frame& F, int l, int gw, int NGW, const int scr_off = 0, const int it0 = 0, const int it1 = EW_ITEMS) {
    LAS float* scr = (LAS float*)(F.lds + scr_off + F.wave * 16640);
    int it = it0 + gw; if (it >= it1) return;
    f32x4 ta[16], tb[16]; EwItem qa = ew_item(F, l, it), qb = qa;
    ew_load(qa, ta, F.lane);
    for (;;) {
        const bool hb = it + NGW < it1; if (hb) { qb = ew_item(F, l, it + NGW); ew_load(qb, tb, F.lane); }
        ew_finish(qa, ta, scr, F.lane);
        if (!hb) break;
        it += NGW;
        const bool ha = it + NGW < it1; if (ha) { qa = ew_item(F, l, it + NGW); ew_load(qa, ta, F.lane); }
        ew_finish(qb, tb, scr, F.lane);
        if (!ha) break;
        it += NGW;
    }
}
__device__ __forceinline__ void phase_ada(Frame& F) {
    LAS float* sc = (LAS float*)F.lds;
    LAS float* red = (LAS float*)(F.lds + 32768);
    for (int i = F.tid; i < NB * D; i += NTHREADS) { const int b = i / D, k = i % D; sc[k * 8 + b] = siluf_(F.in[I_C][i]); }
    __syncthreads();
    float* mod = (float*)(F.ws + WS_MOD);
    for (int it = F.bid; it < DEPTH * 96; it += F.G) {
        const int l = it / 96, n0 = (it % 96) * 64;
        float acc[8];
#pragma unroll
        for (int b = 0; b < 8; ++b) acc[b] = 0.f;
        const float* wp = F.in[I_WADA] + ((size_t)l * D + F.wave * 128) * (6 * D) + n0 + F.lane;
#pragma unroll 4
        for (int k = 0; k < 128; ++k) { const float wv = wp[(size_t)k * (6 * D)]; const LAS f32x4* s = (const LAS f32x4*)(sc + (F.wave * 128 + k) * 8); const f32x4 s0 = s[0], s1 = s[1];
            acc[0] += s0[0] * wv; acc[1] += s0[1] * wv; acc[2] += s0[2] * wv; acc[3] += s0[3] * wv; acc[4] += s1[0] * wv; acc[5] += s1[1] * wv; acc[6] += s1[2] * wv; acc[7] += s1[3] * wv; }
#pragma unroll
        for (int b = 0; b < 8; ++b) red[(F.wave * 8 + b) * 64 + F.lane] = acc[b];
        __syncthreads();
        { const int b = F.tid >> 6; float s = F.in[I_BADA][(size_t)l * 6 * D + n0 + F.lane];
#pragma unroll
          for (int w = 0; w < 8; ++w) s += red[(w * 8 + b) * 64 + F.lane];
          mod[((size_t)l * NB + b) * 6 * D + n0 + F.lane] = s; }
        __syncthreads();
    }
}

struct Row { f32x4 v[4]; };
__device__ __forceinline__ Row row_load(const float* p, int lane) { Row r; const f32x4* q = (const f32x4*)p + lane;
#pragma unroll
    for (int j = 0; j < 4; ++j) r.v[j] = q[64 * j]; return r; }
__device__ __forceinline__ void row_store(float* p, int lane, const Row& r) { f32x4* q = (f32x4*)p + lane;
#pragma unroll
    for (int j = 0; j < 4; ++j) q[64 * j] = r.v[j]; }
__device__ __forceinline__ float row_sumsq(const Row& r) { float s = 0.f;
#pragma unroll
    for (int j = 0; j < 4; ++j) s += (r.v[j][0] * r.v[j][0] + r.v[j][1] * r.v[j][1]) + (r.v[j][2] * r.v[j][2] + r.v[j][3] * r.v[j][3]); return wave_sum(s); }
__device__ __forceinline__ Row row_modnorm(const Row& x, const float* g, const float* sc, const float* sh, int lane) {
    const float rs = rsqrtf(row_sumsq(x) * (1.0f / D) + RMS_EPS); Row gg = row_load(g, lane), s1 = row_load(sc, lane), s0 = row_load(sh, lane), h;
#pragma unroll
    for (int j = 0; j < 4; ++j) h.v[j] = x.v[j] * rs * gg.v[j] * (1.0f + s1.v[j]) + s0.v[j]; return h; }
__device__ __forceinline__ void row_store_bf16(bf16* p, int lane, const Row& r) { v2u* q = (v2u*)p + lane;
#pragma unroll
    for (int j = 0; j < 4; ++j) { v2u w; w.x = pk2(r.v[j][0], r.v[j][1]); w.y = pk2(r.v[j][2], r.v[j][3]); q[64 * j] = w; } }

__device__ __forceinline__ Row row_load_bf16(const bf16* p, int lane) { Row r; const v2u* q = (const v2u*)p + lane;
#pragma unroll
    for (int j = 0; j < 4; ++j) { const v2u w = q[64 * j]; r.v[j] = (f32x4){bflo(w.x), bfhi(w.x), bflo(w.y), bfhi(w.y)}; } return r; }
__device__ __forceinline__ void phase_rowA(Frame& F, int gw, int NGW) {
    bf16* H = (bf16*)(F.ws + WS_H);
    for (int m = gw; m < M; m += NGW) { const int b = m / SEQ; Row x = row_load(F.in[I_X] + (size_t)m * D, F.lane);
        Row h = row_modnorm(x, F.in[I_NMPRE], mod_ptr(F, 0, b, 1), mod_ptr(F, 0, b, 0), F.lane); row_store_bf16(H + (size_t)m * D, F.lane, h); }
}

__device__ __forceinline__ void phase_conv(Frame& F, int l) {
    const bf16* Z = (const bf16*)(F.ws + WS_ZC); bf16* UC = (bf16*)(F.ws + WS_UC);
    LAS float* tile = (LAS float*)F.lds;
    const int c = F.tid;
    float w[CKW];
#pragma unroll
    for (int j = 0; j < CKW; ++j) w[j] = F.in[I_CONVW][((size_t)l * CKW + j) * CW + c];
    const float bias = F.in[I_CONVB][l * CW + c];
    for (int ti = F.bid; ti < M / 32; ti += F.G) {
        const int t0 = ti * 32, s0 = t0 % SEQ;
        float u[62];
#pragma unroll
        for (int i = 0; i < 62; ++i) { const bool ok = (s0 - 30 + i >= 0); const bf16* zr = Z + (size_t)(ok ? t0 - 30 + i : t0) * ZCW;
            const float a = bf2f(zr[c]), gt_ = bf2f(zr[CW + c]); u[i] = ok ? a * sigmoidf_(gt_) : 0.f; }
#pragma unroll
        for (int o = 0; o < 32; ++o) { float a = bias;
#pragma unroll
            for (int j = 0; j < CKW; ++j) a += u[o + j] * w[j];
            tile[o * CW + c] = a; }
        __syncthreads();
#pragma unroll
        for (int q = 0; q < 4; ++q) { const int o = 4 * F.wave + q; float v[8]; float s = 0.f;
#pragma unroll
            for (int i = 0; i < 8; ++i) { v[i] = tile[o * CW + F.lane + 64 * i]; s += v[i]; }
            const float mean = wave_sum(s) * (1.0f / CW); float s2 = 0.f;
#pragma unroll
            for (int i = 0; i < 8; ++i) { v[i] -= mean; s2 += v[i] * v[i]; }
            const float rstd = rsqrtf(wave_sum(s2) * (1.0f / CW) + LN_EPS);
#pragma unroll
            for (int i = 0; i < 8; ++i) { const int cc = F.lane + 64 * i; const float y = v[i] * rstd * F.in[I_CLNG][l * CW + cc] + F.in[I_CLNB][l * CW + cc];
                UC[(size_t)(t0 + o) * D + cc] = (bf16)f2bf(siluf_(y)); } }
        __syncthreads();
    }
}
__device__ __forceinline__ void phase_prep1(Frame& F, int l, int gw, int NGW) {
    const bf16* Z = (const bf16*)(F.ws + WS_ZR); bf16* LIN = (bf16*)(F.ws + WS_LIN);
    const f32x4 mu = *((const f32x4*)(F.in[I_MU] + (size_t)l * COLR + 1536) + F.lane);
    for (int m = gw; m < M; m += NGW) {
        const int s = m % SEQ; const v2u cur = *((const v2u*)(Z + (size_t)m * ZRW + 1536) + F.lane);
        v2u prv = *((const v2u*)(Z + (size_t)(s > 0 ? m - 1 : m) * ZRW + 1536) + F.lane); if (s == 0) { prv.x = 0u; prv.y = 0u; }
        float x[4] = {bflo(cur.x), bfhi(cur.x), bflo(cur.y), bfhi(cur.y)}; const float p[4] = {bflo(prv.x), bfhi(prv.x), bflo(prv.y), bfhi(prv.y)};
#pragma unroll
        for (int i = 0; i < 4; ++i) { x[i] = x[i] + (p[i] - x[i]) * mu[i]; if (F.lane < 16) x[i] = tanhf(x[i]); else if (F.lane >= 32) x[i] = sigmoidf_(x[i]); }
        v2u o; o.x = pk2(x[0], x[1]); o.y = pk2(x[2], x[3]); *((v2u*)(LIN + (size_t)m * KLORA) + F.lane) = o;
    }
}
__device__ __forceinline__ void ld8bf(const bf16* p, float (&o)[8]) { const v4u w = *(const v4u*)p; o[0] = bflo(w.x); o[1] = bfhi(w.x); o[2] = bflo(w.y); o[3] = bfhi(w.y); o[4] = bflo(w.z); o[5] = bfhi(w.z); o[6] = bflo(w.w); o[7] = bfhi(w.w); }
__device__ __forceinline__ void st8bf(bf16* p, const float (&o)[8]) { v4u w; w.x = pk2(o[0], o[1]); w.y = pk2(o[2], o[3]); w.z = pk2(o[4], o[5]); w.w = pk2(o[6], o[7]); *(v4u*)p = w; }
__device__ __forceinline__ void ld8f(const float* p, float (&o)[8]) { const f32x4 a = *(const f32x4*)p, b = *((const f32x4*)p + 1); o[0] = a[0]; o[1] = a[1]; o[2] = a[2]; o[3] = a[3]; o[4] = b[0]; o[5] = b[1]; o[6] = b[2]; o[7] = b[3]; }
__device__ __forceinline__ float grp8_sum(float v) { v += __shfl_xor(v, 1); v += __shfl_xor(v, 2); v += __shfl_xor(v, 4); return v; }
__device__ __forceinline__ void phase_prep2(Frame& F, int l, int gw, int NGW) {
    const bf16* Z = (const bf16*)(F.ws + WS_ZR); const bf16* LOUT = (const bf16*)(F.ws + WS_LOUT);
    bf16* SR = (bf16*)(F.ws + WS_SR); bf16* SKP = (bf16*)(F.ws + WS_SKP); bf16* SV = (bf16*)(F.ws + WS_SV); bf16* SKKN = (bf16*)(F.ws + WS_SKKN); bf16* SKA = (bf16*)(F.ws + WS_SKA);
    float* SDEC = (float*)(F.ws + WS_SDEC); float* BONUS = (float*)(F.ws + WS_BONUS);
    const int c = 8 * F.lane;
    float mur[8], muk[8], muv[8], w0[8], a0[8], kkw[8], kaw[8], rkw[8];
    ld8f(F.in[I_MU] + (size_t)l * COLR + c, mur); ld8f(F.in[I_MU] + (size_t)l * COLR + 512 + c, muk); ld8f(F.in[I_MU] + (size_t)l * COLR + 1024 + c, muv);
    ld8f(F.in[I_W0] + l * RW + c, w0); ld8f(F.in[I_A0] + l * RW + c, a0); ld8f(F.in[I_KK] + l * RW + c, kkw); ld8f(F.in[I_KA] + l * RW + c, kaw); ld8f(F.in[I_RK] + l * RW + c, rkw);
    for (int m = gw; m < M; m += NGW) {
        const int s = m % SEQ; const bf16* zr = Z + (size_t)m * ZRW + c;
        float r[8], k[8], v[8], pr[8], pk[8], pv[8], lw[8], la[8];
        ld8bf(zr, r); ld8bf(zr + 512, k); ld8bf(zr + 1024, v);
        { const bf16* zp = (s > 0) ? zr - ZRW : zr; ld8bf(zp, pr); ld8bf(zp + 512, pk); ld8bf(zp + 1024, pv); }
        if (s == 0) {
#pragma unroll
            for (int i = 0; i < 8; ++i) { pr[i] = 0.f; pk[i] = 0.f; pv[i] = 0.f; } }
        ld8bf(LOUT + (size_t)m * NLORA + c, lw); ld8bf(LOUT + (size_t)m * NLORA + 512 + c, la);
        float dec[8], kp[8], kk[8], ka[8]; float ss = 0.f, bo = 0.f;
#pragma unroll
        for (int i = 0; i < 8; ++i) {
            r[i] += (pr[i] - r[i]) * mur[i]; k[i] += (pk[i] - k[i]) * muk[i]; v[i] += (pv[i] - v[i]) * muv[i];
            dec[i] = __expf(-0.60653066f * sigmoidf_(w0[i] + lw[i]));
            const float a = sigmoidf_(a0[i] + la[i]);
            kk[i] = k[i] * kkw[i]; kp[i] = k[i] * (1.0f + (a - 1.0f) * kaw[i]); ka[i] = a;
            ss += kk[i] * kk[i]; bo += r[i] * kp[i] * rkw[i];
        }
        ss = grp8_sum(ss); bo = grp8_sum(bo);
        const float inv = rsqrtf(fmaxf(ss, 1e-24f));
#pragma unroll
        for (int i = 0; i < 8; ++i) { kk[i] *= inv; ka[i] *= kk[i]; }
        const size_t o = (size_t)m * RW + c;
        st8bf(SR + o, r); st8bf(SKP + o, kp); st8bf(SV + o, v); st8bf(SKKN + o, kk); st8bf(SKA + o, ka);
        *(f32x4*)(SDEC + o) = (f32x4){dec[0], dec[1], dec[2], dec[3]}; *((f32x4*)(SDEC + o) + 1) = (f32x4){dec[4], dec[5], dec[6], dec[7]};
        if ((F.lane & 7) == 0) BONUS[(size_t)m * NH + (F.lane >> 3)] = bo;
    }
}
__device__ __forceinline__ void phase_scan(Frame& F) {
    const bf16* SR = (const bf16*)(F.ws + WS_SR); const bf16* SKP = (const bf16*)(F.ws + WS_SKP); const bf16* SV = (const bf16*)(F.ws + WS_SV);
    const bf16* SKKN = (const bf16*)(F.ws + WS_SKKN); const bf16* SKA = (const bf16*)(F.ws + WS_SKA); const float* SDEC = (const float*)(F.ws + WS_SDEC);
    float* YS = (float*)(F.ws + WS_YS);
    LAS float* buf = (LAS float*)F.lds;
    const int vr = F.lane >> 3, ke = F.lane & 7, vidx = 8 * F.wave + vr;
    for (int bh = F.bid; bh < NB * NH; bh += F.G) {
        const int b = bh / NH, h = bh % NH; const size_t m0 = (size_t)b * SEQ;
        float S[8];
#pragma unroll
        for (int i = 0; i < 8; ++i) S[i] = 0.f;
        for (int c0 = 0; c0 < SEQ; c0 += 64) {
            __syncthreads();
            for (int idx = F.tid; idx < 64 * 64; idx += NTHREADS) { const int t = idx >> 6, k = idx & 63; const size_t g = (m0 + c0 + t) * RW + h * RH + k; LAS float* d = buf + t * 384 + k;
                d[0] = bf2f(SR[g]); d[64] = SDEC[g]; d[128] = bf2f(SKP[g]); d[192] = bf2f(SKKN[g]); d[256] = bf2f(SKA[g]); d[320] = bf2f(SV[g]); }
            __syncthreads();
            for (int t = 0; t < 64; ++t) {
                const LAS float* d = buf + t * 384 + ke * 8;
                float r[8], dc[8], kp[8], kn[8], ka[8];
#pragma unroll
                for (int i = 0; i < 8; ++i) { r[i] = d[i]; dc[i] = d[64 + i]; kp[i] = d[128 + i]; kn[i] = d[192 + i]; ka[i] = d[256 + i]; }
                const float v = buf[t * 384 + 320 + vidx];
                float sa = 0.f;
#pragma unroll
                for (int i = 0; i < 8; ++i) sa += S[i] * kn[i];
                sa = -grp8_sum(sa);
                float y = 0.f;
#pragma unroll
                for (int i = 0; i < 8; ++i) { S[i] = S[i] * dc[i] + sa * ka[i] + v * kp[i]; y += S[i] * r[i]; }
                y = grp8_sum(y);
                if (ke == 0) YS[(m0 + c0 + t) * RW + h * RH + vidx] = y;
            }
        }
    }
}
constexpr int CS = 72, CBUF = 64 * CS * 2;
__device__ __forceinline__ f32x4 cmm(const LAS bf16* A, const LAS bf16* B, int m0, int n0, int lane, f32x4 acc) {
#pragma unroll
    for (int ks = 0; ks < 2; ++ks) {
        const bf16x8 a = *(const LAS bf16x8*)(A + (m0 + (lane & 15)) * CS + ks * 32 + 8 * (lane >> 4));
        const bf16x8 b = *(const LAS bf16x8*)(B + (n0 + (lane & 15)) * CS + ks * 32 + 8 * (lane >> 4));
        acc = __builtin_amdgcn_mfma_f32_16x16x32_bf16(a, b, acc, 0, 0, 0);
    }
    return acc;
}
__device__ __forceinline__ void cst4(LAS bf16* O, int n, int m, const f32x4 v) { v2u w; w.x = pk2(v[0], v[1]); w.y = pk2(v[2], v[3]); *(LAS v2u*)(O + n * CS + m) = w; }
__device__ __forceinline__ f32x4 cld4(const LAS bf16* O, int n, int m) { const v2u w = *(const LAS v2u*)(O + n * CS + m); return (f32x4){bflo(w.x), bfhi(w.x), bflo(w.y), bfhi(w.y)}; }
__device__ __forceinline__ void phase_chunkprep(Frame& F, int l) {
    float* YS = (float*)(F.ws + WS_YS); bf16* CQ = (bf16*)(F.ws + WS_CQ); bf16* CG = (bf16*)(F.ws + WS_CG); float* CH = (float*)(F.ws + WS_CH);
#define CB(i) ((LAS bf16*)(F.lds + (i) * CBUF))
    LAS float* part = (LAS float*)(F.lds + 14 * CBUF);
    LAS float* pcs = part + 512;
    const int lane = F.lane, w = F.wave, n0 = 16 * (w & 3), mA = 32 * (w >> 2), nn = n0 + (lane & 15), mq = 4 * (lane >> 4);
    const bf16* ZRp = (const bf16*)(F.ws + WS_ZR); const bf16* LOUT = (const bf16*)(F.ws + WS_LOUT); bf16* SVo = (bf16*)(F.ws + WS_SV); float* BONUS = (float*)(F.ws + WS_BONUS);
    unsigned short zr_[9], zk_[9], zv_[9], lw_[8], la_[8]; float cst[8];
#define CP_LOAD(PAIR) do { const int bh_ = (PAIR) >> 5, c_ = (PAIR) & 31, h_ = bh_ & 7; const size_t mr_ = (size_t)(bh_ >> 3) * SEQ + c_ * 64 + 8 * w; const int hc_ = h_ * RH + lane; \
        _Pragma("unroll") for (int i = 0; i < 9; ++i) { const size_t row_ = (c_ == 0 && w == 0 && i == 0) ? mr_ : mr_ + i - 1; const bf16* z_ = ZRp + row_ * ZRW + hc_; zr_[i] = z_[0]; zk_[i] = z_[512]; zv_[i] = z_[1024]; } \
        _Pragma("unroll") for (int i = 0; i < 8; ++i) { const bf16* q_ = LOUT + (mr_ + i) * NLORA + hc_; lw_[i] = q_[0]; la_[i] = q_[512]; } \
        cst[0] = F.in[I_MU][(size_t)l * COLR + hc_]; cst[1] = F.in[I_MU][(size_t)l * COLR + 512 + hc_]; cst[2] = F.in[I_MU][(size_t)l * COLR + 1024 + hc_]; \
        cst[3] = F.in[I_W0][l * RW + hc_]; cst[4] = F.in[I_A0][l * RW + hc_]; cst[5] = F.in[I_KK][l * RW + hc_]; cst[6] = F.in[I_KA][l * RW + hc_]; cst[7] = F.in[I_RK][l * RW + hc_]; } while (0)
    if (F.bid < NB * NH * (SEQ / 64)) CP_LOAD(F.bid);
    for (int pair = F.bid; pair < NB * NH * (SEQ / 64); pair += F.G) {
        const int bh = pair >> 5, c = pair & 31, b = bh >> 3, h = bh & 7; const size_t m0 = (size_t)b * SEQ + c * 64;
        {
          float dc[8], kn[8], ka[8], kp[8], rr[8], vv[8], ss[8], bo[8];
          const bool first = (c == 0 && w == 0);
#pragma unroll
          for (int i = 0; i < 8; ++i) {
              const float pr = (first && i == 0) ? 0.f : bf2f(zr_[i]), pk = (first && i == 0) ? 0.f : bf2f(zk_[i]), pv = (first && i == 0) ? 0.f : bf2f(zv_[i]);
              float r = bf2f(zr_[i + 1]), k = bf2f(zk_[i + 1]), v = bf2f(zv_[i + 1]);
              r += (pr - r) * cst[0]; k += (pk - k) * cst[1]; v += (pv - v) * cst[2];
              dc[i] = __expf(-0.60653066f * sigmoidf_(cst[3] + bf2f(lw_[i])));
              const float a = sigmoidf_(cst[4] + bf2f(la_[i]));
              const float kk = k * cst[5]; kp[i] = k * (1.0f + (a - 1.0f) * cst[6]); rr[i] = r; vv[i] = v; kn[i] = kk; ka[i] = a;
              ss[i] = kk * kk; bo[i] = r * kp[i] * cst[7]; }
#pragma unroll
          for (int o = 1; o < 64; o <<= 1) {
#pragma unroll
              for (int i = 0; i < 8; ++i) { ss[i] += __shfl_xor(ss[i], o); bo[i] += __shfl_xor(bo[i], o); } }
#pragma unroll
          for (int i = 0; i < 8; ++i) { kn[i] *= rsqrtf(fmaxf(ss[i], 1e-24f)); ka[i] *= kn[i];
              SVo[(m0 + 8 * w + i) * RW + h * RH + lane] = (bf16)f2bf(vv[i]); if (lane == 0) BONUS[(m0 + 8 * w + i) * NH + h] = bo[i]; }
          float p[8]; p[0] = dc[0];
#pragma unroll
          for (int i = 1; i < 8; ++i) p[i] = p[i - 1] * dc[i];
          part[w * 64 + lane] = p[7];
          __syncthreads();
          float pre = 1.f, tot = 1.f;
#pragma unroll
          for (int g = 0; g < 8; ++g) { const float q = part[g * 64 + lane]; tot *= q; if (g < w) pre *= q; }
          if (w == 0) pcs[lane] = tot;
          float at[8], bt[8], kt[8], rt[8], bh_[8], kh[8];
#pragma unroll
          for (int i = 0; i < 8; ++i) { const float P = pre * p[i], Pm = (i == 0) ? pre : pre * p[i - 1], inv = 1.0f / P;
              at[i] = -kn[i] * Pm; bt[i] = ka[i] * inv; kt[i] = kp[i] * inv; rt[i] = rr[i] * P; bh_[i] = bt[i] * tot; kh[i] = kt[i] * tot; }
#pragma unroll
          for (int i = 0; i < 8; ++i) { const int o = (8 * w + i) * CS + lane; CB(0)[o] = (bf16)f2bf(at[i]); CB(1)[o] = (bf16)f2bf(bt[i]); CB(2)[o] = (bf16)f2bf(kt[i]); CB(3)[o] = (bf16)f2bf(rt[i]); }
          { const int o = lane * CS + 8 * w; v4u q;
            q.x = pk2(at[0], at[1]); q.y = pk2(at[2], at[3]); q.z = pk2(at[4], at[5]); q.w = pk2(at[6], at[7]); *(LAS v4u*)(CB(4) + o) = q;
            q.x = pk2(bh_[0], bh_[1]); q.y = pk2(bh_[2], bh_[3]); q.z = pk2(bh_[4], bh_[5]); q.w = pk2(bh_[6], bh_[7]); *(LAS v4u*)(CB(5) + o) = q;
            q.x = pk2(kh[0], kh[1]); q.y = pk2(kh[2], kh[3]); q.z = pk2(kh[4], kh[5]); q.w = pk2(kh[6], kh[7]); *(LAS v4u*)(CB(6) + o) = q;
            q.x = pk2(vv[0], vv[1]); q.y = pk2(vv[2], vv[3]); q.z = pk2(vv[4], vv[5]); q.w = pk2(vv[6], vv[7]); *(LAS v4u*)(CB(7) + o) = q; }
        }
        if (pair + F.G < NB * NH * (SEQ / 64)) CP_LOAD(pair + F.G);
        __syncthreads();
        const f32x4 z4 = (f32x4){0.f, 0.f, 0.f, 0.f};
#pragma unroll
        for (int tl = 0; tl < 2; ++tl) { const int m0t = mA + 16 * tl, mm = m0t + mq;
            f32x4 a1 = cmm(CB(1), CB(0), m0t, n0, lane, z4), a2 = cmm(CB(0), CB(1), m0t, n0, lane, z4), a3 = cmm(CB(2), CB(0), m0t, n0, lane, z4);
            f32x4 a4 = cmm(CB(1), CB(3), m0t, n0, lane, z4), a5 = cmm(CB(2), CB(3), m0t, n0, lane, z4), t0;
#pragma unroll
            for (int i = 0; i < 4; ++i) { const int m = mm + i; a1[i] = (m < nn) ? a1[i] : 0.f; a2[i] = (nn < m) ? a2[i] : 0.f; a3[i] = (m < nn) ? a3[i] : 0.f; a4[i] = (m <= nn) ? a4[i] : 0.f; a5[i] = (m <= nn) ? a5[i] : 0.f; t0[i] = a1[i] + ((m == nn) ? 1.f : 0.f); }
            cst4(CB(8), nn, mm, a1); cst4(CB(9), nn, mm, a2); cst4(CB(10), nn, mm, t0); cst4(CB(11), nn, mm, a3); cst4(CB(12), nn, mm, a4); cst4(CB(13), nn, mm, a5); }
        __syncthreads();
#pragma unroll
        for (int tl = 0; tl < 2; ++tl) { const int m0t = mA + 16 * tl, mm = m0t + mq;
            cst4(CB(0), nn, mm, cmm(CB(9), CB(8), m0t, n0, lane, z4)); cst4(CB(1), nn, mm, cmm(CB(8), CB(9), m0t, n0, lane, z4)); cst4(CB(2), nn, mm, cmm(CB(11), CB(7), m0t, n0, lane, z4)); }
        __syncthreads();
#define CSTEP(MP, MPT, MPN, MPTN, TI, TO, DO_MP, DO_MPT) do { _Pragma("unroll") for (int tl = 0; tl < 2; ++tl) { const int m0t = mA + 16 * tl, mm = m0t + mq; \
            if (DO_MP) cst4(CB(MPN), nn, mm, cmm(CB(MPT), CB(MP), m0t, n0, lane, z4)); if (DO_MPT) cst4(CB(MPTN), nn, mm, cmm(CB(MP), CB(MPT), m0t, n0, lane, z4)); \
            cst4(CB(TO), nn, mm, cmm(CB(MPT), CB(TI), m0t, n0, lane, cld4(CB(TI), nn, mm))); } __syncthreads(); } while (0)
        CSTEP(0, 1, 8, 9, 10, 11, true, true);
        CSTEP(8, 9, 0, 1, 11, 10, true, true);
        CSTEP(0, 1, 8, 9, 10, 11, true, true);
        CSTEP(8, 9, 0, 1, 11, 10, false, true);
        CSTEP(0, 1, 8, 9, 10, 11, false, false);
#undef CSTEP
#pragma unroll
        for (int tl = 0; tl < 2; ++tl) { const int m0t = mA + 16 * tl, mm = m0t + mq;
            cst4(CB(8), nn, mm, cmm(CB(11), CB(4), m0t, n0, lane, z4)); cst4(CB(9), nn, mm, cmm(CB(11), CB(2), m0t, n0, lane, z4)); }
        __syncthreads();
#pragma unroll
        for (int tl = 0; tl < 2; ++tl) { const int m0t = mA + 16 * tl, mm = m0t + mq;
            { const f32x4 q = cmm(CB(8), CB(12), m0t, n0, lane, cld4(CB(3), nn, mm)); v2u o; o.x = pk2(q[0], q[1]); o.y = pk2(q[2], q[3]); *(v2u*)(CQ + ((size_t)pair * 64 + nn) * 64 + mm) = o; }
            { const f32x4 y = cmm(CB(7), CB(13), m0t, n0, lane, cmm(CB(9), CB(12), m0t, n0, lane, z4)); *(f32x4*)(YS + (m0 + nn) * RW + h * RH + mm) = y; }
            { f32x4 g = cmm(CB(8), CB(5), m0t, n0, lane, z4);
#pragma unroll
              for (int i = 0; i < 4; ++i) g[i] += (mm + i == nn) ? pcs[nn] : 0.f;
              v2u o; o.x = pk2(g[0], g[1]); o.y = pk2(g[2], g[3]); *(v2u*)(CG + ((size_t)pair * 64 + nn) * 64 + mm) = o; }
            { const f32x4 hh = cmm(CB(7), CB(6), m0t, n0, lane, cmm(CB(9), CB(5), m0t, n0, lane, z4)); *(f32x4*)(CH + ((size_t)pair * 64 + nn) * 64 + mm) = hh; }
        }
        __syncthreads();
    }
#undef CB
#undef CP_LOAD
}
typedef float f32x16 __attribute__((ext_vector_type(16)));
__device__ __forceinline__ bf16x8 pack_frag(const f32x16& x, int s) {
    v4u w; w.x = pk2(x[8 * s + 0], x[8 * s + 1]); w.y = pk2(x[8 * s + 2], x[8 * s + 3]); w.z = pk2(x[8 * s + 4], x[8 * s + 5]); w.w = pk2(x[8 * s + 6], x[8 * s + 7]);
    return __builtin_bit_cast(bf16x8, w);
}
__device__ __forceinline__ bf16x8 ld_afrag(const bf16* rowp, int kbase, int hh) {
    const v2u lo = *(const v2u*)(rowp + kbase + 4 * hh), hi = *(const v2u*)(rowp + kbase + 8 + 4 * hh); v4u w; w.x = lo.x; w.y = lo.y; w.z = hi.x; w.w = hi.y; return __builtin_bit_cast(bf16x8, w);
}
__device__ __forceinline__ bf16x8 ld_afrag_lds(const LAS unsigned char* img, int row, int kbase, int hh) {
    const int k0 = kbase + 4 * hh, k1 = k0 + 8;
    const v2u lo = *(const LAS v2u*)(img + row * 128 + (((k0 >> 3) ^ (row & 7)) << 4) + ((k0 & 7) << 1));
    const v2u hi = *(const LAS v2u*)(img + row * 128 + (((k1 >> 3) ^ (row & 7)) << 4) + ((k1 & 7) << 1));
    v4u w; w.x = lo.x; w.y = lo.y; w.z = hi.x; w.w = hi.y; return __builtin_bit_cast(bf16x8, w);
}
constexpr int CS_FLAGS = 98304;
__device__ __forceinline__ void phase_chunkscan(Frame& F) {
    float* YS = (float*)(F.ws + WS_YS); const bf16* CQ = (const bf16*)(F.ws + WS_CQ); const bf16* CG = (const bf16*)(F.ws + WS_CG); const float* CH = (const float*)(F.ws + WS_CH);
    const int lane = F.lane, r32 = lane & 31, hh = lane >> 5;
    LAS unsigned char* ring = F.lds;
    volatile LAS int* flg = (volatile LAS int*)(F.lds + CS_FLAGS);
    constexpr int NCH = SEQ / 64;
    for (int item = F.bid; item < NB * NH * 2; item += F.G) {
        const int bh = item >> 1, vh = item & 1, b = bh >> 3, h = bh & 7; const size_t m0 = (size_t)b * SEQ;
        if (F.wave == 1) {
            const int drow = lane >> 3, dch = lane & 7, dsw = dch ^ drow;
            for (int c = 0; c < NCH; ++c) {
                if (c >= 3) { unsigned sp = 0; while (flg[3] < c - 2) { __builtin_amdgcn_s_sleep(1); if (++sp > (1u << 22)) break; } }
                asm volatile("" ::: "memory");
                const size_t pr_ = (size_t)bh * 32 + c; LAS unsigned char* d_ = ring + (c % 3) * 32768;
                const char* gq_ = (const char*)(CQ + pr_ * 4096) + drow * 128 + dsw * 16; const char* gg_ = (const char*)(CG + pr_ * 4096) + drow * 128 + dsw * 16;
                const char* gh_ = (const char*)(CH + pr_ * 4096 + 32 * vh) + drow * 256 + dch * 16; const char* gy_ = (const char*)(YS + (m0 + c * 64) * RW + h * RH + 32 * vh) + (size_t)drow * (RW * 4) + dch * 16;
#pragma unroll
                for (int i_ = 0; i_ < 8; ++i_) {
                    __builtin_amdgcn_global_load_lds((const unsigned*)(gq_ + i_ * 1024), (LAS unsigned*)(d_ + i_ * 1024), 16, 0, 0);
                    __builtin_amdgcn_global_load_lds((const unsigned*)(gg_ + i_ * 1024), (LAS unsigned*)(d_ + 8192 + i_ * 1024), 16, 0, 0);
                    __builtin_amdgcn_global_load_lds((const unsigned*)(gh_ + i_ * 2048), (LAS unsigned*)(d_ + 16384 + i_ * 1024), 16, 0, 0);
                    __builtin_amdgcn_global_load_lds((const unsigned*)(gy_ + (size_t)i_ * (8 * RW * 4)), (LAS unsigned*)(d_ + 24576 + i_ * 1024), 16, 0, 0); }
                if (c >= 1) { asm volatile("s_waitcnt vmcnt(32)" ::: "memory"); flg[(c - 1) % 3] = c; }
            }
            asm volatile("s_waitcnt vmcnt(0)" ::: "memory"); flg[(NCH - 1) % 3] = NCH;
        } else if (F.wave == 0) {
            f32x16 X[2];
#pragma unroll
            for (int i = 0; i < 16; ++i) { X[0][i] = 0.f; X[1][i] = 0.f; }
            for (int c = 0; c < NCH; ++c) {
                { unsigned sp = 0; while (flg[c % 3] != c + 1) { __builtin_amdgcn_s_sleep(1); if (++sp > (1u << 22)) break; } }
                asm volatile("" ::: "memory"); __builtin_amdgcn_sched_barrier(0);
                const LAS unsigned char* d = ring + (c % 3) * 32768;
                bf16x8 xb[2][2];
#pragma unroll
                for (int kt = 0; kt < 2; ++kt)
#pragma unroll
                    for (int s2 = 0; s2 < 2; ++s2) xb[kt][s2] = pack_frag(X[kt], s2);
                f32x16 Yt[2], Xn[2];
#pragma unroll
                for (int tt = 0; tt < 2; ++tt) {
#pragma unroll
                    for (int i = 0; i < 16; ++i) { const int row = 32 * tt + (i & 3) + 8 * (i >> 2) + 4 * hh; Yt[tt][i] = *(const LAS float*)(d + 24576 + row * 128 + r32 * 4); Xn[tt][i] = *(const LAS float*)(d + 16384 + row * 128 + r32 * 4); }
#pragma unroll
                    for (int kt = 0; kt < 2; ++kt)
#pragma unroll
                        for (int s2 = 0; s2 < 2; ++s2) {
                            Yt[tt] = __builtin_amdgcn_mfma_f32_32x32x16_bf16(ld_afrag_lds(d, 32 * tt + r32, 32 * kt + 16 * s2, hh), xb[kt][s2], Yt[tt], 0, 0, 0);
                            Xn[tt] = __builtin_amdgcn_mfma_f32_32x32x16_bf16(ld_afrag_lds(d + 8192, 32 * tt + r32, 32 * kt + 16 * s2, hh), xb[kt][s2], Xn[tt], 0, 0, 0); }
                }
                asm volatile("s_waitcnt lgkmcnt(0)" ::: "memory");
                flg[3] = c + 1;
#pragma unroll
                for (int tt = 0; tt < 2; ++tt)
#pragma unroll
                    for (int i = 0; i < 16; ++i) { const int row = 32 * tt + (i & 3) + 8 * (i >> 2) + 4 * hh; YS[(m0 + c * 64 + row) * RW + h * RH + 32 * vh + r32] = Yt[tt][i]; }
                X[0] = Xn[0]; X[1] = Xn[1];
            }
        }
    }
}
__device__ __forceinline__ void phase_post(Frame& F, int l, int gw, int NGW) {
    const float* YS = (const float*)(F.ws + WS_YS); const bf16* SV = (const bf16*)(F.ws + WS_SV); const bf16* LOUT = (const bf16*)(F.ws + WS_LOUT); const float* BONUS = (const float*)(F.ws + WS_BONUS);
    bf16* YG = (bf16*)(F.ws + WS_YG);
    const int c = 8 * F.lane; float gg[8], gb[8]; ld8f(F.in[I_GNG] + l * RW + c, gg); ld8f(F.in[I_GNB] + l * RW + c, gb);
    for (int m = gw; m < M; m += NGW) {
        float y[8], v[8], g[8]; ld8f(YS + (size_t)m * RW + c, y); ld8bf(SV + (size_t)m * RW + c, v); ld8bf(LOUT + (size_t)m * NLORA + 1024 + c, g);
        float s = 0.f;
#pragma unroll
        for (int i = 0; i < 8; ++i) s += y[i];
        const float mean = grp8_sum(s) * (1.0f / RH); float s2 = 0.f;
#pragma unroll
        for (int i = 0; i < 8; ++i) { y[i] -= mean; s2 += y[i] * y[i]; }
        const float rstd = rsqrtf(grp8_sum(s2) * (1.0f / RH) + GN_EPS); const float bo = BONUS[(size_t)m * NH + (F.lane >> 3)];
        float o[8];
#pragma unroll
        for (int i = 0; i < 8; ++i) o[i] = (y[i] * rstd * gg[i] + gb[i] + bo * v[i]) * g[i];
        st8bf(YG + (size_t)m * D + RW + c, o);
    }
}

__device__ __forceinline__ unsigned* cnt_word(const Frame& F, int l, int e) { return (unsigned*)(F.ws + WS_CTL) + CW_CNT + (l * NE + e) * 64; }
constexpr int HT_STRIDE = 1032;
__device__ __forceinline__ void phase_rowB(Frame& F, int l, const bool dummy) {
    const bf16* Y = (const bf16*)(F.ws + WS_Y); bf16* H = (bf16*)(F.ws + (dummy ? WS_YEXP + 64 * MiB : WS_H));
    int* LIST = (int*)(F.ws + (dummy ? WS_YEXP + 96 * MiB : WS_LIST)); float* GW = (float*)(F.ws + (dummy ? WS_YEXP + 104 * MiB : WS_GW)); int* TOKA = (int*)(F.ws + (dummy ? WS_YEXP + 112 * MiB : WS_TOKA));
    float* xout = dummy ? (float*)(F.ws + WS_YEXP) : F.out; const int lc = dummy ? l + 2 : l;
    const float* xsrc = (l == 0) ? F.in[I_X] : F.out;
    LAS bf16* hhi = (LAS bf16*)F.lds; LAS bf16* hlo = hhi + 16 * HT_STRIDE;
    LAS float* part = (LAS float*)(F.lds + 2 * 16 * HT_STRIDE * 2);
    LAS float* logit = part + 8 * 16 * 64;
    LAS int* cntl = (LAS int*)(logit + 1024 + 8 * 80);
    LAS int* asg = cntl + 128;
    if (F.tid < 128) cntl[F.tid] = 0;
    __syncthreads();
    int it = 0;
    const int lane = F.lane, w = F.wave, g4 = lane >> 4, j16 = lane & 15;
    const bf16* wrh = (const bf16*)(F.ws + WS_WMIX + (size_t)l * WMIX_STRIDE + WM_RHI); const bf16* wrl = (const bf16*)(F.ws + WS_WMIX + (size_t)l * WMIX_STRIDE + WM_RLO); const float br = F.in[I_BROUTER][l * NE + lane];
    v2u yq[2][4]; Row xq[2];
    if (F.bid < M / 16) {
#pragma unroll
        for (int rr = 0; rr < 2; ++rr) { const int m = F.bid * 16 + 2 * w + rr;
#pragma unroll
            for (int j = 0; j < 4; ++j) yq[rr][j] = *((const v2u*)(Y + (size_t)m * D) + lane + 64 * j);
            xq[rr] = row_load(xsrc + (size_t)m * D, lane); } }
    for (int tile = F.bid; tile < M / 16; tile += F.G, ++it) {
#pragma unroll
        for (int rr = 0; rr < 2; ++rr) {
            const int r = 2 * w + rr, m = tile * 16 + r, b = m / SEQ;
            Row y, x = xq[rr], gp = row_load(F.in[I_NMPOST] + l * D, lane), gt = row_load(mod_ptr(F, l, b, 2), lane);
#pragma unroll
            for (int j = 0; j < 4; ++j) y.v[j] = (f32x4){bflo(yq[rr][j].x), bfhi(yq[rr][j].x), bflo(yq[rr][j].y), bfhi(yq[rr][j].y)};
            const float rs = rsqrtf(row_sumsq(y) * (1.0f / D) + RMS_EPS);
#pragma unroll
            for (int j = 0; j < 4; ++j) x.v[j] = x.v[j] + gt.v[j] * (y.v[j] * rs * gp.v[j]);
            row_store(xout + (size_t)m * D, lane, x);
            Row h = row_modnorm(x, F.in[I_NFPRE] + l * D, mod_ptr(F, l, b, 4), mod_ptr(F, l, b, 3), lane);
            row_store_bf16(H + (size_t)m * D, lane, h);
#pragma unroll
            for (int j = 0; j < 4; ++j) { const unsigned p0 = pk2(h.v[j][0], h.v[j][1]), p1 = pk2(h.v[j][2], h.v[j][3]); v2u hi2; hi2.x = p0; hi2.y = p1;
                v2u lo2; lo2.x = pk2(h.v[j][0] - bflo(p0), h.v[j][1] - bfhi(p0)); lo2.y = pk2(h.v[j][2] - bflo(p1), h.v[j][3] - bfhi(p1));
                *((LAS v2u*)(hhi + r * HT_STRIDE) + lane + 64 * j) = hi2; *((LAS v2u*)(hlo + r * HT_STRIDE) + lane + 64 * j) = lo2; }
        }
        if (tile + F.G < M / 16) {
#pragma unroll
            for (int rr = 0; rr < 2; ++rr) { const int m = (tile + F.G) * 16 + 2 * w + rr;
#pragma unroll
                for (int j = 0; j < 4; ++j) yq[rr][j] = *((const v2u*)(Y + (size_t)m * D) + lane + 64 * j);
                xq[rr] = row_load(xsrc + (size_t)m * D, lane); } }
        __syncthreads();
        if (dummy && MK_RB_LEVEL < 2) continue;
#pragma unroll 1
        for (int et = 0; et < 4; ++et) {
            asm volatile("" : "+s"(wrh), "+s"(wrl));
            f32x4 acc = (f32x4){0.f, 0.f, 0.f, 0.f};
#pragma unroll
            for (int ks = 0; ks < 4; ++ks) { const int ko = 128 * w + 32 * ks + 8 * g4;
                const bf16x8 ah = *(const LAS bf16x8*)(hhi + j16 * HT_STRIDE + ko), al = *(const LAS bf16x8*)(hlo + j16 * HT_STRIDE + ko);
                const bf16x8 bh = *(const bf16x8*)(wrh + (size_t)(16 * et + j16) * D + ko), bl = *(const bf16x8*)(wrl + (size_t)(16 * et + j16) * D + ko);
                acc = __builtin_amdgcn_mfma_f32_16x16x32_bf16(ah, bh, acc, 0, 0, 0); acc = __builtin_amdgcn_mfma_f32_16x16x32_bf16(ah, bl, acc, 0, 0, 0); acc = __builtin_amdgcn_mfma_f32_16x16x32_bf16(al, bh, acc, 0, 0, 0); }
#pragma unroll
            for (int i = 0; i < 4; ++i) part[(w * 16 + 4 * g4 + i) * 64 + 16 * et + j16] = acc[i];
        }
        __syncthreads();
#pragma unroll
        for (int o = 0; o < 2; ++o) { const int idx = F.tid + 512 * o; float sum = 0.f;
#pragma unroll
            for (int ww = 0; ww < 8; ++ww) sum += part[ww * 1024 + idx];
            logit[idx] = sum; }
        __syncthreads();
        if (dummy && MK_RB_LEVEL < 3) continue;
#pragma unroll 1
        for (int rr = 0; rr < 2; ++rr) {
            const int r = 2 * w + rr, m = tile * 16 + r;
            const float score = sigmoidf_(logit[r * 64 + lane]), biased = score + br;
            LAS float* wb = logit + 1024 + w * 80;
            wb[lane] = biased; LDS_WAIT();
            const int g = lane >> 3;
            float gs;
            { const f32x4 ga = *(const LAS f32x4*)(wb + 8 * g), gb = *(const LAS f32x4*)(wb + 8 * g + 4); float m1 = ga[0], m2 = -__builtin_inff();
#define T2(v) do { const float v_ = (v); if (v_ > m1) { m2 = m1; m1 = v_; } else if (v_ > m2) m2 = v_; } while (0)
              T2(ga[1]); T2(ga[2]); T2(ga[3]); T2(gb[0]); T2(gb[1]); T2(gb[2]); T2(gb[3]);
#undef T2
              gs = m1 + m2; }
            if ((lane & 7) == 0) wb[64 + g] = gs;
            LDS_WAIT();
            int grk = 0;
            { const f32x4 s0 = *(const LAS f32x4*)(wb + 64), s1 = *(const LAS f32x4*)(wb + 68);
#pragma unroll
              for (int q = 0; q < 8; ++q) { const float o = (q < 4) ? s0[q & 3] : s1[q & 3]; grk += (o > gs || (o == gs && q < g)) ? 1 : 0; } }
            const float masked = (grk < 4) ? biased : -__builtin_inff();
            wb[lane] = masked; LDS_WAIT();
            int rank = 0;
#pragma unroll
            for (int q = 0; q < 16; ++q) { const f32x4 o = *(const LAS f32x4*)(wb + 4 * q);
#pragma unroll
                for (int i = 0; i < 4; ++i) rank += (o[i] > masked || (o[i] == masked && (4 * q + i) < lane)) ? 1 : 0; }
            LDS_WAIT();
            const bool chosen = rank < TOPK;
            const float ssum = wave_sum(chosen ? score : 0.f);
            if (chosen) { const int lp = __hip_atomic_fetch_add((LAS int*)cntl + lane, 1, __ATOMIC_RELAXED, __HIP_MEMORY_SCOPE_WORKGROUP);
                LAS int* q = asg + ((it * 16 + r) * TOPK + rank) * 2; q[0] = lane * 65536 + lp; q[1] = __builtin_bit_cast(int, score / ssum * ROUTED_SCALE); }
            if (lane == 0) LIST[(size_t)NE * M + m] = m;
        }
    }
    if (dummy && MK_RB_LEVEL < 3) return;
    __syncthreads();
    if (F.tid < NE) cntl[NE + F.tid] = (int)__hip_atomic_fetch_add(cnt_word(F, lc, F.tid), (unsigned)cntl[F.tid], RLX_AGENT);
    __syncthreads();
    for (int idx = F.tid; idx < it * 16 * TOPK; idx += NTHREADS) {
        const int itl = idx / (16 * TOPK), r = (idx / TOPK) % 16, m = (F.bid + itl * F.G) * 16 + r; const int ep = asg[idx * 2], e = ep >> 16, pos = cntl[NE + e] + (ep & 65535);
        LIST[(size_t)e * M + pos] = m; TOKA[((size_t)m * TOPK + (idx % TOPK)) * 2] = e * 65536 + pos; TOKA[((size_t)m * TOPK + (idx % TOPK)) * 2 + 1] = asg[idx * 2 + 1]; }
}

struct MoeTab { LAS int* cnt; LAS int* start; LAS int* tstart; LAS int* ntiles; LAS int* tiles; };
__device__ __forceinline__ MoeTab moe_tab(const Frame& F) { MoeTab T; LAS int* p = (LAS int*)(F.lds + LDS_TAB_OFF); T.cnt = p; T.start = p + 80; T.tstart = p + 160; T.ntiles = p + 240; T.tiles = p + 256; return T; }
__device__ __forceinline__ void moe_build(Frame& F, int l, bool with_tiles) {
    MoeTab T = moe_tab(F);
    __syncthreads();
    if (F.tid <= NE) T.cnt[F.tid] = (F.tid < NE) ? (int)__hip_atomic_load(cnt_word(F, l, F.tid), RLX_AGENT) : M;
    __syncthreads();
    if (F.tid <= NE) { int s = 0, ts = 0; for (int e = 0; e < F.tid; ++e) { const int c = T.cnt[e]; s += c; ts += (c + 255) >> 8; } T.start[F.tid] = s; T.tstart[F.tid] = ts;
        if (F.tid == NE) T.ntiles[0] = ts + ((M + 255) >> 8);
        if (with_tiles) { const int c = T.cnt[F.tid]; const int nt = (c + 255) >> 8;
            for (int rt = 0; rt < nt; ++rt) { LAS int* q = T.tiles + (ts + rt) * 4; q[0] = F.tid; q[1] = rt * 256; q[2] = s + rt * 256; q[3] = (c - rt * 256) < 256 ? (c - rt * 256) : 256; } } }
    __syncthreads();
}
struct MoeOrder {
    LAS const int* tiles; int ntiles, npn, nwg, G, c, bstride;
    __device__ bool next(int i, pg8::Unit& u) const {
        const long L = (long)i * G + c; if (L >= nwg) return false;
        int wgid = (int)L; { const int q = nwg / 8, r = nwg % 8, xcd = wgid % 8, off = wgid / 8; wgid = (xcd < r ? xcd * (q + 1) : r * (q + 1) + (xcd - r) * q) + off; }
        const int tile = wgid / npn, pn = wgid % npn; LAS const int* q = tiles + tile * 4;
        const int q0 = __builtin_amdgcn_readfirstlane(q[0]), q1 = __builtin_amdgcn_readfirstlane(q[1]), q2 = __builtin_amdgcn_readfirstlane(q[2]), q3 = __builtin_amdgcn_readfirstlane(q[3]);
        u.e = q0; u.x0 = q0 * M + q1; u.o0 = q2; u.nrows = q3; u.b0 = q0 * bstride + pn * 256; u.oc0 = pn * 256; u.a0 = q2; return true;
    }
};
__device__ __forceinline__ Row row_load_fp8(const unsigned char* p, int lane) { Row r; const unsigned* q = (const unsigned*)p + lane;
#pragma unroll
    for (int j = 0; j < 4; ++j) { const int w = (int)q[64 * j]; const f32x2 lo = __builtin_amdgcn_cvt_pk_f32_fp8(w, false), hi = __builtin_amdgcn_cvt_pk_f32_fp8(w, true); r.v[j] = (f32x4){lo.x, lo.y, hi.x, hi.y}; } return r; }
__device__ __forceinline__ void phase_rowC(Frame& F, int l, int gw, int NGW, const bool dummy) {
    const unsigned char* YEXP = (const unsigned char*)(F.ws + WS_YEXP); const unsigned char* YSH = YEXP + (size_t)M * TOPK * D; const int* TOKA = (const int*)(F.ws + WS_TOKA); bf16* H = (bf16*)(F.ws + (dummy ? WS_S : WS_H));
    float* xout = dummy ? (float*)(F.ws + WS_S) : F.out;
    MoeTab T = moe_tab(F);
    for (int m = gw; m < M; m += NGW) {
        const int b = m / SEQ;
        Row y = row_load_fp8(YSH + (size_t)m * D, F.lane);
#pragma unroll
        for (int j8 = 0; j8 < TOPK; ++j8) { const int ep = TOKA[((size_t)m * TOPK + j8) * 2]; const float gt_ = __builtin_bit_cast(float, TOKA[((size_t)m * TOPK + j8) * 2 + 1]);
            const int slot = T.start[ep >> 16] + (ep & 65535); const Row t = row_load_fp8(YEXP + (size_t)slot * D, F.lane);
#pragma unroll
            for (int j = 0; j < 4; ++j) y.v[j] += gt_ * t.v[j]; }
        Row x = row_load(F.out + (size_t)m * D, F.lane), gp = row_load(F.in[I_NFPOST] + l * D, F.lane), gt = row_load(mod_ptr(F, l, b, 5), F.lane);
        const float rs = rsqrtf(row_sumsq(y) * (1.0f / D) + RMS_EPS);
#pragma unroll
        for (int j = 0; j < 4; ++j) x.v[j] = x.v[j] + gt.v[j] * (y.v[j] * rs * gp.v[j]);
        row_store(xout + (size_t)m * D, F.lane, x);
        if (l + 1 < DEPTH) { Row h = row_modnorm(x, F.in[I_NMPRE] + (l + 1) * D, mod_ptr(F, l + 1, b, 1), mod_ptr(F, l + 1, b, 0), F.lane); row_store_bf16(H + (size_t)m * D, F.lane, h); }
    }
}

__device__ __forceinline__ void phase_begin(Frame& F) { asm volatile("" : "+s"(F.in), "+s"(F.ws), "+s"(F.out), "+s"(F.bid), "+s"(F.G), "+s"(F.wave));
    F.lane = (int)__builtin_amdgcn_mbcnt_hi(~0u, __builtin_amdgcn_mbcnt_lo(~0u, 0u)); asm volatile("" : "+v"(F.lane)); F.tid = F.wave * 64 + F.lane; }
constexpr int PH_PER_LAYER = 13, NPH = 2 + DEPTH * PH_PER_LAYER;
__device__ __forceinline__ void bar_launder(XcdBarrier& bar) { asm volatile("" : "+s"(bar.bar)); }
#define TBIT(k) ((k) == 0 ? 13 : (k) == 1 ? 14 : ((k) - 2) % PH_PER_LAYER)
#define IN(k) (phase_begin(F), bar_launder(bar), t_ph = (((MK_TIME_MASK >> TBIT(k)) & 1) ? __builtin_amdgcn_s_memrealtime() : 0ull), (lo <= (k) && (k) < hi))
#define SEAM(k) do { if (!MK_PER_PHASE && (k) + 1 < hi) { xcd_barrier(bar, F.tid); if ((MK_TIME_MASK >> TBIT(k)) & 1) t_acc += __builtin_amdgcn_s_memrealtime() - t_ph; if (MK_REPEAT == -3) { bar_launder(bar); xcd_barrier(bar, F.tid); } } } while (0)
template <int L> __device__ __forceinline__ void layer_phases(Frame& F, XcdBarrier& bar, const int lo, const int hi, unsigned long long& t_acc) {
    constexpr int l = L, p0 = 2 + L * PH_PER_LAYER; unsigned long long t_ph = 0;
#define GW_ const int gw = F.bid * NWAVES + F.wave, NGW = F.G * NWAVES
#define WM_ unsigned char* wm = F.ws + WS_WMIX + (size_t)l * WMIX_STRIDE
    if (IN(p0 + 0)) { for (int rep_ = 0; rep_ < ((MK_REPEAT == 0) ? 2 : 1); ++rep_) { phase_begin(F); bar_launder(bar); WM_;
        pg8::Gemm g{(const bf16*)(F.ws + WS_H), (const bf16*)(wm + WM_WIN), D, nullptr}; pg8::StaticOrder S; S.init(M, DIN, F.G, F.bid);
        pg8::EpiZ E{(bf16*)(F.ws + WS_ZC)}; pg8::gemm_phase<pg8::EpiZ, pg8::StaticOrder, false>(F.lds, F.tid, g, S, E);
        { const int nun = (M / 256) * (DIN / 256), idle0 = nun % F.G;
          if (idle0 > 0 && F.bid >= idle0) phase_expert_weights(F, l, (F.bid - idle0) * NWAVES + F.wave, (F.G - idle0) * NWAVES, 0, 0, EW_A); else if (idle0 == 0) { GW_; phase_expert_weights(F, l, gw, NGW, 0, 0, EW_A); } } } SEAM(p0 + 0); }
    if (IN(p0 + 1)) { for (int rep_ = 0; rep_ < ((MK_REPEAT == 1) ? 2 : 1); ++rep_) { phase_begin(F); bar_launder(bar); GW_; phase_conv(F, l); if (MK_REPEAT == 101) phase_conv(F, l); phase_prep1(F, l, gw, NGW); if (MK_REPEAT == 102) phase_prep1(F, l, gw, NGW); } SEAM(p0 + 1); }
    if (IN(p0 + 2)) { for (int rep_ = 0; rep_ < ((MK_REPEAT == 2) ? 2 : 1); ++rep_) { phase_begin(F); bar_launder(bar); WM_; pg8::Gemm g{(const bf16*)(F.ws + WS_LIN), (const bf16*)(wm + WM_LORA), KLORA, nullptr}; pg8::StaticOrder S; S.init(M, NLORA, F.G, F.bid);
        pg8::EpiBf16 E{(bf16*)(F.ws + WS_LOUT), NLORA}; pg8::gemm_phase<pg8::EpiBf16, pg8::StaticOrder, false>(F.lds, F.tid, g, S, E);
        { const int nun = (M / 256) * (NLORA / 256), idle0 = nun % F.G;
          if (idle0 > 0 && F.bid >= idle0) phase_expert_weights(F, l, (F.bid - idle0) * NWAVES + F.wave, (F.G - idle0) * NWAVES, 0, EW_A, EW_B); else if (idle0 == 0) { GW_; phase_expert_weights(F, l, gw, NGW, 0, EW_A, EW_B); } } } SEAM(p0 + 2); }
    if (IN(p0 + 4)) { for (int rep_ = 0; rep_ < ((MK_REPEAT == 4) ? 2 : 1); ++rep_) { phase_begin(F); bar_launder(bar); phase_chunkprep(F, l); } SEAM(p0 + 4); }
    if (IN(p0 + 5)) { for (int rep_ = 0; rep_ < ((MK_REPEAT == 5) ? 2 : 1); ++rep_) { phase_begin(F); bar_launder(bar); const int nscan = NB * NH * 2;
        if (F.tid < 4) ((volatile LAS int*)(F.lds + CS_FLAGS))[F.tid] = 0;
        __syncthreads();
        if (F.G > nscan) { if (F.bid < nscan) { if (F.wave < 2 && rep_ == 0) phase_chunkscan(F); }
                           else phase_expert_weights(F, l, (F.bid - nscan) * NWAVES + F.wave, (F.G - nscan) * NWAVES, 0, EW_B, EW_ITEMS); }
        else { if (rep_ == 0 && F.wave < 2) phase_chunkscan(F); __syncthreads(); { GW_; phase_expert_weights(F, l, gw, NGW, 0, EW_B, EW_ITEMS); } } } SEAM(p0 + 5); }
    if (IN(p0 + 6)) { for (int rep_ = 0; rep_ < ((MK_REPEAT == 6) ? 2 : 1); ++rep_) { phase_begin(F); bar_launder(bar); GW_; phase_post(F, l, gw, NGW); } SEAM(p0 + 6); }
    if (IN(p0 + 7)) { for (int rep_ = 0; rep_ < ((MK_REPEAT == 7) ? 2 : 1); ++rep_) { phase_begin(F); bar_launder(bar); WM_; pg8::StaticOrder S; S.init(M, D, F.G, F.bid);
        pg8::Gemm g{(const bf16*)(F.ws + WS_UC), (const bf16*)(wm + WM_PCONV), D, nullptr}; pg8::EpiMerge2 E{(bf16*)(F.ws + WS_MERGED), (const bf16*)(F.ws + WS_ZG)};
        pg8::gemm_phase<pg8::EpiMerge2, pg8::StaticOrder, false>(F.lds, F.tid, g, S, E); } SEAM(p0 + 7); }
    if (IN(p0 + 8)) { for (int rep_ = 0; rep_ < ((MK_REPEAT == 8) ? 2 : 1); ++rep_) { phase_begin(F); bar_launder(bar); WM_; pg8::Gemm g{(const bf16*)(F.ws + WS_MERGED), (const bf16*)(wm + WM_WO), D, nullptr}; pg8::StaticOrder S; S.init(M, D, F.G, F.bid);
        pg8::EpiBf16 E{(bf16*)(F.ws + WS_Y), D}; pg8::gemm_phase<pg8::EpiBf16, pg8::StaticOrder, false>(F.lds, F.tid, g, S, E); } SEAM(p0 + 8); }
    if (IN(p0 + 9)) { for (int rep_ = 0; rep_ < ((MK_REPEAT == 9) ? 2 : 1); ++rep_) { phase_begin(F); bar_launder(bar); phase_rowB(F, l, (MK_REPEAT == 9) && rep_ == 0); } SEAM(p0 + 9); }
    if (IN(p0 + 10)) { for (int rep_ = 0; rep_ < ((MK_REPEAT == 10) ? 2 : 1); ++rep_) { phase_begin(F); bar_launder(bar); moe_build(F, l, true); MoeTab T = moe_tab(F);
        const int ntl = __builtin_amdgcn_readfirstlane(T.ntiles[0]); MoeOrder S{T.tiles, ntl, 2, ntl * 2, F.G, F.bid, 512};
        pg8::Gemm g{(const bf16*)(F.ws + WS_H), (const bf16*)(F.ws + WS_WGU), D, (const int*)(F.ws + WS_LIST)};
        pg8::EpiSwiGLU E{(bf16*)(F.ws + WS_ACT)}; pg8::gemm_phase<pg8::EpiSwiGLU, MoeOrder, true>(F.lds, F.tid, g, S, E); } SEAM(p0 + 10); }
    if (IN(p0 + 11)) { for (int rep_ = 0; rep_ < ((MK_REPEAT == 11) ? 2 : 1); ++rep_) { phase_begin(F); bar_launder(bar); moe_build(F, l, true); MoeTab T = moe_tab(F);
        const int ntl = __builtin_amdgcn_readfirstlane(T.ntiles[0]); MoeOrder S{T.tiles, ntl, 4, ntl * 4, F.G, F.bid, 1024};
        pg8::Gemm g{(const bf16*)(F.ws + WS_ACT), (const bf16*)(F.ws + WS_WDN), DE, nullptr};
        pg8::EpiFp8 E{(unsigned char*)(F.ws + WS_YEXP), D}; pg8::gemm_phase<pg8::EpiFp8, MoeOrder, false>(F.lds, F.tid, g, S, E); } SEAM(p0 + 11); }
    if (IN(p0 + 12)) { for (int rep_ = 0; rep_ < ((MK_REPEAT == 12) ? 2 : 1); ++rep_) { phase_begin(F); bar_launder(bar); GW_; moe_build(F, l, false); phase_rowC(F, l, gw, NGW, (MK_REPEAT == 12) && rep_ == 0); } SEAM(p0 + 12); }
}
__global__ void __launch_bounds__(NTHREADS, 2) mk_fwd(Args args) {
    extern __shared__ __attribute__((aligned(16))) unsigned char lds_raw[];
    Frame F; F.lds = (LAS unsigned char*)lds_raw; F.tid = threadIdx.x; F.lane = F.tid & 63; F.wave = __builtin_amdgcn_readfirstlane(F.tid >> 6);
    F.G = gridDim.x; F.bid = blockIdx.x; F.in = (const float* const __attribute__((address_space(4)))*)__builtin_amdgcn_kernarg_segment_ptr(); F.out = args.out; F.ws = args.ws;
    volatile LAS unsigned* MISC = (volatile LAS unsigned*)(F.lds + MISC_OFF);
    if (F.tid < 64) MISC[F.tid] = 0u;
    __syncthreads();
    XcdBarrier bar; bar.bar = (unsigned*)(F.ws + WS_CTL) + CW_BAR; bar.x = 0; bar.st = nullptr;
    if (!MK_PER_PHASE) bar = xcd_barrier_post((unsigned*)(F.ws + WS_CTL) + CW_BAR, MISC + 8);
    const int lo = args.ph_lo, hi = (args.ph_hi < MK_LAST_PHASE + 1) ? args.ph_hi : MK_LAST_PHASE + 1;
    unsigned long long t_acc = 0, t_ph = 0;
    if (IN(0)) { for (int rep_ = 0; rep_ < ((MK_REPEAT == -2) ? 2 : 1); ++rep_) { phase_begin(F); bar_launder(bar); GW_; phase_ada(F); phase_mix_weights(F, gw, NGW); } SEAM(0); }
    if (IN(1)) { GW_; phase_rowA(F, gw, NGW); SEAM(1); }
    layer_phases<0>(F, bar, lo, hi, t_acc);
    layer_phases<1>(F, bar, lo, hi, t_acc);
    if (MK_TIME_MASK != 0 && F.bid == 0) { const unsigned long long te = __builtin_amdgcn_s_memrealtime() + t_acc; while (__builtin_amdgcn_s_memrealtime() < te) __builtin_amdgcn_s_sleep(8); }
    if (MK_LAST_PHASE < 2 + 9 && args.ph_hi == NPH) { phase_begin(F); for (size_t i = (size_t)F.bid * NTHREADS + F.tid; i < (size_t)M * D / 4; i += (size_t)F.G * NTHREADS) ((f32x4*)F.out)[i] = ((const f32x4*)F.in[I_X])[i]; }
}
#undef IN
#undef SEAM
#undef GW_
#undef WM_

extern "C" void kernel_launch(void* const* d_in, const int* in_sizes, int n_in, void* d_out, int out_size, void* d_ws, size_t ws_size, hipStream_t stream) {
    static int grid = 0;
    if (grid == 0) {
        if (n_in != N_IN || out_size != M * D) { fprintf(stderr, "kernel_launch: unexpected shapes (n_in %d out %d ws %zu need %zu)\n", n_in, out_size, ws_size, (size_t)WS_END); grid = -1; return; }
        if (ws_size < WS_END) { fprintf(stderr, "kernel_launch: ws too small %zu < %zu\n", ws_size, (size_t)WS_END); grid = -2; }
        int dev = 0, cus = 0;
        if (hipGetDevice(&dev) != hipSuccess || hipDeviceGetAttribute(&cus, hipDeviceAttributeMultiprocessorCount, dev) != hipSuccess) { grid = -1; return; }
        if (hipFuncSetAttribute((const void*)mk_fwd, hipFuncAttributeMaxDynamicSharedMemorySize, LDS_BYTES) != hipSuccess) { fprintf(stderr, "kernel_launch: hipFuncSetAttribute failed\n"); grid = -1; return; }
        (void)hipGetLastError();
        grid = cus;
    }
    if (grid == -2) { (void)hipMemsetAsync(d_out, 0, (size_t)out_size * 4, stream); return; }
    if (grid < 0) return;
    (void)hipMemsetAsync((char*)d_ws + WS_CTL, 0, CTL_ZERO_BYTES, stream);
    Args a{};
    for (int i = 0; i < N_IN; ++i) a.in[i] = (const float*)d_in[i];
    a.out = (float*)d_out; a.ws = (unsigned char*)d_ws;
#if MK_PER_PHASE
    for (int p = 0; p < NPH && p <= MK_LAST_PHASE; ++p) { a.ph_lo = p; a.ph_hi = p + 1; hipLaunchKernelGGL(mk_fwd, dim3(grid), dim3(NTHREADS), LDS_BYTES, stream, a); }
#else
    a.ph_lo = 0; a.ph_hi = NPH;
    hipLaunchKernelGGL(mk_fwd, dim3(grid), dim3(NTHREADS), LDS_BYTES, stream, a);
#endif
}
```

```cpp
#include <hip/hip_runtime.h>
#include <cstdio>
#include <cstdint>

#ifndef MK_PER_PHASE
#define MK_PER_PHASE 0
#endif
#ifndef MK_REPEAT
#define MK_REPEAT -1
#endif
#ifndef MK_TIME_MASK
#define MK_TIME_MASK 0
#endif
#ifndef MK_RB_LEVEL
#define MK_RB_LEVEL 3
#endif
#ifndef MK_LAST_PHASE
#define MK_LAST_PHASE 9999
#endif

#define GAS __attribute__((address_space(1)))
#define LAS __attribute__((address_space(3)))
typedef unsigned short bf16;
typedef unsigned v4u __attribute__((ext_vector_type(4)));
typedef unsigned v2u __attribute__((ext_vector_type(2)));
typedef float f32x4 __attribute__((ext_vector_type(4)));
typedef float f32x2 __attribute__((ext_vector_type(2)));
typedef short bf16x8 __attribute__((ext_vector_type(8)));
typedef GAS unsigned gu32;
#define RLX_AGENT __ATOMIC_RELAXED, __HIP_MEMORY_SCOPE_AGENT
#define LDS_WAIT() asm volatile("s_waitcnt lgkmcnt(0)" ::: "memory")
#define VM_WAIT() asm volatile("s_waitcnt vmcnt(0)" ::: "memory")

constexpr int NB = 8, SEQ = 2048, D = 1024, M = NB * SEQ, DEPTH = 2;
constexpr int CW = 512, CKW = 31, RW = 512, RH = 64, NH = 8, LW = 64, LA = 64, LG = 128;
constexpr int NE = 64, TOPK = 8, DE = 256;
constexpr int DIN = 4864, ZR0 = 1024, ZG0 = 2816, COLR = 1792;
constexpr int NLORA = 1536, KLORA = 256;
constexpr float RMS_EPS = 1e-6f, LN_EPS = 1e-5f, GN_EPS = 64e-5f, ROUTED_SCALE = 2.5f;
constexpr int NWAVES = 8, NTHREADS = 512;

enum { I_X = 0, I_C, I_WADA, I_BADA, I_NMPRE, I_NMPOST, I_NFPRE, I_NFPOST, I_WIN, I_MU, I_CONVW, I_CONVB, I_CLNG, I_CLNB, I_PCONV,
       I_W0, I_W2, I_A0, I_A2, I_G2, I_KK, I_KA, I_RK, I_GNG, I_GNB, I_PRWKV, I_WO, I_WROUTER, I_BROUTER, I_WEG, I_WEU, I_WED, I_WSG, I_WSU, I_WSD, N_IN };

constexpr size_t MiB = 1u << 20;
constexpr size_t WS_CTL = 0, CTL_ZERO_BYTES = 1 * MiB;
constexpr size_t WS_MOD = 1 * MiB;
constexpr size_t WS_BONUS = 1 * MiB + 512 * 1024;
constexpr size_t WS_WMIX = 2 * MiB;
constexpr size_t WMIX_STRIDE = 15 * MiB;
constexpr size_t WM_WIN = 0, WM_PCONV = (size_t)DIN * D * 2, WM_PRWKV = WM_PCONV + (size_t)D * CW * 2, WM_WO = WM_PRWKV + (size_t)D * RW * 2, WM_LORA = WM_WO + (size_t)D * D * 2;
constexpr size_t WM_RHI = WM_LORA + (size_t)NLORA * KLORA * 2, WM_RLO = WM_RHI + (size_t)NE * D * 2;
static_assert(WM_RLO + (size_t)NE * D * 2 <= WMIX_STRIDE, "wmix");
constexpr size_t WS_WGU = 32 * MiB;
constexpr size_t WS_WDN = 97 * MiB;
constexpr size_t WS_H = 130 * MiB;
constexpr size_t WS_LIST = 162 * MiB;
constexpr size_t WS_GW = 167 * MiB;
constexpr size_t WS_TOKA = 172 * MiB;
constexpr size_t WS_S = 173 * MiB;
constexpr size_t WS_ZC = WS_S;
constexpr size_t WS_ZR = WS_S + 32 * MiB;
constexpr size_t WS_ZG = WS_S + 88 * MiB;
constexpr size_t WS_CQ = WS_S;
constexpr size_t WS_CG = WS_S + 16 * MiB;
constexpr size_t WS_CH = WS_S + 32 * MiB;
constexpr int ZCW = 1024, ZRW = 1792, ZGW = 2048;
static_assert(WS_ZR == WS_ZC + (size_t)NB * SEQ * 1024 * 2 && WS_ZG == WS_ZR + (size_t)NB * SEQ * 1792 * 2, "ZC | ZR | ZG adjacent");
constexpr size_t WS_LIN = WS_S + 152 * MiB;
constexpr size_t WS_LOUT = WS_S + 160 * MiB;
constexpr size_t WS_SR = WS_S + 208 * MiB;
constexpr size_t WS_SKP = WS_SR + 16 * MiB, WS_SV = WS_SR + 32 * MiB, WS_SKKN = WS_SR + 48 * MiB, WS_SKA = WS_SR + 64 * MiB;
constexpr size_t WS_SDEC = WS_SR + 80 * MiB;
constexpr size_t WS_YS = WS_SDEC + 32 * MiB;
constexpr size_t WS_UC = WS_SR;
constexpr size_t WS_YG = WS_UC;
constexpr size_t WS_MERGED = WS_SKKN;
constexpr size_t WS_Y = WS_SDEC;
constexpr size_t WS_ACT = WS_S;
constexpr size_t WS_YEXP = WS_S + 74 * MiB;
constexpr size_t WS_YSH = WS_S + 330 * MiB;
constexpr size_t WS_XB = WS_S + 352 * MiB;
constexpr size_t WS_END = WS_S + 384 * MiB;
constexpr int CW_BAR = 4096;
constexpr int CW_CNT = 16384;
constexpr int RING_BYTES = 131072, LDS_TAB_OFF = RING_BYTES, LDS_TAB_BYTES = 11264, LDS_ROWTAB_OFF = LDS_TAB_OFF + LDS_TAB_BYTES, LDS_GWTAB_OFF = LDS_ROWTAB_OFF + 2048, MISC_OFF = 163840 - 256, LDS_BYTES = 163840;
static_assert(MISC_OFF + 256 <= LDS_BYTES, "lds");

__device__ __forceinline__ unsigned f2bf(float f) { unsigned u = __builtin_bit_cast(unsigned, f); return (u + 0x7fffu + ((u >> 16) & 1u)) >> 16; }
typedef __bf16 bf16x2_t __attribute__((ext_vector_type(2)));
__device__ __forceinline__ unsigned pk2(float lo, float hi) { const f32x2 f = {lo, hi}; return __builtin_bit_cast(unsigned, __builtin_convertvector(f, bf16x2_t)); }
__device__ __forceinline__ float bf2f(unsigned b) { return __builtin_bit_cast(float, b << 16); }
__device__ __forceinline__ float bflo(unsigned w) { return __builtin_bit_cast(float, w << 16); }
__device__ __forceinline__ float bfhi(unsigned w) { return __builtin_bit_cast(float, w & 0xffff0000u); }
__device__ __forceinline__ float sigmoidf_(float x) { return __builtin_amdgcn_rcpf(1.0f + __expf(-x)); }
__device__ __forceinline__ float siluf_(float x) { return x * __builtin_amdgcn_rcpf(1.0f + __expf(-x)); }
template <int CTRL, int RMASK> __device__ __forceinline__ float dpp_get(float v) { return __builtin_bit_cast(float, __builtin_amdgcn_update_dpp(0, __builtin_bit_cast(int, v), CTRL, RMASK, 0xF, true)); }
__device__ __forceinline__ float wave_sum(float v) {
    v += dpp_get<0xB1, 0xF>(v); v += dpp_get<0x4E, 0xF>(v); v += dpp_get<0x141, 0xF>(v); v += dpp_get<0x140, 0xF>(v);
    v += dpp_get<0x142, 0xA>(v); v += dpp_get<0x143, 0xC>(v);
    return __builtin_bit_cast(float, __builtin_amdgcn_readlane(__builtin_bit_cast(int, v), 63));
}
namespace pg8 {
constexpr int BM = 256, BK = 64, HALF = 128, HTB = HALF * BK * 2, STAGE_BYTES = 8 * HTB, NXCD = 8, WGM = 8;
__host__ __device__ __forceinline__ int lds_byte(int r, int c) { const int st = (r >> 4) * 2 + (c >> 5), rr = r & 15, cc = c & 31, ob = rr * 64 + cc * 2; return st * 1024 + (ob ^ (((ob >> 9) & 1) << 5)); }
__host__ __device__ __forceinline__ void stage_rc(int b, int& R, int& C) { const int st = b / 1024, sb = b % 1024, swz = sb ^ (((sb >> 9) & 1) << 5); R = (st >> 1) * 16 + swz / 64; C = (st & 1) * 32 + (swz % 64) / 2; }
__host__ __device__ __forceinline__ int perm32(int rho) { const int n = rho >> 4, i = rho & 15; return 8 * (i >> 2) + 4 * n + (i & 3); }

struct Unit { int a0, b0, o0, oc0, nrows, e, x0; };
struct Gemm { const bf16* A; const bf16* Bt; int K; const int* list; };

struct StaticOrder {
    int nM, nN, nwg, G, c;
    __device__ void init(int M_, int N_, int G_, int c_) { nM = M_ / BM; nN = N_ / BM; nwg = nM * nN; G = G_; c = c_; }
    __device__ bool next(int i, Unit& u) const {
        const long L = (long)i * G + c; if (L >= nwg) return false;
        int wgid = (int)L; { const int q = nwg / NXCD, r = nwg % NXCD, xcd = wgid % NXCD, off = wgid / NXCD; wgid = (xcd < r ? xcd * (q + 1) : r * (q + 1) + (xcd - r) * q) + off; }
        const int nig = WGM * nN, gid = wgid / nig, fm = gid * WGM, gsz = (nM - fm) < WGM ? (nM - fm) : WGM;
        const int pm = fm + ((wgid % nig) % gsz), pn = (wgid % nig) / gsz;
        u.a0 = pm * BM; u.b0 = pn * BM; u.o0 = pm * BM; u.oc0 = pn * BM; u.nrows = BM; u.e = 0; u.x0 = 0; return true;
    }
};

__device__ __forceinline__ unsigned cvt_pk_bf16(float lo, float hi) { unsigned r; asm volatile("v_cvt_pk_bf16_f32 %0, %1, %2" : "=v"(r) : "v"(lo), "v"(hi)); return r; }

struct EpiF32 {
    static constexpr bool PERM = false, HAS_MID = false;
    float* C; int ldc;
    __device__ __forceinline__ void operator()(const f32x4 (&acc)[2][2][4][2], const Unit& u, int wr, int wc, int fr, int fq) const {
        const int row0 = wr * 64 + fr, col0 = u.oc0 + wc * 32 + 4 * fq;
#pragma unroll
        for (int ai = 0; ai < 2; ++ai)
#pragma unroll
            for (int m = 0; m < 4; ++m) { const int r = row0 + ai * HALF + m * 16; if (r < u.nrows) { float* rowp = C + (size_t)(u.o0 + r) * ldc + col0;
#pragma unroll
                for (int bj = 0; bj < 2; ++bj)
#pragma unroll
                    for (int n = 0; n < 2; ++n) *(f32x4*)(rowp + bj * HALF + n * 16) = acc[ai][bj][m][n]; } }
    }
};
struct EpiBf16 {
    static constexpr bool PERM = true, HAS_MID = false;
    bf16* O; int ldc;
    __device__ __forceinline__ void operator()(const f32x4 (&acc)[2][2][4][2], const Unit& u, int wr, int wc, int fr, int fq) const {
        const int row0 = wr * 64 + fr, col0 = u.oc0 + wc * 32 + 8 * fq;
#pragma unroll
        for (int ai = 0; ai < 2; ++ai)
#pragma unroll
            for (int m = 0; m < 4; ++m) { const int r = row0 + ai * HALF + m * 16; if (r < u.nrows) { bf16* rowp = O + (size_t)(u.o0 + r) * ldc + col0;
#pragma unroll
                for (int bj = 0; bj < 2; ++bj) { const f32x4 v0 = acc[ai][bj][m][0], v1 = acc[ai][bj][m][1];
                    v4u w; w.x = cvt_pk_bf16(v0[0], v0[1]); w.y = cvt_pk_bf16(v0[2], v0[3]); w.z = cvt_pk_bf16(v1[0], v1[1]); w.w = cvt_pk_bf16(v1[2], v1[3]);
                    *(v4u*)(rowp + bj * HALF) = w; } } }
    }
};
struct EpiZ {
    static constexpr bool PERM = true, HAS_MID = false;
    bf16* ZC;
    __device__ __forceinline__ void operator()(const f32x4 (&acc)[2][2][4][2], const Unit& u, int wr, int wc, int fr, int fq) const {
        const int seg = (u.oc0 < 1024) ? 0 : (u.oc0 < 2816) ? 1 : 2;
        const int ldc = (seg == 0) ? 1024 : (seg == 1) ? 1792 : 2048, c0 = u.oc0 - ((seg == 0) ? 0 : (seg == 1) ? 1024 : 2816);
        bf16* O = ZC + ((seg == 0) ? (size_t)0 : (seg == 1) ? (size_t)M * 1024 : (size_t)M * (1024 + 1792));
        const int row0 = u.o0 + wr * 64 + fr, col0 = c0 + wc * 32 + 8 * fq;
#pragma unroll
        for (int ai = 0; ai < 2; ++ai)
#pragma unroll
            for (int m = 0; m < 4; ++m) { bf16* rowp = O + (size_t)(row0 + ai * HALF + m * 16) * ldc + col0;
#pragma unroll
                for (int bj = 0; bj < 2; ++bj) { const f32x4 v0 = acc[ai][bj][m][0], v1 = acc[ai][bj][m][1];
                    v4u w; w.x = cvt_pk_bf16(v0[0], v0[1]); w.y = cvt_pk_bf16(v0[2], v0[3]); w.z = cvt_pk_bf16(v1[0], v1[1]); w.w = cvt_pk_bf16(v1[2], v1[3]);
                    *(v4u*)(rowp + bj * HALF) = w; } }
    }
};
template <bool FIRST> struct EpiMerge {
    static constexpr bool PERM = true, HAS_MID = false;
    bf16* O; const bf16* Z; int gcol0;
    __device__ __forceinline__ void operator()(const f32x4 (&acc)[2][2][4][2], const Unit& u, int wr, int wc, int fr, int fq) const {
        const int row0 = u.o0 + wr * 64 + fr, col0 = u.oc0 + wc * 32 + 8 * fq;
#pragma unroll
        for (int ai = 0; ai < 2; ++ai)
#pragma unroll
            for (int m = 0; m < 4; ++m) { const int r = row0 + ai * HALF + m * 16; bf16* rowp = O + (size_t)r * D + col0; const bf16* zp = Z + (size_t)r * 2048 + gcol0 + col0;
#pragma unroll
                for (int bj = 0; bj < 2; ++bj) { const v4u g = *(const v4u*)(zp + bj * HALF); const f32x4 a0 = acc[ai][bj][m][0], a1 = acc[ai][bj][m][1];
                    float o[8];
                    o[0] = a0[0] * sigmoidf_(bflo(g.x)); o[1] = a0[1] * sigmoidf_(bfhi(g.x)); o[2] = a0[2] * sigmoidf_(bflo(g.y)); o[3] = a0[3] * sigmoidf_(bfhi(g.y));
                    o[4] = a1[0] * sigmoidf_(bflo(g.z)); o[5] = a1[1] * sigmoidf_(bfhi(g.z)); o[6] = a1[2] * sigmoidf_(bflo(g.w)); o[7] = a1[3] * sigmoidf_(bfhi(g.w));
                    if (!FIRST) { const v4u p = *(const v4u*)(rowp + bj * HALF);
                        o[0] += bflo(p.x); o[1] += bfhi(p.x); o[2] += bflo(p.y); o[3] += bfhi(p.y); o[4] += bflo(p.z); o[5] += bfhi(p.z); o[6] += bflo(p.w); o[7] += bfhi(p.w); }
                    v4u w; w.x = cvt_pk_bf16(o[0], o[1]); w.y = cvt_pk_bf16(o[2], o[3]); w.z = cvt_pk_bf16(o[4], o[5]); w.w = cvt_pk_bf16(o[6], o[7]);
                    *(v4u*)(rowp + bj * HALF) = w; } }
    }
};
struct EpiMerge2 {
    static constexpr bool PERM = true, HAS_MID = true;
    bf16* O; const bf16* ZG;
    __device__ __forceinline__ void mid(f32x4 (&acc)[2][2][4][2], const Unit& u, int wr, int wc, int fr, int fq) const {
        const int row0 = u.o0 + wr * 64 + fr, col0 = u.oc0 + wc * 32 + 8 * fq;
#pragma unroll
        for (int ai = 0; ai < 2; ++ai)
#pragma unroll
            for (int m = 0; m < 4; ++m) { const bf16* zp = ZG + (size_t)(row0 + ai * HALF + m * 16) * 2048 + col0;
#pragma unroll
                for (int bj = 0; bj < 2; ++bj) { const v4u g1 = *(const v4u*)(zp + bj * HALF), g2 = *(const v4u*)(zp + 1024 + bj * HALF);
#define RT_(a, b) ((1.0f + __expf(-(b))) * __builtin_amdgcn_rcpf(1.0f + __expf(-(a))))
                    acc[ai][bj][m][0][0] *= RT_(bflo(g1.x), bflo(g2.x)); acc[ai][bj][m][0][1] *= RT_(bfhi(g1.x), bfhi(g2.x)); acc[ai][bj][m][0][2] *= RT_(bflo(g1.y), bflo(g2.y)); acc[ai][bj][m][0][3] *= RT_(bfhi(g1.y), bfhi(g2.y));
                    acc[ai][bj][m][1][0] *= RT_(bflo(g1.z), bflo(g2.z)); acc[ai][bj][m][1][1] *= RT_(bfhi(g1.z), bfhi(g2.z)); acc[ai][bj][m][1][2] *= RT_(bflo(g1.w), bflo(g2.w)); acc[ai][bj][m][1][3] *= RT_(bfhi(g1.w), bfhi(g2.w));
#undef RT_
                } }
    }
    __device__ __forceinline__ void operator()(const f32x4 (&acc)[2][2][4][2], const Unit& u, int wr, int wc, int fr, int fq) const {
        const int row0 = u.o0 + wr * 64 + fr, col0 = u.oc0 + wc * 32 + 8 * fq;
#pragma unroll
        for (int ai = 0; ai < 2; ++ai)
#pragma unroll
            for (int m = 0; m < 4; ++m) { const int r = row0 + ai * HALF + m * 16; bf16* rowp = O + (size_t)r * D + col0; const bf16* zp = ZG + (size_t)r * 2048 + 1024 + col0;
#pragma unroll
                for (int bj = 0; bj < 2; ++bj) { const v4u g = *(const v4u*)(zp + bj * HALF); const f32x4 a0 = acc[ai][bj][m][0], a1 = acc[ai][bj][m][1];
                    v4u w; w.x = cvt_pk_bf16(a0[0] * sigmoidf_(bflo(g.x)), a0[1] * sigmoidf_(bfhi(g.x))); w.y = cvt_pk_bf16(a0[2] * sigmoidf_(bflo(g.y)), a0[3] * sigmoidf_(bfhi(g.y)));
                    w.z = cvt_pk_bf16(a1[0] * sigmoidf_(bflo(g.z)), a1[1] * sigmoidf_(bfhi(g.z))); w.w = cvt_pk_bf16(a1[2] * sigmoidf_(bflo(g.w)), a1[3] * sigmoidf_(bfhi(g.w)));
                    *(v4u*)(rowp + bj * HALF) = w; } }
    }
};
struct EpiFp8 {
    static constexpr bool PERM = true, HAS_MID = false;
    unsigned char* O; int ldc;
    __device__ __forceinline__ void operator()(const f32x4 (&acc)[2][2][4][2], const Unit& u, int wr, int wc, int fr, int fq) const {
        const int row0 = wr * 64 + fr, col0 = u.oc0 + wc * 32 + 8 * fq;
#pragma unroll
        for (int ai = 0; ai < 2; ++ai)
#pragma unroll
            for (int m = 0; m < 4; ++m) { const int r = row0 + ai * HALF + m * 16; if (r < u.nrows) { unsigned char* rowp = O + (size_t)(u.o0 + r) * ldc + col0;
#pragma unroll
                for (int bj = 0; bj < 2; ++bj) { const f32x4 v0 = acc[ai][bj][m][0], v1 = acc[ai][bj][m][1]; int w0 = 0, w1 = 0;
                    w0 = __builtin_amdgcn_cvt_pk_fp8_f32(v0[0], v0[1], w0, false); w0 = __builtin_amdgcn_cvt_pk_fp8_f32(v0[2], v0[3], w0, true);
                    w1 = __builtin_amdgcn_cvt_pk_fp8_f32(v1[0], v1[1], w1, false); w1 = __builtin_amdgcn_cvt_pk_fp8_f32(v1[2], v1[3], w1, true);
                    v2u w; w.x = (unsigned)w0; w.y = (unsigned)w1; *(v2u*)(rowp + bj * HALF) = w; } } }
    }
};
struct EpiSwiGLU {
    static constexpr bool PERM = true, HAS_MID = false;
    bf16* O;
    __device__ __forceinline__ void operator()(const f32x4 (&acc)[2][2][4][2], const Unit& u, int wr, int wc, int fr, int fq) const {
        const int row0 = wr * 64 + fr, col0 = (u.oc0 >> 1) + wc * 32 + 8 * fq;
#pragma unroll
        for (int ai = 0; ai < 2; ++ai)
#pragma unroll
            for (int m = 0; m < 4; ++m) { const int r = row0 + ai * HALF + m * 16; if (r < u.nrows) { bf16* rowp = O + (size_t)(u.o0 + r) * DE + col0;
                const f32x4 g0 = acc[ai][0][m][0], g1 = acc[ai][0][m][1], u0 = acc[ai][1][m][0], u1 = acc[ai][1][m][1];
                v4u w; w.x = cvt_pk_bf16(siluf_(g0[0]) * u0[0], siluf_(g0[1]) * u0[1]); w.y = cvt_pk_bf16(siluf_(g0[2]) * u0[2], siluf_(g0[3]) * u0[3]);
                w.z = cvt_pk_bf16(siluf_(g1[0]) * u1[0], siluf_(g1[1]) * u1[1]); w.w = cvt_pk_bf16(siluf_(g1[2]) * u1[2], siluf_(g1[3]) * u1[3]);
                *(v4u*)rowp = w; } }
    }
};

constexpr int ROWTAB_OFF = 131072 + 11264, MAXU = 8;
template <class Epi, class Sched, bool GATHER>
__device__ __forceinline__ void gemm_phase(LAS unsigned char* lds, const int tid, const Gemm g, const Sched& S, const Epi& E) {
    const int wid = __builtin_amdgcn_readfirstlane(tid >> 6), lane = tid & 63, wr = wid >> 2, wc = wid & 3, fr = lane & 15, fq = lane >> 4;
    const int K = g.K, nt = K / BK;
    int sR, sC; stage_rc(tid * 16, sR, sC);
    const unsigned voffA = (unsigned)(sR * K + sC) * 2u;
    const unsigned voffB = (unsigned)((Epi::PERM ? ((sR & ~31) + perm32(sR & 31)) : sR) * K + sC) * 2u;
    const size_t kstep = (size_t)(BK * 2);
    const size_t pstep = (size_t)64 * K * 2;
    const size_t hstep = (size_t)HALF * K * 2;
    const unsigned ldsw = (unsigned)wid * 1024u;
    const int aoff = lds_byte(wr * 64 + fr, fq * 8), boff = lds_byte(wc * 32 + fr, fq * 8);
    LAS unsigned* rowtab = (LAS unsigned*)(lds + ROWTAB_OFF);
#define PG8_SA(b, h) (((b) * 2 + (h)) * HTB)
#define PG8_SB(b, h) ((4 + (b) * 2 + (h)) * HTB)
#define PG8_STAGE(bufoff, gbase, voff) do { _Pragma("unroll") for (int _i = 0; _i < 2; ++_i) { const char* _gb = (const char*)(gbase) + _i * pstep; asm volatile("" : "+s"(_gb));   \
        __builtin_amdgcn_global_load_lds((const unsigned*)(_gb + (voff)), (LAS unsigned*)(lds + (bufoff) + ldsw + _i * 8192), 16, 0, 0); } } while (0)
#define PG8_STAGE_G(bufoff, kb, sel, h) do { _Pragma("unroll") for (int _i = 0; _i < 2; ++_i) { const unsigned _ro = rowtab[(sel) * 256 + (h) * HALF + sR + 64 * _i] + (unsigned)(sC * 2); const char* _gb = (const char*)(kb); asm volatile("" : "+s"(_gb)); \
        __builtin_amdgcn_global_load_lds((const unsigned*)(_gb + _ro), (LAS unsigned*)(lds + (bufoff) + ldsw + _i * 8192), 16, 0, 0); } } while (0)
#define PG8_STAGE_A(bufoff, basep, kb, sel, h) do { if constexpr (GATHER) PG8_STAGE_G(bufoff, (const char*)g.A + (kb), sel, h); else PG8_STAGE(bufoff, (basep) + (kb) + (h) * hstep, voffA); } while (0)
#define PG8_ROWTAB(sel, u) do { if (tid < 256) { const int _rr = tid < (u).nrows ? tid : (u).nrows - 1; rowtab[(sel) * 256 + tid] = (unsigned)g.list[(u).x0 + _rr] * (unsigned)(K * 2); } } while (0)
#define PG8_LDA(dst, b, h) do { _Pragma("unroll") for (int m = 0; m < 4; ++m) _Pragma("unroll") for (int k = 0; k < 2; ++k) dst[m][k] = *(const LAS bf16x8*)(lds + PG8_SA(b, h) + aoff + m * 2048 + k * 1024); } while (0)
#define PG8_LDB(dst, b, h) do { _Pragma("unroll") for (int n = 0; n < 2; ++n) _Pragma("unroll") for (int k = 0; k < 2; ++k) dst[n][k] = *(const LAS bf16x8*)(lds + PG8_SB(b, h) + boff + n * 2048 + k * 1024); } while (0)
#define PG8_MMA(ai, bj, At, Bt) do { __builtin_amdgcn_s_setprio(1); _Pragma("unroll") for (int m = 0; m < 4; ++m) _Pragma("unroll") for (int n = 0; n < 2; ++n) _Pragma("unroll") for (int k = 0; k < 2; ++k) \
        acc[ai][bj][m][n] = __builtin_amdgcn_mfma_f32_16x16x32_bf16(Bt[n][k], At[m][k], acc[ai][bj][m][n], 0, 0, 0); __builtin_amdgcn_s_setprio(0); } while (0)
#define PG8_WAIT_V(n) asm volatile("s_waitcnt vmcnt(" #n ")" ::: "memory")
#define PG8_WAIT_L(n) asm volatile("s_waitcnt lgkmcnt(" #n ")" ::: "memory")
#define PG8_BAR __builtin_amdgcn_s_barrier()
#define PG8_SCHED __builtin_amdgcn_sched_barrier(0)
    Unit cur, nxt; int ui = 0;
    if (!S.next(0, cur)) return;
    f32x4 acc[2][2][4][2];
#pragma unroll
    for (int a = 0; a < 2; ++a)
#pragma unroll
        for (int b = 0; b < 2; ++b)
#pragma unroll
            for (int m = 0; m < 4; ++m)
#pragma unroll
                for (int n = 0; n < 2; ++n) acc[a][b][m][n] = (f32x4){0.f, 0.f, 0.f, 0.f};
    bf16x8 At[4][2], B0[2][2], B1[2][2];
    int par = 0;
    if constexpr (GATHER) {
        Unit uu = cur; for (int q = 0; q < MAXU; ++q) { PG8_ROWTAB(q, uu); if (!S.next(q + 1, uu)) break; }
        asm volatile("s_waitcnt vmcnt(0) lgkmcnt(0)" ::: "memory"); __syncthreads(); }
    const char* cA = (const char*)g.A + (size_t)cur.a0 * K * 2;
    const char* cB = (const char*)g.Bt + (size_t)cur.b0 * K * 2;
    PG8_STAGE(PG8_SB(0, 0), cB, voffB); PG8_STAGE(PG8_SB(0, 1), cB + hstep, voffB); PG8_STAGE_A(PG8_SA(0, 0), cA, 0, 0, 0); PG8_STAGE_A(PG8_SA(0, 1), cA, 0, 0, 1);
    if (wr == 1) PG8_BAR;
    PG8_WAIT_V(2); PG8_BAR;
    PG8_STAGE(PG8_SB(1, 0), cB + kstep, voffB); PG8_STAGE_A(PG8_SA(1, 0), cA, kstep, 0, 0); PG8_STAGE(PG8_SB(1, 1), cB + hstep + kstep, voffB);
    PG8_WAIT_V(6); PG8_BAR;
    for (;;) {
        const bool has_next = S.next(ui + 1, nxt);
        const char* nA = has_next ? (const char*)g.A + (size_t)nxt.a0 * K * 2 : cA;
        const char* nB = has_next ? (const char*)g.Bt + (size_t)nxt.b0 * K * 2 : cB;
        const int npar = has_next ? (par + 1) : par;
        for (int t = 0; t < nt; t += 2) {
            if constexpr (Epi::HAS_MID) { if (t == nt / 2) E.mid(acc, cur, wr, wc, fr, fq); }
            const bool last = (t == nt - 2);
            const size_t k1 = (size_t)(t + 1) * kstep;
            const char* a2 = last ? nA : cA; const size_t k2 = last ? 0 : (size_t)(t + 2) * kstep; const char* b2 = last ? nB : cB + (size_t)(t + 2) * kstep;
            const size_t k3 = k2 + kstep; const char* b3 = b2 + kstep;
            const int p2 = last ? npar : par;
            PG8_LDB(B0, 0, 0); PG8_LDB(B1, 0, 1); PG8_SCHED; PG8_LDA(At, 0, 0); PG8_STAGE_A(PG8_SA(1, 1), cA, k1, par, 1);
            PG8_WAIT_V(8); PG8_WAIT_L(0); PG8_BAR; PG8_MMA(0, 0, At, B0); PG8_MMA(0, 1, At, B1); PG8_BAR; PG8_SCHED;
            PG8_LDA(At, 0, 1); PG8_STAGE(PG8_SB(0, 0), b2, voffB); PG8_STAGE(PG8_SB(0, 1), b2 + hstep, voffB); PG8_STAGE_A(PG8_SA(0, 0), a2, k2, p2, 0);
            PG8_WAIT_V(8); PG8_WAIT_L(0); PG8_BAR; PG8_MMA(1, 0, At, B0); PG8_MMA(1, 1, At, B1); PG8_BAR; PG8_SCHED;
            PG8_LDB(B0, 1, 0); PG8_LDB(B1, 1, 1); PG8_SCHED; PG8_LDA(At, 1, 0); PG8_STAGE_A(PG8_SA(0, 1), a2, k2, p2, 1);
            PG8_WAIT_V(8); PG8_WAIT_L(0); PG8_BAR; PG8_MMA(0, 0, At, B0); PG8_MMA(0, 1, At, B1); PG8_BAR; PG8_SCHED;
            PG8_LDA(At, 1, 1); PG8_STAGE(PG8_SB(1, 0), b3, voffB); PG8_STAGE(PG8_SB(1, 1), b3 + hstep, voffB); PG8_STAGE_A(PG8_SA(1, 0), a2, k3, p2, 0);
            PG8_WAIT_V(8); PG8_WAIT_L(0); PG8_BAR; PG8_MMA(1, 0, At, B0); PG8_MMA(1, 1, At, B1); PG8_BAR; PG8_SCHED;
        }
        if (wr == 0) PG8_BAR;
        E(acc, cur, wr, wc, fr, fq);
        if (!has_next) break;
#pragma unroll
        for (int a = 0; a < 2; ++a)
#pragma unroll
            for (int b = 0; b < 2; ++b)
#pragma unroll
                for (int m = 0; m < 4; ++m)
#pragma unroll
                    for (int n = 0; n < 2; ++n) acc[a][b][m][n] = (f32x4){0.f, 0.f, 0.f, 0.f};
        cur = nxt; cA = nA; cB = nB; par = npar; ++ui;
        if (wr == 1) PG8_BAR;
    }
    PG8_WAIT_V(0);
    PG8_BAR;
#undef PG8_SA
#undef PG8_SB
#undef PG8_STAGE
#undef PG8_STAGE_G
#undef PG8_STAGE_A
#undef PG8_ROWTAB
#undef PG8_LDA
#undef PG8_LDB
#undef PG8_MMA
#undef PG8_WAIT_V
#undef PG8_WAIT_L
#undef PG8_BAR
#undef PG8_SCHED
}
}

#define XB_TMO      128
#define XB_XCNT(j)  (256  + 64 * (j))
#define XB_XSUB(j)  (1280 + 64 * (j))
#define XB_XGEN(j)  (2304 + 64 * (j))
#define XB_TOP      3328
#define XB_TOPGEN   3392
#define XCD_BAR_WORDS 3456
#define XB_SPIN_CAP (1u << 18)
__device__ __forceinline__ unsigned xb_ld(unsigned* p)              { return __hip_atomic_load(p, __ATOMIC_RELAXED, __HIP_MEMORY_SCOPE_AGENT); }
__device__ __forceinline__ unsigned xb_add(unsigned* p, unsigned v) { return __hip_atomic_fetch_add(p, v, __ATOMIC_RELAXED, __HIP_MEMORY_SCOPE_AGENT); }
__device__ __forceinline__ unsigned xb_xcc_id() { return (unsigned)__builtin_amdgcn_s_getreg((3 << 11) | 20) & 0xFu; }
#define XB_SPIN(cond, bar) do { unsigned _sp = 0; while (cond) { __builtin_amdgcn_s_sleep(1); \
    if ((++_sp & 255u) == 0u) { if (xb_ld(&(bar)[XB_TMO])) break; if (_sp > XB_SPIN_CAP) { atomicAdd(&(bar)[XB_TMO], 1u); break; } } } } while (0)
struct XcdBarrier { unsigned* bar; unsigned x; volatile LAS unsigned* st; };
__device__ __forceinline__ XcdBarrier xcd_barrier_post(unsigned* bar, volatile LAS unsigned* st) {
    XcdBarrier b; b.bar = bar; b.x = xb_xcc_id(); b.st = st;
    if (threadIdx.x == 0) (void)xb_add(&bar[XB_XCNT(b.x)], 1u);
    return b;
}
__device__ __forceinline__ void xcd_barrier_complete(unsigned* bar, unsigned x, unsigned& nloc, unsigned& nx) {
    const unsigned G = gridDim.x * gridDim.y * gridDim.z;
    unsigned sum, cnt, mine, sp = 0u;
    for (;;) {
        sum = 0u; cnt = 0u; mine = 0u;
#pragma unroll
        for (unsigned j = 0; j < 16; ++j) { const unsigned c = xb_ld(&bar[XB_XCNT(j)]); sum += c; cnt += (c > 0u) ? 1u : 0u; mine = (j == x) ? c : mine; }
        if (sum == G) break;
        __builtin_amdgcn_s_sleep(1);
        if ((++sp & 255u) == 0u) { if (xb_ld(&bar[XB_TMO])) break; if (sp > XB_SPIN_CAP) { atomicAdd(&bar[XB_TMO], 1u); break; } }
    }
    nloc = mine > 0u ? mine : 1u; nx = cnt > 0u ? cnt : 1u;
}
__device__ __forceinline__ void xcd_barrier(const XcdBarrier& b, const int tid) {
    asm volatile("s_waitcnt vmcnt(0)" ::: "memory");
    __syncthreads();
    if (tid == 0) {
        unsigned* bar = b.bar;
        __builtin_amdgcn_s_waitcnt(0);
        unsigned nloc = b.st[0], nx = b.st[1];
        if (nloc == 0u) { xcd_barrier_complete(bar, b.x, nloc, nx); b.st[0] = nloc; b.st[1] = nx; }
        const unsigned old = xb_add(&bar[XB_XSUB(b.x)], 1u);
        const unsigned gen = old / nloc;
        if (old + 1u == (gen + 1u) * nloc) {
            __builtin_amdgcn_fence(__ATOMIC_RELEASE, "agent");
            asm volatile("s_waitcnt vmcnt(0)" ::: "memory");
            const unsigned og = xb_add(&bar[XB_TOP], 1u);
            const unsigned tgt = (og / nx + 1u) * nx;
            if (og + 1u != tgt) XB_SPIN((int)(xb_ld(&bar[XB_TOP]) - tgt) < 0, bar);
            __builtin_amdgcn_fence(__ATOMIC_ACQUIRE, "agent");
            xb_add(&bar[XB_XGEN(b.x)], 1u);
            asm volatile("s_waitcnt vmcnt(0)" ::: "memory");
        } else {
            XB_SPIN(xb_ld(&bar[XB_XGEN(b.x)]) == gen, bar);
            __builtin_amdgcn_fence(__ATOMIC_ACQUIRE, "agent");
            asm volatile("s_waitcnt vmcnt(0)" ::: "memory");
        }
    }
    __syncthreads();
}

struct Args { const float* in[N_IN]; float* out; unsigned char* ws; int ph_lo, ph_hi; };
struct Frame {
    LAS unsigned char* lds;
    int tid, lane, wave, G, bid;
    const float* const __attribute__((address_space(4)))* in; GAS float* out; GAS unsigned char* ws;
};
__device__ __forceinline__ const float* mod_ptr(const Frame& F, int l, int b, int part) { return (const float*)(F.ws + WS_MOD) + ((size_t)(l * NB + b) * 6 + part) * D; }

__device__ __forceinline__ void transpose_item(const float* W, int N, int k0, int n0, bf16* WT, int ldo, int drow0, int dcol0, LAS float* scr, int lane) {
    float tv[32];
#pragma unroll
    for (int i = 0; i < 32; ++i) tv[i] = W[(size_t)(k0 + 2 * i + (lane >> 5)) * N + n0 + (lane & 31)];
#pragma unroll
    for (int i = 0; i < 32; ++i) scr[(2 * i + (lane >> 5)) * 33 + (lane & 31)] = tv[i];
    LDS_WAIT(); asm volatile("" ::: "memory");
    const int c = lane & 7;
#pragma unroll
    for (int j = 0; j < 4; ++j) { const int n = (lane >> 3) + 8 * j; const LAS float* s = scr + (8 * c) * 33 + n;
        v4u o; o.x = pk2(s[0 * 33], s[1 * 33]); o.y = pk2(s[2 * 33], s[3 * 33]); o.z = pk2(s[4 * 33], s[5 * 33]); o.w = pk2(s[6 * 33], s[7 * 33]);
        *(GAS v4u*)(WT + (size_t)(drow0 + n) * ldo + dcol0 + k0 + 8 * c) = o; }
    LDS_WAIT(); asm volatile("" ::: "memory");
}
struct EwItem { const float* src; bf16* dst; int N, ldo; };
__device__ __forceinline__ void ew_load(const EwItem& q, f32x4 (&tv)[16], int lane) {
#pragma unroll
    for (int i = 0; i < 16; ++i) tv[i] = *(const f32x4*)(q.src + (size_t)(4 * i + (lane >> 4)) * q.N + 4 * (lane & 15));
}
__device__ __forceinline__ void ew_finish(const EwItem& q, const f32x4 (&tv)[16], LAS float* scr, int lane) {
#pragma unroll
    for (int i = 0; i < 16; ++i) { LAS float* d = scr + (4 * i + (lane >> 4)) * 65 + 4 * (lane & 15); d[0] = tv[i][0]; d[1] = tv[i][1]; d[2] = tv[i][2]; d[3] = tv[i][3]; }
    LDS_WAIT(); asm volatile("" ::: "memory");
    const int c = lane & 7;
#pragma unroll
    for (int j = 0; j < 8; ++j) { const int n = (lane >> 3) + 8 * j; const LAS float* sp = scr + (8 * c) * 65 + n;
        v4u o; o.x = pk2(sp[0 * 65], sp[1 * 65]); o.y = pk2(sp[2 * 65], sp[3 * 65]); o.z = pk2(sp[4 * 65], sp[5 * 65]); o.w = pk2(sp[6 * 65], sp[7 * 65]);
        __builtin_nontemporal_store(o, (GAS v4u*)(q.dst + (size_t)n * q.ldo + 8 * c)); }
    LDS_WAIT(); asm volatile("" ::: "memory");
}
__device__ __forceinline__ int titems(int K, int N) { return (K / 64) * (N / 32); }
__device__ __forceinline__ void tdo(const float* W, int K, int N, int item, bf16* WT, int ldo, int drow0, LAS float* scr, int lane) {
    const int nblk = N / 32, kb = item / nblk, nb = item % nblk; transpose_item(W, N, 64 * kb, 32 * nb, WT, ldo, drow0 + 32 * nb, 0, scr, lane);
}

__device__ __forceinline__ void phase_mix_weights(Frame& F, int gw, int NGW, const int l0, const int l1, const int scr_off) {
    LAS float* scr = (LAS float*)(F.lds + scr_off);
    constexpr int T_WIN = (D / 64) * (DIN / 32), T_PC = (CW / 64) * (D / 32), T_PR = (RW / 64) * (D / 32), T_WO = (D / 64) * (D / 32), T_L = T_WIN + T_PC + T_PR + T_WO;
    for (int it = l0 * T_L + gw; it < l1 * T_L; it += NGW) {
        const int l = it / T_L; int r = it % T_L; GAS unsigned char* wm = F.ws + WS_WMIX + (size_t)l * WMIX_STRIDE;
        if (r < T_WIN) { tdo(F.in[I_WIN] + (size_t)l * D * DIN, D, DIN, r, (bf16*)(wm + WM_WIN), D, 0, scr, F.lane); continue; } r -= T_WIN;
        if (r < T_PC) { tdo(F.in[I_PCONV] + (size_t)l * CW * D, CW, D, r, (bf16*)(wm + WM_PCONV), D, 0, scr, F.lane); continue; } r -= T_PC;
        if (r < T_PR) { tdo(F.in[I_PRWKV] + (size_t)l * RW * D, RW, D, r, (bf16*)(wm + WM_PCONV) + CW, D, 0, scr, F.lane); continue; } r -= T_PR;
        tdo(F.in[I_WO] + (size_t)l * D * D, D, D, r, (bf16*)(wm + WM_WO), D, 0, scr, F.lane);
    }
    for (int i = l0 * NE * D + gw * 64 + F.lane; i < l1 * NE * D; i += NGW * 64) { const int l = i / (NE * D), r = i % (NE * D), e = r / D, k = r % D;
        const float v = F.in[I_WROUTER][((size_t)l * D + k) * NE + e]; const unsigned hi = f2bf(v); GAS unsigned char* wm = F.ws + WS_WMIX + (size_t)l * WMIX_STRIDE;
        ((bf16*)(wm + WM_RHI))[r] = (bf16)hi; ((bf16*)(wm + WM_RLO))[r] = (bf16)f2bf(v - bf2f(hi)); }
    for (int i = l0 * NLORA * KLORA + gw * 64 + F.lane; i < l1 * NLORA * KLORA; i += NGW * 64) {
        const int l = i / (NLORA * KLORA), r = i % (NLORA * KLORA), n = r / KLORA, k = r % KLORA; float v = 0.f;
        if (n < 512) { if (k < 64) v = F.in[I_W2][((size_t)l * LW + k) * RW + n]; }
        else if (n < 1024) { if (k >= 64 && k < 128) v = F.in[I_A2][((size_t)l * LA + (k - 64)) * RW + (n - 512)]; }
        else { if (k >= 128) v = F.in[I_G2][((size_t)l * LG + (k - 128)) * RW + (n - 1024)]; }
        ((bf16*)(F.ws + WS_WMIX + (size_t)l * WMIX_STRIDE + WM_LORA))[r] = (bf16)f2bf(v);
    }
}
constexpr int EW_ITEMS = (NE + 1) * 192, EW_A = 2688, EW_B = 2688 + 2048;
__device__ __forceinline__ EwItem ew_item(const Frame& F, int l, int it) {
    constexpr int T_G = (D / 64) * (DE / 64), T_D = (DE / 64) * (D / 64), T_E = 2 * T_G + T_D;
    static_assert((NE + 1) * T_E == EW_ITEMS, "items");
    bf16* WGU = (bf16*)(F.ws + WS_WGU); bf16* WDN = (bf16*)(F.ws + WS_WDN);
    const int e = it / T_E; int r = it % T_E; EwItem q;
    if (r < 2 * T_G) { const int up = r >= T_G; if (up) r -= T_G;
        const float* W = (e < NE) ? (up ? F.in[I_WEU] : F.in[I_WEG]) + ((size_t)l * NE + e) * D * DE : (up ? F.in[I_WSU] : F.in[I_WSG]) + (size_t)l * D * DE;
        const int nblk = DE / 64, kb = r / nblk, nb = r % nblk, n0 = 64 * nb;
        const int drow0 = e * 512 + (n0 >> 7) * 256 + (up ? 128 : 0) + (n0 & 127);
        q.src = W + (size_t)(64 * kb) * DE + n0; q.N = DE; q.dst = WGU + (size_t)drow0 * D + 64 * kb; q.ldo = D;
    } else { r -= 2 * T_G;
        const float* W = (e < NE) ? F.in[I_WED] + ((size_t)l * NE + e) * DE * D : F.in[I_WSD] + (size_t)l * DE * D;
        const int nblk = D / 64, kb = r / nblk, nb = r % nblk;
        q.src = W + (size_t)(64 * kb) * D + 64 * nb; q.N = D; q.dst = WDN + (size_t)(e * D + 64 * nb) * DE + 64 * kb; q.ldo = DE;
    }
    return q;
}
__device__ __forceinline__ void phase_expert_weights(Frame& F, int l, int gw, int NGW, const int scr_off = 0, const int it0 = 0, const int it1 = EW_ITEMS) {
    LAS float* scr = (LAS float*)(F.lds + scr_off + F.wave * 16640);
    int it = it0 + gw; if (it >= it1) return;
    f32x4 ta[16], tb[16]; EwItem qa = ew_item(F, l, it), qb = qa;
    ew_load(qa, ta, F.lane);
    for (;;) {
        const bool hb = it + NGW < it1; if (hb) { qb = ew_item(F, l, it + NGW); ew_load(qb, tb, F.lane); }
        ew_finish(qa, ta, scr, F.lane);
        if (!hb) break;
        it += NGW;
        const bool ha = it + NGW < it1; if (ha) { qa = ew_item(F, l, it + NGW); ew_load(qa, ta, F.lane); }
        ew_finish(qb, tb, scr, F.lane);
        if (!ha) break;
        it += NGW;
    }
}
__device__ __forceinline__ void phase_ada(Frame& F) {
    LAS float* sc = (LAS float*)F.lds;
    LAS float* red = (LAS float*)(F.lds + 32768);
    for (int i = F.tid; i < NB * D; i += NTHREADS) { const int b = i / D, k = i % D; sc[k * 8 + b] = siluf_(F.in[I_C][i]); }
    __syncthreads();
    float* mod = (float*)(F.ws + WS_MOD);
    for (int it = F.bid; it < DEPTH * 96; it += F.G) {
        const int l = it / 96, n0 = (it % 96) * 64;
        float acc[8];
#pragma unroll
        for (int b = 0; b < 8; ++b) acc[b] = 0.f;
        const float* wp = F.in[I_WADA] + ((size_t)l * D + F.wave * 128) * (6 * D) + n0 + F.lane;
#pragma unroll 32
        for (int k = 0; k < 128; ++k) { const float wv = wp[(size_t)k * (6 * D)]; const LAS f32x4* s = (const LAS f32x4*)(sc + (F.wave * 128 + k) * 8); const f32x4 s0 = s[0], s1 = s[1];
            acc[0] += s0[0] * wv; acc[1] += s0[1] * wv; acc[2] += s0[2] * wv; acc[3] += s0[3] * wv; acc[4] += s1[0] * wv; acc[5] += s1[1] * wv; acc[6] += s1[2] * wv; acc[7] += s1[3] * wv; }
#pragma unroll
        for (int b = 0; b < 8; ++b) red[(F.wave * 8 + b) * 64 + F.lane] = acc[b];
        __syncthreads();
        { const int b = F.tid >> 6; float s = F.in[I_BADA][(size_t)l * 6 * D + n0 + F.lane];
#pragma unroll
          for (int w = 0; w < 8; ++w) s += red[(w * 8 + b) * 64 + F.lane];
          mod[((size_t)l * NB + b) * 6 * D + n0 + F.lane] = s; }
        __syncthreads();
    }
}

struct Row { f32x4 v[4]; };
__device__ __forceinline__ Row row_load(const float* p, int lane) { Row r; const f32x4* q = (const f32x4*)p + lane;
#pragma unroll
    for (int j = 0; j < 4; ++j) r.v[j] = q[64 * j]; return r; }
__device__ __forceinline__ void row_store(float* p, int lane, const Row& r) { f32x4* q = (f32x4*)p + lane;
#pragma unroll
    for (int j = 0; j < 4; ++j) q[64 * j] = r.v[j]; }
__device__ __forceinline__ float row_sumsq(const Row& r) { float s = 0.f;
#pragma unroll
    for (int j = 0; j < 4; ++j) s += (r.v[j][0] * r.v[j][0] + r.v[j][1] * r.v[j][1]) + (r.v[j][2] * r.v[j][2] + r.v[j][3] * r.v[j][3]); return wave_sum(s); }
__device__ __forceinline__ Row row_modnorm(const Row& x, const float* g, const float* sc, const float* sh, int lane) {
    const float rs = rsqrtf(row_sumsq(x) * (1.0f / D) + RMS_EPS); Row gg = row_load(g, lane), s1 = row_load(sc, lane), s0 = row_load(sh, lane), h;
#pragma unroll
    for (int j = 0; j < 4; ++j) h.v[j] = x.v[j] * rs * gg.v[j] * (1.0f + s1.v[j]) + s0.v[j]; return h; }
__device__ __forceinline__ void row_store_bf16(bf16* p, int lane, const Row& r) { v2u* q = (v2u*)p + lane;
#pragma unroll
    for (int j = 0; j < 4; ++j) { v2u w; w.x = pk2(r.v[j][0], r.v[j][1]); w.y = pk2(r.v[j][2], r.v[j][3]); q[64 * j] = w; } }

__device__ __forceinline__ Row row_load_bf16(const bf16* p, int lane) { Row r; const v2u* q = (const v2u*)p + lane;
#pragma unroll
    for (int j = 0; j < 4; ++j) { const v2u w = q[64 * j]; r.v[j] = (f32x4){bflo(w.x), bfhi(w.x), bflo(w.y), bfhi(w.y)}; } return r; }
__device__ __forceinline__ void phase_rowA(Frame& F, int gw, int NGW) {
    bf16* H = (bf16*)(F.ws + WS_H);
    for (int m = gw; m < M; m += NGW) { const int b = m / SEQ; Row x = row_load(F.in[I_X] + (size_t)m * D, F.lane);
        Row h = row_modnorm(x, F.in[I_NMPRE], mod_ptr(F, 0, b, 1), mod_ptr(F, 0, b, 0), F.lane); row_store_bf16(H + (size_t)m * D, F.lane, h); }
}

__device__ __forceinline__ void phase_conv(Frame& F, int l) {
    const bf16* Z = (const bf16*)(F.ws + WS_ZC); bf16* UC = (bf16*)(F.ws + WS_UC);
    LAS float* tile = (LAS float*)F.lds;
    const int c2 = 2 * (F.tid & 255), half = F.tid >> 8;
    f32x2 w[CKW];
#pragma unroll
    for (int j = 0; j < CKW; ++j) w[j] = *(const f32x2*)(F.in[I_CONVW] + ((size_t)l * CKW + j) * CW + c2);
    const f32x2 bias = *(const f32x2*)(F.in[I_CONVB] + l * CW + c2);
    for (int ti = F.bid; ti < M / 64; ti += F.G) {
        const int t0 = ti * 64 + 32 * half, s0 = t0 % SEQ;
        f32x2 u[62];
#pragma unroll
        for (int i = 0; i < 62; ++i) { const bool ok = (s0 - 30 + i >= 0); const bf16* zr = Z + (size_t)(ok ? t0 - 30 + i : t0) * ZCW;
            const unsigned a2 = *(const unsigned*)(zr + c2), g2 = *(const unsigned*)(zr + CW + c2);
            const f32x2 uu = {bflo(a2) * sigmoidf_(bflo(g2)), bfhi(a2) * sigmoidf_(bfhi(g2))}; u[i] = ok ? uu : (f32x2){0.f, 0.f}; }
#pragma unroll
        for (int o = 0; o < 32; ++o) { f32x2 a = bias;
#pragma unroll
            for (int j = 0; j < CKW; ++j) a = __builtin_elementwise_fma(u[o + j], w[j], a);
            *(LAS f32x2*)(tile + (32 * half + o) * CW + c2) = a; }
        __syncthreads();
#pragma unroll 2
        for (int q = 0; q < 8; ++q) { const int o = 8 * F.wave + q; float v[8]; float s = 0.f;
#pragma unroll
            for (int i = 0; i < 8; ++i) { v[i] = tile[o * CW + F.lane + 64 * i]; s += v[i]; }
            const float mean = wave_sum(s) * (1.0f / CW); float s2 = 0.f;
#pragma unroll
            for (int i = 0; i < 8; ++i) { v[i] -= mean; s2 += v[i] * v[i]; }
            const float rstd = rsqrtf(wave_sum(s2) * (1.0f / CW) + LN_EPS);
#pragma unroll
            for (int i = 0; i < 8; ++i) { const int cc = F.lane + 64 * i; const float y = v[i] * rstd * F.in[I_CLNG][l * CW + cc] + F.in[I_CLNB][l * CW + cc];
                UC[(size_t)(ti * 64 + o) * D + cc] = (bf16)f2bf(siluf_(y)); } }
        __syncthreads();
    }
}
__device__ __forceinline__ void phase_prep1(Frame& F, int l, int gw, int NGW) {
    const bf16* Z = (const bf16*)(F.ws + WS_ZR); bf16* LIN = (bf16*)(F.ws + WS_LIN);
    const f32x4 mu = *((const f32x4*)(F.in[I_MU] + (size_t)l * COLR + 1536) + F.lane);
    for (int m = gw; m < M; m += NGW) {
        const int s = m % SEQ; const v2u cur = *((const v2u*)(Z + (size_t)m * ZRW + 1536) + F.lane);
        v2u prv = *((const v2u*)(Z + (size_t)(s > 0 ? m - 1 : m) * ZRW + 1536) + F.lane); if (s == 0) { prv.x = 0u; prv.y = 0u; }
        float x[4] = {bflo(cur.x), bfhi(cur.x), bflo(cur.y), bfhi(cur.y)}; const float p[4] = {bflo(prv.x), bfhi(prv.x), bflo(prv.y), bfhi(prv.y)};
#pragma unroll
        for (int i = 0; i < 4; ++i) { x[i] = x[i] + (p[i] - x[i]) * mu[i]; if (F.lane < 16) x[i] = tanhf(x[i]); else if (F.lane >= 32) x[i] = sigmoidf_(x[i]); }
        v2u o; o.x = pk2(x[0], x[1]); o.y = pk2(x[2], x[3]); *((v2u*)(LIN + (size_t)m * KLORA) + F.lane) = o;
    }
}
__device__ __forceinline__ void ld8bf(const bf16* p, float (&o)[8]) { const v4u w = *(const v4u*)p; o[0] = bflo(w.x); o[1] = bfhi(w.x); o[2] = bflo(w.y); o[3] = bfhi(w.y); o[4] = bflo(w.z); o[5] = bfhi(w.z); o[6] = bflo(w.w); o[7] = bfhi(w.w); }
__device__ __forceinline__ void st8bf(bf16* p, const float (&o)[8]) { v4u w; w.x = pk2(o[0], o[1]); w.y = pk2(o[2], o[3]); w.z = pk2(o[4], o[5]); w.w = pk2(o[6], o[7]); *(v4u*)p = w; }
__device__ __forceinline__ void ld8f(const float* p, float (&o)[8]) { const f32x4 a = *(const f32x4*)p, b = *((const f32x4*)p + 1); o[0] = a[0]; o[1] = a[1]; o[2] = a[2]; o[3] = a[3]; o[4] = b[0]; o[5] = b[1]; o[6] = b[2]; o[7] = b[3]; }
__device__ __forceinline__ float grp8_sum(float v) { v += dpp_get<0xB1, 0xF>(v); v += dpp_get<0x4E, 0xF>(v); v += dpp_get<0x141, 0xF>(v); return v; }
__device__ __forceinline__ void phase_prep2(Frame& F, int l, int gw, int NGW) {
    const bf16* Z = (const bf16*)(F.ws + WS_ZR); const bf16* LOUT = (const bf16*)(F.ws + WS_LOUT);
    bf16* SR = (bf16*)(F.ws + WS_SR); bf16* SKP = (bf16*)(F.ws + WS_SKP); bf16* SV = (bf16*)(F.ws + WS_SV); bf16* SKKN = (bf16*)(F.ws + WS_SKKN); bf16* SKA = (bf16*)(F.ws + WS_SKA);
    float* SDEC = (float*)(F.ws + WS_SDEC); float* BONUS = (float*)(F.ws + WS_BONUS);
    const int c = 8 * F.lane;
    float mur[8], muk[8], muv[8], w0[8], a0[8], kkw[8], kaw[8], rkw[8];
    ld8f(F.in[I_MU] + (size_t)l * COLR + c, mur); ld8f(F.in[I_MU] + (size_t)l * COLR + 512 + c, muk); ld8f(F.in[I_MU] + (size_t)l * COLR + 1024 + c, muv);
    ld8f(F.in[I_W0] + l * RW + c, w0); ld8f(F.in[I_A0] + l * RW + c, a0); ld8f(F.in[I_KK] + l * RW + c, kkw); ld8f(F.in[I_KA] + l * RW + c, kaw); ld8f(F.in[I_RK] + l * RW + c, rkw);
    for (int m = gw; m < M; m += NGW) {
        const int s = m % SEQ; const bf16* zr = Z + (size_t)m * ZRW + c;
        float r[8], k[8], v[8], pr[8], pk[8], pv[8], lw[8], la[8];
        ld8bf(zr, r); ld8bf(zr + 512, k); ld8bf(zr + 1024, v);
        { const bf16* zp = (s > 0) ? zr - ZRW : zr; ld8bf(zp, pr); ld8bf(zp + 512, pk); ld8bf(zp + 1024, pv); }
        if (s == 0) {
#pragma unroll
            for (int i = 0; i < 8; ++i) { pr[i] = 0.f; pk[i] = 0.f; pv[i] = 0.f; } }
        ld8bf(LOUT + (size_t)m * NLORA + c, lw); ld8bf(LOUT + (size_t)m * NLORA + 512 + c, la);
        float dec[8], kp[8], kk[8], ka[8]; float ss = 0.f, bo = 0.f;
#pragma unroll
        for (int i = 0; i < 8; ++i) {
            r[i] += (pr[i] - r[i]) * mur[i]; k[i] += (pk[i] - k[i]) * muk[i]; v[i] += (pv[i] - v[i]) * muv[i];
            dec[i] = __expf(-0.60653066f * sigmoidf_(w0[i] + lw[i]));
            const float a = sigmoidf_(a0[i] + la[i]);
            kk[i] = k[i] * kkw[i]; kp[i] = k[i] * (1.0f + (a - 1.0f) * kaw[i]); ka[i] = a;
            ss += kk[i] * kk[i]; bo += r[i] * kp[i] * rkw[i];
        }
        ss = grp8_sum(ss); bo = grp8_sum(bo);
        const float inv = rsqrtf(fmaxf(ss, 1e-24f));
#pragma unroll
        for (int i = 0; i < 8; ++i) { kk[i] *= inv; ka[i] *= kk[i]; }
        const size_t o = (size_t)m * RW + c;
        st8bf(SR + o, r); st8bf(SKP + o, kp); st8bf(SV + o, v); st8bf(SKKN + o, kk); st8bf(SKA + o, ka);
        *(f32x4*)(SDEC + o) = (f32x4){dec[0], dec[1], dec[2], dec[3]}; *((f32x4*)(SDEC + o) + 1) = (f32x4){dec[4], dec[5], dec[6], dec[7]};
        if ((F.lane & 7) == 0) BONUS[(size_t)m * NH + (F.lane >> 3)] = bo;
    }
}
__device__ __forceinline__ void phase_scan(Frame& F) {
    const bf16* SR = (const bf16*)(F.ws + WS_SR); const bf16* SKP = (const bf16*)(F.ws + WS_SKP); const bf16* SV = (const bf16*)(F.ws + WS_SV);
    const bf16* SKKN = (const bf16*)(F.ws + WS_SKKN); const bf16* SKA = (const bf16*)(F.ws + WS_SKA); const float* SDEC = (const float*)(F.ws + WS_SDEC);
    float* YS = (float*)(F.ws + WS_YS);
    LAS float* buf = (LAS float*)F.lds;
    const int vr = F.lane >> 3, ke = F.lane & 7, vidx = 8 * F.wave + vr;
    for (int bh = F.bid; bh < NB * NH; bh += F.G) {
        const int b = bh / NH, h = bh % NH; const size_t m0 = (size_t)b * SEQ;
        float S[8];
#pragma unroll
        for (int i = 0; i < 8; ++i) S[i] = 0.f;
        for (int c0 = 0; c0 < SEQ; c0 += 64) {
            __syncthreads();
            for (int idx = F.tid; idx < 64 * 64; idx += NTHREADS) { const int t = idx >> 6, k = idx & 63; const size_t g = (m0 + c0 + t) * RW + h * RH + k; LAS float* d = buf + t * 384 + k;
                d[0] = bf2f(SR[g]); d[64] = SDEC[g]; d[128] = bf2f(SKP[g]); d[192] = bf2f(SKKN[g]); d[256] = bf2f(SKA[g]); d[320] = bf2f(SV[g]); }
            __syncthreads();
            for (int t = 0; t < 64; ++t) {
                const LAS float* d = buf + t * 384 + ke * 8;
                float r[8], dc[8], kp[8], kn[8], ka[8];
#pragma unroll
                for (int i = 0; i < 8; ++i) { r[i] = d[i]; dc[i] = d[64 + i]; kp[i] = d[128 + i]; kn[i] = d[192 + i]; ka[i] = d[256 + i]; }
                const float v = buf[t * 384 + 320 + vidx];
                float sa = 0.f;
#pragma unroll
                for (int i = 0; i < 8; ++i) sa += S[i] * kn[i];
                sa = -grp8_sum(sa);
                float y = 0.f;
#pragma unroll
                for (int i = 0; i < 8; ++i) { S[i] = S[i] * dc[i] + sa * ka[i] + v * kp[i]; y += S[i] * r[i]; }
                y = grp8_sum(y);
                if (ke == 0) YS[(m0 + c0 + t) * RW + h * RH + vidx] = y;
            }
        }
    }
}
constexpr int CS = 72, CBUF = 64 * CS * 2;
__device__ __forceinline__ f32x4 cmm(const LAS bf16* A, const LAS bf16* B, int m0, int n0, int lane, f32x4 acc) {
#pragma unroll
    for (int ks = 0; ks < 2; ++ks) {
        const bf16x8 a = *(const LAS bf16x8*)(A + (m0 + (lane & 15)) * CS + ks * 32 + 8 * (lane >> 4));
        const bf16x8 b = *(const LAS bf16x8*)(B + (n0 + (lane & 15)) * CS + ks * 32 + 8 * (lane >> 4));
        acc = __builtin_amdgcn_mfma_f32_16x16x32_bf16(a, b, acc, 0, 0, 0);
    }
    return acc;
}
__device__ __forceinline__ void cst4(LAS bf16* O, int n, int m, const f32x4 v) { v2u w; w.x = pk2(v[0], v[1]); w.y = pk2(v[2], v[3]); *(LAS v2u*)(O + n * CS + m) = w; }
__device__ __forceinline__ f32x4 cld4(const LAS bf16* O, int n, int m) { const v2u w = *(const LAS v2u*)(O + n * CS + m); return (f32x4){bflo(w.x), bfhi(w.x), bflo(w.y), bfhi(w.y)}; }
__device__ __forceinline__ void phase_chunkprep(Frame& F, int l) {
    float* YS = (float*)(F.ws + WS_YS); bf16* CQ = (bf16*)(F.ws + WS_CQ); bf16* CG = (bf16*)(F.ws + WS_CG); float* CH = (float*)(F.ws + WS_CH);
#define CB(i) ((LAS bf16*)(F.lds + (i) * CBUF))
    LAS float* part = (LAS float*)(F.lds + 14 * CBUF);
    LAS float* pcs = part + 512;
    const int lane = F.lane, w = F.wave, n0 = 16 * (w & 3), mA = 32 * (w >> 2), nn = n0 + (lane & 15), mq = 4 * (lane >> 4);
    const bf16* ZRp = (const bf16*)(F.ws + WS_ZR); const bf16* LOUT = (const bf16*)(F.ws + WS_LOUT); bf16* SVo = (bf16*)(F.ws + WS_SV); float* BONUS = (float*)(F.ws + WS_BONUS);
    unsigned short zr_[9], zk_[9], zv_[9], lw_[8], la_[8]; float cst[8];
#define CP_LOAD(PAIR) do { const int bh_ = (PAIR) >> 5, c_ = (PAIR) & 31, h_ = bh_ & 7; const size_t mr_ = (size_t)(bh_ >> 3) * SEQ + c_ * 64 + 8 * w; const int hc_ = h_ * RH + lane; \
        _Pragma("unroll") for (int i = 0; i < 9; ++i) { const size_t row_ = (c_ == 0 && w == 0 && i == 0) ? mr_ : mr_ + i - 1; const bf16* z_ = ZRp + row_ * ZRW + hc_; zr_[i] = z_[0]; zk_[i] = z_[512]; zv_[i] = z_[1024]; } \
        _Pragma("unroll") for (int i = 0; i < 8; ++i) { const bf16* q_ = LOUT + (mr_ + i) * NLORA + hc_; lw_[i] = q_[0]; la_[i] = q_[512]; } \
        cst[0] = F.in[I_MU][(size_t)l * COLR + hc_]; cst[1] = F.in[I_MU][(size_t)l * COLR + 512 + hc_]; cst[2] = F.in[I_MU][(size_t)l * COLR + 1024 + hc_]; \
        cst[3] = F.in[I_W0][l * RW + hc_]; cst[4] = F.in[I_A0][l * RW + hc_]; cst[5] = F.in[I_KK][l * RW + hc_]; cst[6] = F.in[I_KA][l * RW + hc_]; cst[7] = F.in[I_RK][l * RW + hc_]; } while (0)
    if (F.bid < NB * NH * (SEQ / 64)) CP_LOAD(F.bid);
    for (int pair = F.bid; pair < NB * NH * (SEQ / 64); pair += F.G) {
        const int bh = pair >> 5, c = pair & 31, b = bh >> 3, h = bh & 7; const size_t m0 = (size_t)b * SEQ + c * 64;
        {
          float dc[8], kn[8], ka[8], kp[8], rr[8], vv[8], ss[8], bo[8];
          const bool first = (c == 0 && w == 0);
#pragma unroll
          for (int i = 0; i < 8; ++i) {
              const float pr = (first && i == 0) ? 0.f : bf2f(zr_[i]), pk = (first && i == 0) ? 0.f : bf2f(zk_[i]), pv = (first && i == 0) ? 0.f : bf2f(zv_[i]);
              float r = bf2f(zr_[i + 1]), k = bf2f(zk_[i + 1]), v = bf2f(zv_[i + 1]);
              r += (pr - r) * cst[0]; k += (pk - k) * cst[1]; v += (pv - v) * cst[2];
              dc[i] = __expf(-0.60653066f * sigmoidf_(cst[3] + bf2f(lw_[i])));
              const float a = sigmoidf_(cst[4] + bf2f(la_[i]));
              const float kk = k * cst[5]; kp[i] = k * (1.0f + (a - 1.0f) * cst[6]); rr[i] = r; vv[i] = v; kn[i] = kk; ka[i] = a;
              ss[i] = kk * kk; bo[i] = r * kp[i] * cst[7]; }
#pragma unroll
          for (int i = 0; i < 8; ++i) { ss[i] = wave_sum(ss[i]); bo[i] = wave_sum(bo[i]); }
#pragma unroll
          for (int i = 0; i < 8; ++i) { kn[i] *= rsqrtf(fmaxf(ss[i], 1e-24f)); ka[i] *= kn[i];
              SVo[(m0 + 8 * w + i) * RW + h * RH + lane] = (bf16)f2bf(vv[i]); if (lane == 0) BONUS[(m0 + 8 * w + i) * NH + h] = bo[i]; }
          float p[8]; p[0] = dc[0];
#pragma unroll
          for (int i = 1; i < 8; ++i) p[i] = p[i - 1] * dc[i];
          part[w * 64 + lane] = p[7];
          __syncthreads();
          float pre = 1.f, tot = 1.f;
#pragma unroll
          for (int g = 0; g < 8; ++g) { const float q = part[g * 64 + lane]; tot *= q; if (g < w) pre *= q; }
          if (w == 0) pcs[lane] = tot;
          float at[8], bt[8], kt[8], rt[8], bh_[8], kh[8];
#pragma unroll
          for (int i = 0; i < 8; ++i) { const float P = pre * p[i], Pm = (i == 0) ? pre : pre * p[i - 1], inv = __builtin_amdgcn_rcpf(P);
              at[i] = -kn[i] * Pm; bt[i] = ka[i] * inv; kt[i] = kp[i] * inv; rt[i] = rr[i] * P; bh_[i] = bt[i] * tot; kh[i] = kt[i] * tot; }
#pragma unroll
          for (int i = 0; i < 8; ++i) { const int o = (8 * w + i) * CS + lane; CB(0)[o] = (bf16)f2bf(at[i]); CB(1)[o] = (bf16)f2bf(bt[i]); CB(2)[o] = (bf16)f2bf(kt[i]); CB(3)[o] = (bf16)f2bf(rt[i]); }
          { const int o = lane * CS + 8 * w; v4u q;
            q.x = pk2(at[0], at[1]); q.y = pk2(at[2], at[3]); q.z = pk2(at[4], at[5]); q.w = pk2(at[6], at[7]); *(LAS v4u*)(CB(4) + o) = q;
            q.x = pk2(bh_[0], bh_[1]); q.y = pk2(bh_[2], bh_[3]); q.z = pk2(bh_[4], bh_[5]); q.w = pk2(bh_[6], bh_[7]); *(LAS v4u*)(CB(5) + o) = q;
            q.x = pk2(kh[0], kh[1]); q.y = pk2(kh[2], kh[3]); q.z = pk2(kh[4], kh[5]); q.w = pk2(kh[6], kh[7]); *(LAS v4u*)(CB(6) + o) = q;
            q.x = pk2(vv[0], vv[1]); q.y = pk2(vv[2], vv[3]); q.z = pk2(vv[4], vv[5]); q.w = pk2(vv[6], vv[7]); *(LAS v4u*)(CB(7) + o) = q; }
        }
        if (pair + F.G < NB * NH * (SEQ / 64)) CP_LOAD(pair + F.G);
        __syncthreads();
        const f32x4 z4 = (f32x4){0.f, 0.f, 0.f, 0.f};
#pragma unroll
        for (int tl = 0; tl < 2; ++tl) { const int m0t = mA + 16 * tl, mm = m0t + mq;
            f32x4 a1 = cmm(CB(1), CB(0), m0t, n0, lane, z4), a2 = cmm(CB(0), CB(1), m0t, n0, lane, z4), a3 = cmm(CB(2), CB(0), m0t, n0, lane, z4);
            f32x4 a4 = cmm(CB(1), CB(3), m0t, n0, lane, z4), a5 = cmm(CB(2), CB(3), m0t, n0, lane, z4), t0;
#pragma unroll
            for (int i = 0; i < 4; ++i) { const int m = mm + i; a1[i] = (m < nn) ? a1[i] : 0.f; a2[i] = (nn < m) ? a2[i] : 0.f; a3[i] = (m < nn) ? a3[i] : 0.f; a4[i] = (m <= nn) ? a4[i] : 0.f; a5[i] = (m <= nn) ? a5[i] : 0.f; t0[i] = a1[i] + ((m == nn) ? 1.f : 0.f); }
            cst4(CB(8), nn, mm, a1); cst4(CB(9), nn, mm, a2); cst4(CB(10), nn, mm, t0); cst4(CB(11), nn, mm, a3); cst4(CB(12), nn, mm, a4); cst4(CB(13), nn, mm, a5); }
        __syncthreads();
#pragma unroll
        for (int tl = 0; tl < 2; ++tl) { const int m0t = mA + 16 * tl, mm = m0t + mq;
            cst4(CB(0), nn, mm, cmm(CB(9), CB(8), m0t, n0, lane, z4)); cst4(CB(1), nn, mm, cmm(CB(8), CB(9), m0t, n0, lane, z4)); cst4(CB(2), nn, mm, cmm(CB(11), CB(7), m0t, n0, lane, z4)); }
        __syncthreads();
#define CSTEP(MP, MPT, MPN, MPTN, TI, TO, DO_MP, DO_MPT) do { _Pragma("unroll") for (int tl = 0; tl < 2; ++tl) { const int m0t = mA + 16 * tl, mm = m0t + mq; \
            if (DO_MP) cst4(CB(MPN), nn, mm, cmm(CB(MPT), CB(MP), m0t, n0, lane, z4)); if (DO_MPT) cst4(CB(MPTN), nn, mm, cmm(CB(MP), CB(MPT), m0t, n0, lane, z4)); \
            cst4(CB(TO), nn, mm, cmm(CB(MPT), CB(TI), m0t, n0, lane, cld4(CB(TI), nn, mm))); } __syncthreads(); } while (0)
        CSTEP(0, 1, 8, 9, 10, 11, true, true);
        CSTEP(8, 9, 0, 1, 11, 10, true, true);
        CSTEP(0, 1, 8, 9, 10, 11, true, true);
        CSTEP(8, 9, 0, 1, 11, 10, false, true);
        CSTEP(0, 1, 8, 9, 10, 11, false, false);
#undef CSTEP
#pragma unroll
        for (int tl = 0; tl < 2; ++tl) { const int m0t = mA + 16 * tl, mm = m0t + mq;
            cst4(CB(8), nn, mm, cmm(CB(11), CB(4), m0t, n0, lane, z4)); cst4(CB(9), nn, mm, cmm(CB(11), CB(2), m0t, n0, lane, z4)); }
        __syncthreads();
#pragma unroll
        for (int tl = 0; tl < 2; ++tl) { const int m0t = mA + 16 * tl, mm = m0t + mq;
            { const f32x4 q = cmm(CB(8), CB(12), m0t, n0, lane, cld4(CB(3), nn, mm)); v2u o; o.x = pk2(q[0], q[1]); o.y = pk2(q[2], q[3]); *(v2u*)(CQ + ((size_t)pair * 64 + nn) * 64 + mm) = o; }
            { const f32x4 y = cmm(CB(7), CB(13), m0t, n0, lane, cmm(CB(9), CB(12), m0t, n0, lane, z4)); *(f32x4*)(YS + (m0 + nn) * RW + h * RH + mm) = y; }
            { f32x4 g = cmm(CB(8), CB(5), m0t, n0, lane, z4);
#pragma unroll
              for (int i = 0; i < 4; ++i) g[i] += (mm + i == nn) ? pcs[nn] : 0.f;
              v2u o; o.x = pk2(g[0], g[1]); o.y = pk2(g[2], g[3]); *(v2u*)(CG + ((size_t)pair * 64 + nn) * 64 + mm) = o; }
            { const f32x4 hh = cmm(CB(7), CB(6), m0t, n0, lane, cmm(CB(9), CB(5), m0t, n0, lane, z4)); *(f32x4*)(CH + ((size_t)pair * 64 + nn) * 64 + mm) = hh; }
        }
        __syncthreads();
    }
#undef CB
#undef CP_LOAD
}
typedef float f32x16 __attribute__((ext_vector_type(16)));
__device__ __forceinline__ bf16x8 pack_frag(const f32x16& x, int s) {
    v4u w; w.x = pk2(x[8 * s + 0], x[8 * s + 1]); w.y = pk2(x[8 * s + 2], x[8 * s + 3]); w.z = pk2(x[8 * s + 4], x[8 * s + 5]); w.w = pk2(x[8 * s + 6], x[8 * s + 7]);
    return __builtin_bit_cast(bf16x8, w);
}
__device__ __forceinline__ bf16x8 ld_afrag(const bf16* rowp, int kbase, int hh) {
    const v2u lo = *(const v2u*)(rowp + kbase + 4 * hh), hi = *(const v2u*)(rowp + kbase + 8 + 4 * hh); v4u w; w.x = lo.x; w.y = lo.y; w.z = hi.x; w.w = hi.y; return __builtin_bit_cast(bf16x8, w);
}
__device__ __forceinline__ bf16x8 ld_afrag_lds(const LAS unsigned char* img, int row, int kbase, int hh) {
    const int k0 = kbase + 4 * hh, k1 = k0 + 8;
    const v2u lo = *(const LAS v2u*)(img + row * 128 + (((k0 >> 3) ^ (row & 7)) << 4) + ((k0 & 7) << 1));
    const v2u hi = *(const LAS v2u*)(img + row * 128 + (((k1 >> 3) ^ (row & 7)) << 4) + ((k1 & 7) << 1));
    v4u w; w.x = lo.x; w.y = lo.y; w.z = hi.x; w.w = hi.y; return __builtin_bit_cast(bf16x8, w);
}
constexpr int CS_FLAGS = 98304;
__device__ __forceinline__ void phase_chunkscan(Frame& F) {
    float* YS = (float*)(F.ws + WS_YS); const bf16* CQ = (const bf16*)(F.ws + WS_CQ); const bf16* CG = (const bf16*)(F.ws + WS_CG); const float* CH = (const float*)(F.ws + WS_CH);
    const int lane = F.lane, r32 = lane & 31, hh = lane >> 5;
    LAS unsigned char* ring = F.lds;
    volatile LAS int* flg = (volatile LAS int*)(F.lds + CS_FLAGS);
    constexpr int NCH = SEQ / 64;
    for (int item = F.bid; item < NB * NH * 2; item += F.G) {
        const int bh = item >> 1, vh = item & 1, b = bh >> 3, h = bh & 7; const size_t m0 = (size_t)b * SEQ;
        if (F.wave == 1) {
            const int drow = lane >> 3, dch = lane & 7, dsw = dch ^ drow;
            for (int c = 0; c < NCH; ++c) {
                if (c >= 3) { unsigned sp = 0; while (flg[3] < c - 2) { __builtin_amdgcn_s_sleep(1); if (++sp > (1u << 22)) break; } }
                asm volatile("" ::: "memory");
                const size_t pr_ = (size_t)bh * 32 + c; LAS unsigned char* d_ = ring + (c % 3) * 32768;
                const char* gq_ = (const char*)(CQ + pr_ * 4096) + drow * 128 + dsw * 16; const char* gg_ = (const char*)(CG + pr_ * 4096) + drow * 128 + dsw * 16;
                const char* gh_ = (const char*)(CH + pr_ * 4096 + 32 * vh) + drow * 256 + dch * 16; const char* gy_ = (const char*)(YS + (m0 + c * 64) * RW + h * RH + 32 * vh) + (size_t)drow * (RW * 4) + dch * 16;
#pragma unroll
                for (int i_ = 0; i_ < 8; ++i_) {
                    __builtin_amdgcn_global_load_lds((const unsigned*)(gq_ + i_ * 1024), (LAS unsigned*)(d_ + i_ * 1024), 16, 0, 0);
                    __builtin_amdgcn_global_load_lds((const unsigned*)(gg_ + i_ * 1024), (LAS unsigned*)(d_ + 8192 + i_ * 1024), 16, 0, 0);
                    __builtin_amdgcn_global_load_lds((const unsigned*)(gh_ + i_ * 2048), (LAS unsigned*)(d_ + 16384 + i_ * 1024), 16, 0, 0);
                    __builtin_amdgcn_global_load_lds((const unsigned*)(gy_ + (size_t)i_ * (8 * RW * 4)), (LAS unsigned*)(d_ + 24576 + i_ * 1024), 16, 0, 0); }
                if (c >= 1) { asm volatile("s_waitcnt vmcnt(32)" ::: "memory"); flg[(c - 1) % 3] = c; }
            }
            asm volatile("s_waitcnt vmcnt(0)" ::: "memory"); flg[(NCH - 1) % 3] = NCH;
        } else if (F.wave == 0) {
            f32x16 X[2];
#pragma unroll
            for (int i = 0; i < 16; ++i) { X[0][i] = 0.f; X[1][i] = 0.f; }
            for (int c = 0; c < NCH; ++c) {
                { unsigned sp = 0; while (flg[c % 3] != c + 1) { __builtin_amdgcn_s_sleep(1); if (++sp > (1u << 22)) break; } }
                asm volatile("" ::: "memory"); __builtin_amdgcn_sched_barrier(0);
                const LAS unsigned char* d = ring + (c % 3) * 32768;
                bf16x8 xb[2][2];
#pragma unroll
                for (int kt = 0; kt < 2; ++kt)
#pragma unroll
                    for (int s2 = 0; s2 < 2; ++s2) xb[kt][s2] = pack_frag(X[kt], s2);
                f32x16 Yt[2], Xn[2];
#pragma unroll
                for (int tt = 0; tt < 2; ++tt) {
#pragma unroll
                    for (int i = 0; i < 16; ++i) { const int row = 32 * tt + (i & 3) + 8 * (i >> 2) + 4 * hh; Yt[tt][i] = *(const LAS float*)(d + 24576 + row * 128 + r32 * 4); Xn[tt][i] = *(const LAS float*)(d + 16384 + row * 128 + r32 * 4); }
#pragma unroll
                    for (int kt = 0; kt < 2; ++kt)
#pragma unroll
                        for (int s2 = 0; s2 < 2; ++s2) {
                            Yt[tt] = __builtin_amdgcn_mfma_f32_32x32x16_bf16(ld_afrag_lds(d, 32 * tt + r32, 32 * kt + 16 * s2, hh), xb[kt][s2], Yt[tt], 0, 0, 0);
                            Xn[tt] = __builtin_amdgcn_mfma_f32_32x32x16_bf16(ld_afrag_lds(d + 8192, 32 * tt + r32, 32 * kt + 16 * s2, hh), xb[kt][s2], Xn[tt], 0, 0, 0); }
                }
                asm volatile("s_waitcnt lgkmcnt(0)" ::: "memory");
                flg[3] = c + 1;
#pragma unroll
                for (int tt = 0; tt < 2; ++tt)
#pragma unroll
                    for (int i = 0; i < 16; ++i) { const int row = 32 * tt + (i & 3) + 8 * (i >> 2) + 4 * hh; YS[(m0 + c * 64 + row) * RW + h * RH + 32 * vh + r32] = Yt[tt][i]; }
                X[0] = Xn[0]; X[1] = Xn[1];
            }
        }
    }
}
__device__ __forceinline__ void phase_post(Frame& F, int l, int gw, int NGW) {
    const float* YS = (const float*)(F.ws + WS_YS); const bf16* SV = (const bf16*)(F.ws + WS_SV); const bf16* LOUT = (const bf16*)(F.ws + WS_LOUT); const float* BONUS = (const float*)(F.ws + WS_BONUS);
    bf16* YG = (bf16*)(F.ws + WS_YG);
    const int c = 8 * F.lane; float gg[8], gb[8]; ld8f(F.in[I_GNG] + l * RW + c, gg); ld8f(F.in[I_GNB] + l * RW + c, gb);
    for (int m = gw; m < M; m += NGW) {
        float y[8], v[8], g[8]; ld8f(YS + (size_t)m * RW + c, y); ld8bf(SV + (size_t)m * RW + c, v); ld8bf(LOUT + (size_t)m * NLORA + 1024 + c, g);
        float s = 0.f;
#pragma unroll
        for (int i = 0; i < 8; ++i) s += y[i];
        const float mean = grp8_sum(s) * (1.0f / RH); float s2 = 0.f;
#pragma unroll
        for (int i = 0; i < 8; ++i) { y[i] -= mean; s2 += y[i] * y[i]; }
        const float rstd = rsqrtf(grp8_sum(s2) * (1.0f / RH) + GN_EPS); const float bo = BONUS[(size_t)m * NH + (F.lane >> 3)];
        float o[8];
#pragma unroll
        for (int i = 0; i < 8; ++i) o[i] = (y[i] * rstd * gg[i] + gb[i] + bo * v[i]) * g[i];
        st8bf(YG + (size_t)m * D + RW + c, o);
    }
}

__device__ __forceinline__ unsigned* cnt_word(const Frame& F, int l, int e) { return (unsigned*)(F.ws + WS_CTL) + CW_CNT + (l * NE + e) * 64; }
constexpr int HT_STRIDE = 1032;
__device__ __forceinline__ void phase_rowB(Frame& F, int l, const bool dummy) {
    const bf16* Y = (const bf16*)(F.ws + WS_Y); bf16* H = (bf16*)(F.ws + (dummy ? WS_YEXP + 64 * MiB : WS_H));
    int* LIST = (int*)(F.ws + (dummy ? WS_YEXP + 96 * MiB : WS_LIST)); float* GW = (float*)(F.ws + (dummy ? WS_YEXP + 104 * MiB : WS_GW)); int* TOKA = (int*)(F.ws + (dummy ? WS_YEXP + 112 * MiB : WS_TOKA));
    bf16* xout = (bf16*)(F.ws + (dummy ? WS_YEXP : WS_XB)); const int lc = dummy ? l + 2 : l;
    const float* xsrc = F.in[I_X]; const bf16* xsrcb = (const bf16*)(F.ws + WS_XB);
    LAS bf16* hhi = (LAS bf16*)F.lds; LAS bf16* hlo = hhi + 16 * HT_STRIDE;
    LAS float* part = (LAS float*)(F.lds + 2 * 16 * HT_STRIDE * 2);
    LAS float* logit = part + 8 * 16 * 64;
    LAS int* cntl = (LAS int*)(logit + 1024 + 16 * 80);
    LAS int* asg = cntl + 128;
    if (F.tid < 128) cntl[F.tid] = 0;
    __syncthreads();
    int it = 0;
    const int lane = F.lane, w = F.wave, g4 = lane >> 4, j16 = lane & 15;
    const bf16* wrh = (const bf16*)(F.ws + WS_WMIX + (size_t)l * WMIX_STRIDE + WM_RHI); const bf16* wrl = (const bf16*)(F.ws + WS_WMIX + (size_t)l * WMIX_STRIDE + WM_RLO); const float br = F.in[I_BROUTER][l * NE + lane];
    v2u yq[2][4]; Row xq[2];
    if (F.bid < M / 16) {
#pragma unroll
        for (int rr = 0; rr < 2; ++rr) { const int m = F.bid * 16 + 2 * w + rr;
#pragma unroll
            for (int j = 0; j < 4; ++j) yq[rr][j] = *((const v2u*)(Y + (size_t)m * D) + lane + 64 * j);
            xq[rr] = (l == 0) ? row_load(xsrc + (size_t)m * D, lane) : row_load_bf16(xsrcb + (size_t)m * D, lane); } }
    for (int tile = F.bid; tile < M / 16; tile += F.G, ++it) {
#pragma unroll
        for (int rr = 0; rr < 2; ++rr) {
            const int r = 2 * w + rr, m = tile * 16 + r, b = m / SEQ;
            Row y, x = xq[rr], gp = row_load(F.in[I_NMPOST] + l * D, lane), gt = row_load(mod_ptr(F, l, b, 2), lane);
#pragma unroll
            for (int j = 0; j < 4; ++j) y.v[j] = (f32x4){bflo(yq[rr][j].x), bfhi(yq[rr][j].x), bflo(yq[rr][j].y), bfhi(yq[rr][j].y)};
            const float rs = rsqrtf(row_sumsq(y) * (1.0f / D) + RMS_EPS);
#pragma unroll
            for (int j = 0; j < 4; ++j) x.v[j] = x.v[j] + gt.v[j] * (y.v[j] * rs * gp.v[j]);
            row_store_bf16(xout + (size_t)m * D, lane, x);
            Row h = row_modnorm(x, F.in[I_NFPRE] + l * D, mod_ptr(F, l, b, 4), mod_ptr(F, l, b, 3), lane);
            row_store_bf16(H + (size_t)m * D, lane, h);
#pragma unroll
            for (int j = 0; j < 4; ++j) { const unsigned p0 = pk2(h.v[j][0], h.v[j][1]), p1 = pk2(h.v[j][2], h.v[j][3]); v2u hi2; hi2.x = p0; hi2.y = p1;
                v2u lo2; lo2.x = pk2(h.v[j][0] - bflo(p0), h.v[j][1] - bfhi(p0)); lo2.y = pk2(h.v[j][2] - bflo(p1), h.v[j][3] - bfhi(p1));
                *((LAS v2u*)(hhi + r * HT_STRIDE) + lane + 64 * j) = hi2; *((LAS v2u*)(hlo + r * HT_STRIDE) + lane + 64 * j) = lo2; }
        }
        if (tile + F.G < M / 16) {
#pragma unroll
            for (int rr = 0; rr < 2; ++rr) { const int m = (tile + F.G) * 16 + 2 * w + rr;
#pragma unroll
                for (int j = 0; j < 4; ++j) yq[rr][j] = *((const v2u*)(Y + (size_t)m * D) + lane + 64 * j);
                xq[rr] = (l == 0) ? row_load(xsrc + (size_t)m * D, lane) : row_load_bf16(xsrcb + (size_t)m * D, lane); } }
        __syncthreads();
        if (dummy && MK_RB_LEVEL < 2) continue;
#pragma unroll 1
        for (int eh = 0; eh < 2; ++eh) {
            asm volatile("" : "+s"(wrh), "+s"(wrl));
            bf16x8 bh[2][4], bl[2][4];
#pragma unroll
            for (int e2 = 0; e2 < 2; ++e2)
#pragma unroll
                for (int ks = 0; ks < 4; ++ks) { const size_t o = (size_t)(16 * (2 * eh + e2) + j16) * D + 128 * w + 32 * ks + 8 * g4; bh[e2][ks] = *(const bf16x8*)(wrh + o); bl[e2][ks] = *(const bf16x8*)(wrl + o); }
            f32x4 acc[2] = {(f32x4){0.f, 0.f, 0.f, 0.f}, (f32x4){0.f, 0.f, 0.f, 0.f}};
#pragma unroll
            for (int ks = 0; ks < 4; ++ks) { const int ko = 128 * w + 32 * ks + 8 * g4;
                const bf16x8 ah = *(const LAS bf16x8*)(hhi + j16 * HT_STRIDE + ko), al = *(const LAS bf16x8*)(hlo + j16 * HT_STRIDE + ko);
#pragma unroll
                for (int e2 = 0; e2 < 2; ++e2) { acc[e2] = __builtin_amdgcn_mfma_f32_16x16x32_bf16(ah, bh[e2][ks], acc[e2], 0, 0, 0); acc[e2] = __builtin_amdgcn_mfma_f32_16x16x32_bf16(ah, bl[e2][ks], acc[e2], 0, 0, 0); acc[e2] = __builtin_amdgcn_mfma_f32_16x16x32_bf16(al, bh[e2][ks], acc[e2], 0, 0, 0); } }
#pragma unroll
            for (int e2 = 0; e2 < 2; ++e2)
#pragma unroll
                for (int i = 0; i < 4; ++i) part[(w * 16 + 4 * g4 + i) * 64 + 16 * (2 * eh + e2) + j16] = acc[e2][i];
        }
        __syncthreads();
#pragma unroll
        for (int o = 0; o < 2; ++o) { const int idx = F.tid + 512 * o; float sum = 0.f;
#pragma unroll
            for (int ww = 0; ww < 8; ++ww) sum += part[ww * 1024 + idx];
            logit[idx] = sum; }
        __syncthreads();
        if (dummy && MK_RB_LEVEL < 3) continue;
#pragma unroll
        for (int rr = 0; rr < 2; ++rr) {
            const int r = 2 * w + rr, m = tile * 16 + r;
            const float score = sigmoidf_(logit[r * 64 + lane]), biased = score + br;
            LAS float* wb = logit + 1024 + (2 * w + rr) * 80;
            wb[lane] = biased; LDS_WAIT();
            const int g = lane >> 3;
            float gs;
            { const f32x4 ga = *(const LAS f32x4*)(wb + 8 * g), gb = *(const LAS f32x4*)(wb + 8 * g + 4); float m1 = ga[0], m2 = -__builtin_inff();
#define T2(v) do { const float v_ = (v); if (v_ > m1) { m2 = m1; m1 = v_; } else if (v_ > m2) m2 = v_; } while (0)
              T2(ga[1]); T2(ga[2]); T2(ga[3]); T2(gb[0]); T2(gb[1]); T2(gb[2]); T2(gb[3]);
#undef T2
              gs = m1 + m2; }
            if ((lane & 7) == 0) wb[64 + g] = gs;
            LDS_WAIT();
            int grk = 0;
            { const f32x4 s0 = *(const LAS f32x4*)(wb + 64), s1 = *(const LAS f32x4*)(wb + 68);
#pragma unroll
              for (int q = 0; q < 8; ++q) { const float o = (q < 4) ? s0[q & 3] : s1[q & 3]; grk += (o > gs || (o == gs && q < g)) ? 1 : 0; } }
            const unsigned long long selb = __ballot(grk < 4);
            int rank = 0;
#pragma unroll
            for (int gq = 0; gq < 8; ++gq) if ((selb >> (8 * gq)) & 1ull) {
                const f32x4 o0 = *(const LAS f32x4*)(wb + 8 * gq), o1 = *(const LAS f32x4*)(wb + 8 * gq + 4);
#pragma unroll
                for (int i = 0; i < 4; ++i) { rank += (o0[i] > biased || (o0[i] == biased && (8 * gq + i) < lane)) ? 1 : 0; rank += (o1[i] > biased || (o1[i] == biased && (8 * gq + 4 + i) < lane)) ? 1 : 0; } }
            LDS_WAIT();
            const bool chosen = (grk < 4) && rank < TOPK;
            const float ssum = wave_sum(chosen ? score : 0.f);
            if (chosen) { const int lp = __hip_atomic_fetch_add((LAS int*)cntl + lane, 1, __ATOMIC_RELAXED, __HIP_MEMORY_SCOPE_WORKGROUP);
                LAS int* q = asg + ((it * 16 + r) * TOPK + rank) * 2; q[0] = lane * 65536 + lp; q[1] = __builtin_bit_cast(int, score / ssum * ROUTED_SCALE); }
            if (lane == 0) LIST[(size_t)NE * M + m] = m;
        }
    }
    if (dummy && MK_RB_LEVEL < 3) return;
    __syncthreads();
    if (F.tid < NE) cntl[NE + F.tid] = (int)__hip_atomic_fetch_add(cnt_word(F, lc, F.tid), (unsigned)cntl[F.tid], RLX_AGENT);
    __syncthreads();
    for (int idx = F.tid; idx < it * 16 * TOPK; idx += NTHREADS) {
        const int itl = idx / (16 * TOPK), r = (idx / TOPK) % 16, m = (F.bid + itl * F.G) * 16 + r; const int ep = asg[idx * 2], e = ep >> 16, pos = cntl[NE + e] + (ep & 65535);
        LIST[(size_t)e * M + pos] = m; TOKA[((size_t)m * TOPK + (idx % TOPK)) * 2] = e * 65536 + pos; TOKA[((size_t)m * TOPK + (idx % TOPK)) * 2 + 1] = asg[idx * 2 + 1]; }
}

struct MoeTab { LAS int* cnt; LAS int* start; LAS int* tstart; LAS int* ntiles; LAS int* tiles; };
__device__ __forceinline__ MoeTab moe_tab(const Frame& F) { MoeTab T; LAS int* p = (LAS int*)(F.lds + LDS_TAB_OFF); T.cnt = p; T.start = p + 80; T.tstart = p + 160; T.ntiles = p + 240; T.tiles = p + 256; return T; }
__device__ __forceinline__ void moe_build(Frame& F, int l, bool with_tiles) {
    MoeTab T = moe_tab(F);
    __syncthreads();
    if (F.tid <= NE) T.cnt[F.tid] = (F.tid < NE) ? (int)__hip_atomic_load(cnt_word(F, l, F.tid), RLX_AGENT) : M;
    __syncthreads();
    if (F.tid <= NE) { int s = 0, ts = 0; for (int e = 0; e < F.tid; ++e) { const int c = T.cnt[e]; s += c; ts += (c + 255) >> 8; } T.start[F.tid] = s; T.tstart[F.tid] = ts;
        if (F.tid == NE) T.ntiles[0] = ts + ((M + 255) >> 8);
        if (with_tiles) { const int c = T.cnt[F.tid]; const int nt = (c + 255) >> 8;
            for (int rt = 0; rt < nt; ++rt) { LAS int* q = T.tiles + (ts + rt) * 4; q[0] = F.tid; q[1] = rt * 256; q[2] = s + rt * 256; q[3] = (c - rt * 256) < 256 ? (c - rt * 256) : 256; } } }
    __syncthreads();
}
struct MoeOrder {
    LAS const int* tiles; int ntiles, npn, nwg, G, c, bstride;
    __device__ bool next(int i, pg8::Unit& u) const {
        const long L = (long)i * G + c; if (L >= nwg) return false;
        int wgid = (int)L; { const int q = nwg / 8, r = nwg % 8, xcd = wgid % 8, off = wgid / 8; wgid = (xcd < r ? xcd * (q + 1) : r * (q + 1) + (xcd - r) * q) + off; }
        const int tile = wgid / npn, pn = wgid % npn; LAS const int* q = tiles + tile * 4;
        const int q0 = __builtin_amdgcn_readfirstlane(q[0]), q1 = __builtin_amdgcn_readfirstlane(q[1]), q2 = __builtin_amdgcn_readfirstlane(q[2]), q3 = __builtin_amdgcn_readfirstlane(q[3]);
        u.e = q0; u.x0 = q0 * M + q1; u.o0 = q2; u.nrows = q3; u.b0 = q0 * bstride + pn * 256; u.oc0 = pn * 256; u.a0 = q2; return true;
    }
};
__device__ __forceinline__ Row row_load_fp8(const unsigned char* p, int lane) { Row r; const unsigned* q = (const unsigned*)p + lane;
#pragma unroll
    for (int j = 0; j < 4; ++j) { const int w = (int)q[64 * j]; const f32x2 lo = __builtin_amdgcn_cvt_pk_f32_fp8(w, false), hi = __builtin_amdgcn_cvt_pk_f32_fp8(w, true); r.v[j] = (f32x4){lo.x, lo.y, hi.x, hi.y}; } return r; }
__device__ __forceinline__ void phase_rowC(Frame& F, int l, int gw, int NGW, const bool dummy) {
    const unsigned char* YEXP = (const unsigned char*)(F.ws + WS_YEXP); const unsigned char* YSH = YEXP + (size_t)M * TOPK * D; const int* TOKA = (const int*)(F.ws + WS_TOKA); bf16* H = (bf16*)(F.ws + (dummy ? WS_S : WS_H));
    bf16* xb = (bf16*)(F.ws + WS_XB); bf16* xoutb = dummy ? (bf16*)(F.ws + WS_S) : xb; float* xoutf = dummy ? (float*)(F.ws + WS_S) : (float*)F.out;
    MoeTab T = moe_tab(F);
    v4u tk[4];
    if (gw < M) {
#pragma unroll
        for (int q = 0; q < 4; ++q) tk[q] = *((const v4u*)(TOKA + (size_t)gw * TOPK * 2) + q); }
    for (int m = gw; m < M; m += NGW) {
        const int b = m / SEQ;
        unsigned raw[TOPK + 1][4];
        { const unsigned* q = (const unsigned*)(YSH + (size_t)m * D) + F.lane;
#pragma unroll
          for (int j = 0; j < 4; ++j) raw[TOPK][j] = q[64 * j]; }
#pragma unroll
        for (int j8 = 0; j8 < TOPK; ++j8) { const int ep = (int)((j8 & 1) ? tk[j8 >> 1].z : tk[j8 >> 1].x);
            const int slot = T.start[ep >> 16] + (ep & 65535); const unsigned* q = (const unsigned*)(YEXP + (size_t)slot * D) + F.lane;
#pragma unroll
            for (int j = 0; j < 4; ++j) raw[j8][j] = q[64 * j]; }
        float gts[TOPK];
#pragma unroll
        for (int j8 = 0; j8 < TOPK; ++j8) gts[j8] = __builtin_bit_cast(float, (j8 & 1) ? tk[j8 >> 1].w : tk[j8 >> 1].y);
        { const int mn = (m + NGW < M) ? m + NGW : m;
#pragma unroll
          for (int q = 0; q < 4; ++q) tk[q] = *((const v4u*)(TOKA + (size_t)mn * TOPK * 2) + q); }
        Row y;
#pragma unroll
        for (int j = 0; j < 4; ++j) { const int w = (int)raw[TOPK][j]; const f32x2 lo = __builtin_amdgcn_cvt_pk_f32_fp8(w, false), hi = __builtin_amdgcn_cvt_pk_f32_fp8(w, true); y.v[j] = (f32x4){lo.x, lo.y, hi.x, hi.y}; }
#pragma unroll
        for (int j8 = 0; j8 < TOPK; ++j8)
#pragma unroll
            for (int j = 0; j < 4; ++j) { const int w = (int)raw[j8][j]; const f32x2 lo = __builtin_amdgcn_cvt_pk_f32_fp8(w, false), hi = __builtin_amdgcn_cvt_pk_f32_fp8(w, true);
                y.v[j][0] += gts[j8] * lo.x; y.v[j][1] += gts[j8] * lo.y; y.v[j][2] += gts[j8] * hi.x; y.v[j][3] += gts[j8] * hi.y; }
        Row x = row_load_bf16(xb + (size_t)m * D, F.lane), gp = row_load(F.in[I_NFPOST] + l * D, F.lane), gt = row_load(mod_ptr(F, l, b, 5), F.lane);
        const float rs = rsqrtf(row_sumsq(y) * (1.0f / D) + RMS_EPS);
#pragma unroll
        for (int j = 0; j < 4; ++j) x.v[j] = x.v[j] + gt.v[j] * (y.v[j] * rs * gp.v[j]);
        if (l + 1 < DEPTH) row_store_bf16(xoutb + (size_t)m * D, F.lane, x); else row_store(xoutf + (size_t)m * D, F.lane, x);
        if (l + 1 < DEPTH) { Row h = row_modnorm(x, F.in[I_NMPRE] + (l + 1) * D, mod_ptr(F, l + 1, b, 1), mod_ptr(F, l + 1, b, 0), F.lane); row_store_bf16(H + (size_t)m * D, F.lane, h); }
    }
}

__device__ __forceinline__ void phase_begin(Frame& F) { asm volatile("" : "+s"(F.in), "+s"(F.ws), "+s"(F.out), "+s"(F.bid), "+s"(F.G), "+s"(F.wave));
    F.lane = (int)__builtin_amdgcn_mbcnt_hi(~0u, __builtin_amdgcn_mbcnt_lo(~0u, 0u)); asm volatile("" : "+v"(F.lane)); F.tid = F.wave * 64 + F.lane; }
constexpr int PH_PER_LAYER = 13, NPH = 2 + DEPTH * PH_PER_LAYER;
__device__ __forceinline__ void bar_launder(XcdBarrier& bar) { asm volatile("" : "+s"(bar.bar)); }
#define TBIT(k) ((k) == 0 ? 13 : (k) == 1 ? 14 : ((k) - 2) % PH_PER_LAYER)
#define IN(k) (phase_begin(F), bar_launder(bar), t_ph = (((MK_TIME_MASK >> TBIT(k)) & 1) ? __builtin_amdgcn_s_memrealtime() : 0ull), (lo <= (k) && (k) < hi))
#define SEAM(k) do { if (!MK_PER_PHASE && (k) + 1 < hi) { xcd_barrier(bar, F.tid); if ((MK_TIME_MASK >> TBIT(k)) & 1) t_acc += __builtin_amdgcn_s_memrealtime() - t_ph; if (MK_REPEAT == -3) { bar_launder(bar); xcd_barrier(bar, F.tid); } } } while (0)
template <int L> __device__ __forceinline__ void layer_phases(Frame& F, XcdBarrier& bar, const int lo, const int hi, unsigned long long& t_acc) {
    constexpr int l = L, p0 = 2 + L * PH_PER_LAYER; unsigned long long t_ph = 0;
#define GW_ const int gw = F.bid * NWAVES + F.wave, NGW = F.G * NWAVES
#define WM_ GAS unsigned char* wm = F.ws + WS_WMIX + (size_t)l * WMIX_STRIDE
    if (IN(p0 + 0)) { for (int rep_ = 0; rep_ < ((MK_REPEAT == 0) ? 2 : 1); ++rep_) { phase_begin(F); bar_launder(bar); WM_;
        pg8::Gemm g{(const bf16*)(F.ws + WS_H), (const bf16*)(wm + WM_WIN), D, nullptr}; pg8::StaticOrder S; S.init(M, DIN, F.G, F.bid);
        pg8::EpiZ E{(bf16*)(F.ws + WS_ZC)}; pg8::gemm_phase<pg8::EpiZ, pg8::StaticOrder, false>(F.lds, F.tid, g, S, E);
        { const int nun = (M / 256) * (DIN / 256), idle0 = nun % F.G;
          if (idle0 > 0 && F.bid >= idle0) phase_expert_weights(F, l, (F.bid - idle0) * NWAVES + F.wave, (F.G - idle0) * NWAVES, 0, 0, EW_A); else if (idle0 == 0) { GW_; phase_expert_weights(F, l, gw, NGW, 0, 0, EW_A); } } } SEAM(p0 + 0); }
    if (IN(p0 + 1)) { for (int rep_ = 0; rep_ < ((MK_REPEAT == 1) ? 2 : 1); ++rep_) { phase_begin(F); bar_launder(bar); GW_; phase_conv(F, l); if (MK_REPEAT == 101) phase_conv(F, l); phase_prep1(F, l, gw, NGW); if (MK_REPEAT == 102) phase_prep1(F, l, gw, NGW); } SEAM(p0 + 1); }
    if (IN(p0 + 2)) { for (int rep_ = 0; rep_ < ((MK_REPEAT == 2) ? 2 : 1); ++rep_) { phase_begin(F); bar_launder(bar); WM_; pg8::Gemm g{(const bf16*)(F.ws + WS_LIN), (const bf16*)(wm + WM_LORA), KLORA, nullptr}; pg8::StaticOrder S; S.init(M, NLORA, F.G, F.bid);
        pg8::EpiBf16 E{(bf16*)(F.ws + WS_LOUT), NLORA}; pg8::gemm_phase<pg8::EpiBf16, pg8::StaticOrder, false>(F.lds, F.tid, g, S, E);
        { const int nun = (M / 256) * (NLORA / 256), idle0 = nun % F.G;
          if (idle0 > 0 && F.bid >= idle0) phase_expert_weights(F, l, (F.bid - idle0) * NWAVES + F.wave, (F.G - idle0) * NWAVES, 0, EW_A, EW_B); else if (idle0 == 0) { GW_; phase_expert_weights(F, l, gw, NGW, 0, EW_A, EW_B); } } } SEAM(p0 + 2); }
    if (IN(p0 + 4)) { for (int rep_ = 0; rep_ < ((MK_REPEAT == 4) ? 2 : 1); ++rep_) { phase_begin(F); bar_launder(bar); phase_chunkprep(F, l); } SEAM(p0 + 4); }
    if (IN(p0 + 5)) { for (int rep_ = 0; rep_ < ((MK_REPEAT == 5) ? 2 : 1); ++rep_) { phase_begin(F); bar_launder(bar); const int nscan = NB * NH * 2;
        if (F.tid < 4) ((volatile LAS int*)(F.lds + CS_FLAGS))[F.tid] = 0;
        __syncthreads();
        if (F.G > nscan) { if (F.bid < nscan) { if (F.wave < 2) { if (rep_ == 0) phase_chunkscan(F); }
                                                else if (l + 1 < DEPTH && rep_ == 0) phase_mix_weights(F, F.bid * 6 + (F.wave - 2), nscan * 6, l + 1, l + 2, 102400 + (F.wave - 2) * 8704); }
                           else phase_expert_weights(F, l, (F.bid - nscan) * NWAVES + F.wave, (F.G - nscan) * NWAVES, 0, EW_B, EW_ITEMS); }
        else { if (rep_ == 0 && F.wave < 2) phase_chunkscan(F); __syncthreads(); { GW_; phase_expert_weights(F, l, gw, NGW, 0, EW_B, EW_ITEMS); if (l + 1 < DEPTH && rep_ == 0) phase_mix_weights(F, gw, NGW, l + 1, l + 2, 65536 + F.wave * 8704); } } } SEAM(p0 + 5); }
    if (IN(p0 + 6)) { for (int rep_ = 0; rep_ < ((MK_REPEAT == 6) ? 2 : 1); ++rep_) { phase_begin(F); bar_launder(bar); GW_; phase_post(F, l, gw, NGW); } SEAM(p0 + 6); }
    if (IN(p0 + 7)) { for (int rep_ = 0; rep_ < ((MK_REPEAT == 7) ? 2 : 1); ++rep_) { phase_begin(F); bar_launder(bar); WM_; pg8::StaticOrder S; S.init(M, D, F.G, F.bid);
        pg8::Gemm g{(const bf16*)(F.ws + WS_UC), (const bf16*)(wm + WM_PCONV), D, nullptr}; pg8::EpiMerge2 E{(bf16*)(F.ws + WS_MERGED), (const bf16*)(F.ws + WS_ZG)};
        pg8::gemm_phase<pg8::EpiMerge2, pg8::StaticOrder, false>(F.lds, F.tid, g, S, E); } SEAM(p0 + 7); }
    if (IN(p0 + 8)) { for (int rep_ = 0; rep_ < ((MK_REPEAT == 8) ? 2 : 1); ++rep_) { phase_begin(F); bar_launder(bar); WM_; pg8::Gemm g{(const bf16*)(F.ws + WS_MERGED), (const bf16*)(wm + WM_WO), D, nullptr}; pg8::StaticOrder S; S.init(M, D, F.G, F.bid);
        pg8::EpiBf16 E{(bf16*)(F.ws + WS_Y), D}; pg8::gemm_phase<pg8::EpiBf16, pg8::StaticOrder, false>(F.lds, F.tid, g, S, E); } SEAM(p0 + 8); }
    if (IN(p0 + 9)) { for (int rep_ = 0; rep_ < ((MK_REPEAT == 9) ? 2 : 1); ++rep_) { phase_begin(F); bar_launder(bar); phase_rowB(F, l, (MK_REPEAT == 9) && rep_ == 0); } SEAM(p0 + 9); }
    if (IN(p0 + 10)) { for (int rep_ = 0; rep_ < ((MK_REPEAT == 10) ? 2 : 1); ++rep_) { phase_begin(F); bar_launder(bar); moe_build(F, l, true); MoeTab T = moe_tab(F);
        const int ntl = __builtin_amdgcn_readfirstlane(T.ntiles[0]); MoeOrder S{T.tiles, ntl, 2, ntl * 2, F.G, F.bid, 512};
        pg8::Gemm g{(const bf16*)(F.ws + WS_H), (const bf16*)(F.ws + WS_WGU), D, (const int*)(F.ws + WS_LIST)};
        pg8::EpiSwiGLU E{(bf16*)(F.ws + WS_ACT)}; pg8::gemm_phase<pg8::EpiSwiGLU, MoeOrder, true>(F.lds, F.tid, g, S, E); } SEAM(p0 + 10); }
    if (IN(p0 + 11)) { for (int rep_ = 0; rep_ < ((MK_REPEAT == 11) ? 2 : 1); ++rep_) { phase_begin(F); bar_launder(bar); moe_build(F, l, true); MoeTab T = moe_tab(F);
        const int ntl = __builtin_amdgcn_readfirstlane(T.ntiles[0]); MoeOrder S{T.tiles, ntl, 4, ntl * 4, F.G, F.bid, 1024};
        pg8::Gemm g{(const bf16*)(F.ws + WS_ACT), (const bf16*)(F.ws + WS_WDN), DE, nullptr};
        pg8::EpiFp8 E{(unsigned char*)(F.ws + WS_YEXP), D}; pg8::gemm_phase<pg8::EpiFp8, MoeOrder, false>(F.lds, F.tid, g, S, E); } SEAM(p0 + 11); }
    if (IN(p0 + 12)) { for (int rep_ = 0; rep_ < ((MK_REPEAT == 12) ? 2 : 1); ++rep_) { phase_begin(F); bar_launder(bar); GW_; moe_build(F, l, false); phase_rowC(F, l, gw, NGW, (MK_REPEAT == 12) && rep_ == 0); } SEAM(p0 + 12); }
}
__global__ void __launch_bounds__(NTHREADS, 2) mk_fwd(Args args) {
    extern __shared__ __attribute__((aligned(16))) unsigned char lds_raw[];
    Frame F; F.lds = (LAS unsigned char*)lds_raw; F.tid = threadIdx.x; F.lane = F.tid & 63; F.wave = __builtin_amdgcn_readfirstlane(F.tid >> 6);
    F.G = gridDim.x; F.bid = blockIdx.x; F.in = (const float* const __attribute__((address_space(4)))*)__builtin_amdgcn_kernarg_segment_ptr(); F.out = (GAS float*)args.out; F.ws = (GAS unsigned char*)args.ws;
    volatile LAS unsigned* MISC = (volatile LAS unsigned*)(F.lds + MISC_OFF);
    if (F.tid < 64) MISC[F.tid] = 0u;
    __syncthreads();
    XcdBarrier bar; bar.bar = (unsigned*)(F.ws + WS_CTL) + CW_BAR; bar.x = 0; bar.st = nullptr;
    if (!MK_PER_PHASE) bar = xcd_barrier_post((unsigned*)(F.ws + WS_CTL) + CW_BAR, MISC + 8);
    const int lo = args.ph_lo, hi = (args.ph_hi < MK_LAST_PHASE + 1) ? args.ph_hi : MK_LAST_PHASE + 1;
    unsigned long long t_acc = 0, t_ph = 0;
    if (IN(0)) { for (int rep_ = 0; rep_ < ((MK_REPEAT == -2) ? 2 : 1); ++rep_) { phase_begin(F); bar_launder(bar); GW_; phase_ada(F); phase_mix_weights(F, gw, NGW, 0, 1, 65536 + F.wave * 8704); } SEAM(0); }
    if (IN(1)) { GW_; phase_rowA(F, gw, NGW); SEAM(1); }
    layer_phases<0>(F, bar, lo, hi, t_acc);
    layer_phases<1>(F, bar, lo, hi, t_acc);
    if (MK_TIME_MASK != 0 && F.bid == 0) { const unsigned long long te = __builtin_amdgcn_s_memrealtime() + t_acc; while (__builtin_amdgcn_s_memrealtime() < te) __builtin_amdgcn_s_sleep(8); }
    if (MK_LAST_PHASE < 2 + 9 && args.ph_hi == NPH) { phase_begin(F); for (size_t i = (size_t)F.bid * NTHREADS + F.tid; i < (size_t)M * D / 4; i += (size_t)F.G * NTHREADS) ((f32x4*)F.out)[i] = ((const f32x4*)F.in[I_X])[i]; }
}
#undef IN
#undef SEAM
#undef GW_
#undef WM_

extern "C" void kernel_launch(void* const* d_in, const int* in_sizes, int n_in, void* d_out, int out_size, void* d_ws, size_t ws_size, hipStream_t stream) {
    static int grid = 0;
    if (grid == 0) {
        if (n_in != N_IN || out_size != M * D) { fprintf(stderr, "kernel_launch: unexpected shapes (n_in %d out %d ws %zu need %zu)\n", n_in, out_size, ws_size, (size_t)WS_END); grid = -1; return; }
        if (ws_size < WS_END) { fprintf(stderr, "kernel_launch: ws too small %zu < %zu\n", ws_size, (size_t)WS_END); grid = -2; }
        int dev = 0, cus = 0;
        if (hipGetDevice(&dev) != hipSuccess || hipDeviceGetAttribute(&cus, hipDeviceAttributeMultiprocessorCount, dev) != hipSuccess) { grid = -1; return; }
        if (hipFuncSetAttribute((const void*)mk_fwd, hipFuncAttributeMaxDynamicSharedMemorySize, LDS_BYTES) != hipSuccess) { fprintf(stderr, "kernel_launch: hipFuncSetAttribute failed\n"); grid = -1; return; }
        (void)hipGetLastError();
        grid = cus;
    }
    if (grid == -2) { (void)hipMemsetAsync(d_out, 0, (size_t)out_size * 4, stream); return; }
    if (grid < 0) return;
    (void)hipMemsetAsync((char*)d_ws + WS_CTL, 0, CTL_ZERO_BYTES, stream);
    Args a{};
    for (int i = 0; i < N_IN; ++i) a.in[i] = (const float*)d_in[i];
    a.out = (float*)d_out; a.ws = (unsigned char*)d_ws;
#if MK_PER_PHASE
    for (int p = 0; p < NPH && p <= MK_LAST_PHASE; ++p) { a.ph_lo = p; a.ph_hi = p + 1; hipLaunchKernelGGL(mk_fwd, dim3(grid), dim3(NTHREADS), LDS_BYTES, stream, a); }
#else
    a.ph_lo = 0; a.ph_hi = NPH;
    hipLaunchKernelGGL(mk_fwd, dim3(grid), dim3(NTHREADS), LDS_BYTES, stream, a);
#endif
}
```
